# Optimizing an MI355X kernel written in HIP

```python
import jax, jax.numpy as jnp
from jax import lax
import numpy as np

D_MODEL = 4096
BATCH = 4
SEQ = 2048
DEPTH = 2
DEC_BATCH = 32
DEC_SEQ = 64
PAST_LEN = 4096

CHUNK = 64
N_EVEN = (DEPTH + 1) // 2
N_ODD = DEPTH // 2
CONV_DIM = D_MODEL // 2
CONV_W = 3
N_HEADS = 32
N_KV = 8
HEAD_DIM = 64
Q_DIM = N_HEADS * HEAD_DIM
KV_DIM = N_KV * HEAD_DIM
WINDOW = 128
WIN_CHUNKS = WINDOW // CHUNK
IN_AB_DIM = 3 * CONV_DIM + Q_DIM + 2 * KV_DIM
MIX_AB_DIM = CONV_DIM + Q_DIM
SPLIT_AB = (CONV_DIM, 2 * CONV_DIM, 3 * CONV_DIM, 3 * CONV_DIM + Q_DIM, 3 * CONV_DIM + Q_DIM + KV_DIM)
GMLP_CHUNK = 128
GMLP_DIM = D_MODEL
GMLP_GROUPS = 16
GMLP_GDIM = GMLP_DIM // GMLP_GROUPS
D_FF = 11008
FFN_CONV_W = 3
RMS_EPS = 1e-6
LN_EPS = 1e-5
NEG_INF = -1e30

kernel_name = 'chunk_causal_hybrid_conv_swa_gmlp_step'


def alibi_slopes():
    exps = np.arange(1, N_HEADS + 1, dtype=np.float32) * (8.0 / N_HEADS)
    return jnp.asarray(np.power(2.0, -exps).astype(np.float32))


def rmsnorm(x, g):
    xf = x.astype(jnp.float32)
    y = xf * lax.rsqrt(jnp.mean(xf * xf, axis=-1, keepdims=True) + RMS_EPS)
    return (y * g.astype(jnp.float32)).astype(x.dtype)


def layernorm(x, g, b):
    xf = x.astype(jnp.float32)
    mu = jnp.mean(xf, axis=-1, keepdims=True)
    var = jnp.mean(jnp.square(xf - mu), axis=-1, keepdims=True)
    y = (xf - mu) * lax.rsqrt(var + LN_EPS) * g.astype(jnp.float32) + b.astype(jnp.float32)
    return y.astype(x.dtype)


def causal_dwconv(x, prev, w):
    t = x.shape[1]
    xp = jnp.concatenate([prev.astype(x.dtype), x], axis=1)
    out = xp[:, 0:t] * w[0]
    for j in range(1, w.shape[0]):
        out = out + xp[:, j:j + t] * w[j]
    return out, xp[:, t:]


def attention_core(q, k, v, q_pos, k_pos, sinks):
    bsz, n, t = q.shape[0], q.shape[1], q.shape[2]
    g = N_HEADS // N_KV
    qg = q.reshape(bsz, n, t, N_KV, g, HEAD_DIM)
    scores = jnp.einsum('bntkgd,bnskd->bnkgts', qg, k,
                        preferred_element_type=jnp.float32) * (HEAD_DIM ** -0.5)
    slopes = alibi_slopes().reshape(N_KV, g)
    dist = jnp.abs(q_pos[:, :, None] - k_pos[:, None, :]).astype(jnp.float32)
    bias = -slopes[None, :, :, None, None] * dist[:, None, None]
    valid = (k_pos >= 0)[:, None, None, None, :]
    scores = jnp.where(valid[None], scores + bias[None], NEG_INF)
    sink = sinks.astype(jnp.float32).reshape(1, 1, N_KV, g, 1, 1)
    m = jnp.maximum(jnp.max(scores, axis=-1, keepdims=True), sink)
    p = jnp.exp(scores - m)
    denom = jnp.sum(p, axis=-1, keepdims=True) + jnp.exp(sink - m)
    out = jnp.einsum('bnkgts,bnskd->bntkgd', p / denom, v.astype(jnp.float32))
    return out.reshape(bsz, n * t, N_HEADS * HEAD_DIM).astype(q.dtype)


def swa_prompt(q, k, v, sinks):
    bsz, s = q.shape[0], q.shape[1]
    nc = s // CHUNK
    qc = q.reshape(bsz, nc, CHUNK, N_HEADS, HEAD_DIM)
    kr = k.reshape(bsz, s, N_KV, HEAD_DIM)
    vr = v.reshape(bsz, s, N_KV, HEAD_DIM)
    pad = jnp.zeros((bsz, WIN_CHUNKS, CHUNK, N_KV, HEAD_DIM), k.dtype)
    kp = jnp.concatenate([pad, kr.reshape(bsz, nc, CHUNK, N_KV, HEAD_DIM)], axis=1)
    vp = jnp.concatenate([pad, vr.reshape(bsz, nc, CHUNK, N_KV, HEAD_DIM)], axis=1)
    kb = jnp.concatenate([kp[:, j:j + nc] for j in range(WIN_CHUNKS + 1)], axis=2)
    vb = jnp.concatenate([vp[:, j:j + nc] for j in range(WIN_CHUNKS + 1)], axis=2)
    c = jnp.arange(nc, dtype=jnp.int32)[:, None]
    q_pos = c * CHUNK + jnp.arange(CHUNK, dtype=jnp.int32)[None]
    k_pos = (c - WIN_CHUNKS) * CHUNK + jnp.arange((WIN_CHUNKS + 1) * CHUNK, dtype=jnp.int32)[None]
    out = attention_core(qc, kb, vb, q_pos, k_pos, sinks)
    return out, kr[:, s - WINDOW:], vr[:, s - WINDOW:]


def swa_sample(q, k, v, k_cache, v_cache, sinks):
    bsz, t = q.shape[0], q.shape[1]
    qc = q.reshape(bsz, 1, t, N_HEADS, HEAD_DIM)
    k_all = jnp.concatenate([k_cache.astype(k.dtype), k.reshape(bsz, t, N_KV, HEAD_DIM)], axis=1)
    v_all = jnp.concatenate([v_cache.astype(v.dtype), v.reshape(bsz, t, N_KV, HEAD_DIM)], axis=1)
    q_pos = (PAST_LEN + jnp.arange(t, dtype=jnp.int32))[None]
    k_pos = (PAST_LEN - WINDOW + jnp.arange(WINDOW + t, dtype=jnp.int32))[None]
    out = attention_core(qc, k_all[:, None], v_all[:, None], q_pos, k_pos, sinks)
    return out, k_all[:, t:], v_all[:, t:]


def mixer_ab(h, conv_prev, k_cache, v_cache, w_in, conv_w, sinks, w_out):
    proj = h @ w_in
    gate_b, gate_c, hv, q, k, v = jnp.split(proj, SPLIT_AB, axis=-1)
    a, conv_state = causal_dwconv(gate_c * hv, conv_prev, conv_w)
    a = gate_b * a
    if k_cache is None:
        attn, k_state, v_state = swa_prompt(q, k, v, sinks)
    else:
        attn, k_state, v_state = swa_sample(q, k, v, k_cache, v_cache, sinks)
    y = jnp.concatenate([a, attn], axis=-1) @ w_out
    return y, conv_state, k_state, v_state


def gmlp_mixer(h, w_in, ln_g, ln_b, w_s, b_s, w_out):
    bsz, t = h.shape[0], h.shape[1]
    z = jax.nn.gelu(h @ w_in, approximate=False)
    u, v = jnp.split(z, 2, axis=-1)
    v = layernorm(v, ln_g, ln_b)
    cl = min(t, GMLP_CHUNK)
    n = t // cl
    vc = v.reshape(bsz, n, cl, GMLP_GROUPS, GMLP_GDIM)
    ws = jnp.tril(w_s[:, :cl, :cl])
    s = jnp.einsum('gts,bnsgc->bntgc', ws, vc) + b_s[:, :cl].T[None, None, :, :, None]
    y = (u * s.reshape(bsz, t, GMLP_DIM)) @ w_out
    return y, v


def conv_ffn(h, prev, w_up, conv_w, conv_b, w_down):
    up = h @ w_up
    c, state = causal_dwconv(up, prev, conv_w)
    g, u = jnp.split(c + conv_b, 2, axis=-1)
    return (jax.nn.silu(g) * u) @ w_down, state


def trunk(x, conv_a_cache, swa_k_cache, swa_v_cache, ffn_cache, norm_mix, norm_ffn, norm_final,
          w_in_ab, conv_w_a, sinks, w_out_ab, w_in_c, ln_g_c, ln_b_c, w_s_c, b_s_c, w_out_c,
          w_up_ffn, conv_w_ffn, conv_b_ffn, w_down_ffn):
    sample = ffn_cache is not None
    bsz = x.shape[0]
    conv_states, k_states, v_states, ffn_states, gv_states = [], [], [], [], []
    for layer in range(DEPTH):
        i = layer // 2
        h = rmsnorm(x, norm_mix[layer])
        if layer % 2 == 0:
            if sample:
                prev, kc, vc = conv_a_cache[i], swa_k_cache[i], swa_v_cache[i]
            else:
                prev, kc, vc = jnp.zeros((bsz, CONV_W - 1, CONV_DIM), x.dtype), None, None
            y, cs, ks, vs = mixer_ab(h, prev, kc, vc, w_in_ab[i], conv_w_a[i], sinks[i], w_out_ab[i])
            conv_states.append(cs)
            k_states.append(ks)
            v_states.append(vs)
        else:
            y, gv = gmlp_mixer(h, w_in_c[i], ln_g_c[i], ln_b_c[i], w_s_c[i], b_s_c[i], w_out_c[i])
            gv_states.append(gv)
        x = x + y
        h = rmsnorm(x, norm_ffn[layer])
        fprev = ffn_cache[layer] if sample else jnp.zeros((bsz, FFN_CONV_W - 1, 2 * D_FF), x.dtype)
        y, fs = conv_ffn(h, fprev, w_up_ffn[layer], conv_w_ffn[layer], conv_b_ffn[layer], w_down_ffn[layer])
        ffn_states.append(fs)
        x = x + y
    x = rmsnorm(x, norm_final)
    return (x, jnp.stack(conv_states), jnp.stack(k_states), jnp.stack(v_states),
            jnp.stack(ffn_states), jnp.stack(gv_states))


def setup_inputs(seed: int = 0) -> dict:
    key = jax.random.key(seed)
    ks = jax.random.split(key, 24)

    def nrm(k, shape, scale):
        return jax.random.normal(k, shape, jnp.float32) * scale

    return {
        'x_prompt': nrm(ks[0], (BATCH, SEQ, D_MODEL), 1.0),
        'x_sample': nrm(ks[1], (DEC_BATCH, DEC_SEQ, D_MODEL), 1.0),
        'state_conv_a': nrm(ks[2], (N_EVEN, DEC_BATCH, CONV_W - 1, CONV_DIM), 1.0),
        'cache_swa_k': nrm(ks[3], (N_EVEN, DEC_BATCH, WINDOW, N_KV, HEAD_DIM), 1.0),
        'cache_swa_v': nrm(ks[4], (N_EVEN, DEC_BATCH, WINDOW, N_KV, HEAD_DIM), 1.0),
        'state_ffn_conv': nrm(ks[5], (DEPTH, DEC_BATCH, FFN_CONV_W - 1, 2 * D_FF), 1.0),
        'norm_mix': 1.0 + nrm(ks[6], (DEPTH, D_MODEL), 0.05),
        'norm_ffn': 1.0 + nrm(ks[7], (DEPTH, D_MODEL), 0.05),
        'norm_final': 1.0 + nrm(ks[8], (D_MODEL,), 0.05),
        'w_in_ab': nrm(ks[9], (N_EVEN, D_MODEL, IN_AB_DIM), D_MODEL ** -0.5),
        'conv_w_a': nrm(ks[10], (N_EVEN, CONV_W, CONV_DIM), CONV_W ** -0.5),
        'sinks': nrm(ks[11], (N_EVEN, N_HEADS), 0.5),
        'w_out_ab': nrm(ks[12], (N_EVEN, MIX_AB_DIM, D_MODEL), MIX_AB_DIM ** -0.5),
        'w_in_c': nrm(ks[13], (N_ODD, D_MODEL, 2 * GMLP_DIM), D_MODEL ** -0.5),
        'ln_g_c': 1.0 + nrm(ks[14], (N_ODD, GMLP_DIM), 0.05),
        'ln_b_c': nrm(ks[15], (N_ODD, GMLP_DIM), 0.02),
        'w_s_c': nrm(ks[16], (N_ODD, GMLP_GROUPS, GMLP_CHUNK, GMLP_CHUNK), GMLP_CHUNK ** -0.5),
        'b_s_c': 1.0 + nrm(ks[17], (N_ODD, GMLP_GROUPS, GMLP_CHUNK), 0.1),
        'w_out_c': nrm(ks[18], (N_ODD, GMLP_DIM, D_MODEL), GMLP_DIM ** -0.5),
        'w_up_ffn': nrm(ks[19], (DEPTH, D_MODEL, 2 * D_FF), D_MODEL ** -0.5),
        'conv_w_ffn': nrm(ks[20], (DEPTH, FFN_CONV_W, 2 * D_FF), FFN_CONV_W ** -0.5),
        'conv_b_ffn': nrm(ks[21], (DEPTH, 2 * D_FF), 0.02),
        'w_down_ffn': nrm(ks[22], (DEPTH, D_FF, D_MODEL), D_FF ** -0.5),
    }


def reference(x_prompt, x_sample, state_conv_a, cache_swa_k, cache_swa_v, state_ffn_conv,
              norm_mix, norm_ffn, norm_final, w_in_ab, conv_w_a, sinks, w_out_ab,
              w_in_c, ln_g_c, ln_b_c, w_s_c, b_s_c, w_out_c,
              w_up_ffn, conv_w_ffn, conv_b_ffn, w_down_ffn):
    y_p, conv_p, k_p, v_p, ffn_p, _ = trunk(
        x_prompt, None, None, None, None, norm_mix, norm_ffn, norm_final,
        w_in_ab, conv_w_a, sinks, w_out_ab, w_in_c, ln_g_c, ln_b_c, w_s_c, b_s_c, w_out_c,
        w_up_ffn, conv_w_ffn, conv_b_ffn, w_down_ffn)
    y_s, conv_s, k_s, v_s, ffn_s, gv_s = trunk(
        x_sample, state_conv_a, cache_swa_k, cache_swa_v, state_ffn_conv, norm_mix, norm_ffn, norm_final,
        w_in_ab, conv_w_a, sinks, w_out_ab, w_in_c, ln_g_c, ln_b_c, w_s_c, b_s_c, w_out_c,
        w_up_ffn, conv_w_ffn, conv_b_ffn, w_down_ffn)
    return (y_p, y_s, conv_p, conv_s, k_p, k_s, v_p, v_s, ffn_p, ffn_s, gv_s)
```

```cpp
#include <hip/hip_runtime.h>
#include <cstdio>
#include <cstdint>
namespace pg8 {
#define PG8_LAS __attribute__((address_space(3)))
typedef unsigned short bf16_t;
typedef short bf16x8 __attribute__((ext_vector_type(8)));
typedef float f32x4 __attribute__((ext_vector_type(4)));
typedef unsigned u32x4 __attribute__((ext_vector_type(4)));
constexpr int BM = 256, BK = 64, HALF = 128, HTB = HALF * BK * 2  , STAGE_BYTES = 8 * HTB, NXCD = 8, WGM = 8;

__host__ __device__ __forceinline__ int lds_byte(int r, int c) { const int st = (r >> 4) * 2 + (c >> 5), rr = r & 15, cc = c & 31, ob = rr * 64 + cc * 2; return st * 1024 + (ob ^ (((ob >> 9) & 1) << 5)); }
__host__ __device__ __forceinline__ void stage_rc(int b, int& R, int& C) { const int st = b / 1024, sb = b % 1024, swz = sb ^ (((sb >> 9) & 1) << 5); R = (st >> 1) * 16 + swz / 64; C = (st & 1) * 32 + (swz % 64) / 2; }
__host__ __device__ __forceinline__ int perm32(int rho) { const int n = rho >> 4, i = rho & 15; return 8 * (i >> 2) + 4 * n + (i & 3); }

struct Unit { int pm, pn; };
struct Gemm { const bf16_t* A; const bf16_t* Bt; int M, N, K; };

struct StaticOrder {
    int nM, nN, nwg, G, c;
    __host__ __device__ void init(int M, int N, int G_, int c_) { nM = M / BM; nN = N / BM; nwg = nM * nN; G = G_; c = c_; }
    __host__ __device__ bool next(int i, Unit& u) const {
        const long L = (long)i * G + c; if (L >= nwg) return false;
        int wgid = (int)L; { const int q = nwg / NXCD, r = nwg % NXCD, xcd = wgid % NXCD, off = wgid / NXCD; wgid = (xcd < r ? xcd * (q + 1) : r * (q + 1) + (xcd - r) * q) + off; }
        const int nig = WGM * nN, gid = wgid / nig, fm = gid * WGM, gsz = (nM - fm) < WGM ? (nM - fm) : WGM;
        u.pm = fm + ((wgid % nig) % gsz); u.pn = (wgid % nig) / gsz; return true;
    }
    __device__ __forceinline__ void a_ready(const Unit&) const {}
    __device__ __forceinline__ void done(const Unit&) const {}
};

__device__ __forceinline__ unsigned cvt_pk_bf16(float lo, float hi) { unsigned r; asm volatile("v_cvt_pk_bf16_f32 %0, %1, %2" : "=v"(r) : "v"(lo), "v"(hi)); return r; }
typedef float f32x2 __attribute__((ext_vector_type(2)));
__device__ __forceinline__ f32x2 gelu_pk(f32x2 v) {
    const f32x2 av = __builtin_elementwise_abs(v), d = av * 0.2316418882f + 1.0f;
    f32x2 t; t.x = __builtin_amdgcn_rcpf(d.x); t.y = __builtin_amdgcn_rcpf(d.y);
    f32x2 q = t * 0.5307027145f + (-0.7265760135f); q = q * t + 0.7107068705f; q = q * t + (-0.142248368f); q = q * t + 0.127414796f; q = q * t;
    const f32x2 s = (v * v) * (-0.72134752044f);
    f32x2 e; e.x = __builtin_amdgcn_exp2f(s.x); e.y = __builtin_amdgcn_exp2f(s.y);
    const f32x2 m = v * (q * e), r = v - m;
    f32x2 o; o.x = v.x < 0.f ? m.x : r.x; o.y = v.y < 0.f ? m.y : r.y; return o;
}

template <int ACT> struct EpiBf16 {
    static constexpr bool PERM = true, AFTER_DRAIN = false;
    bf16_t* O; int ldc;
    __device__ __forceinline__ void operator()(const f32x4 (&acc)[2][2][4][2], const Unit& u, int wr, int wc, int fr, int fq) const {
        const int row0 = u.pm * BM + wr * 64 + fr; const int col0 = u.pn * BM + wc * 32 + 8 * fq;
#pragma unroll
        for (int ai = 0; ai < 2; ++ai)
#pragma unroll
            for (int m = 0; m < 4; ++m) { bf16_t* rowp = O + (size_t)(row0 + ai * HALF + m * 16) * ldc + col0;
#pragma unroll
                for (int bj = 0; bj < 2; ++bj) { f32x4 v0 = acc[ai][bj][m][0], v1 = acc[ai][bj][m][1];
                    if (ACT == 1) { f32x2 a = gelu_pk((f32x2){v0[0], v0[1]}), b = gelu_pk((f32x2){v0[2], v0[3]}), c = gelu_pk((f32x2){v1[0], v1[1]}), d = gelu_pk((f32x2){v1[2], v1[3]});
                        v0 = (f32x4){a.x, a.y, b.x, b.y}; v1 = (f32x4){c.x, c.y, d.x, d.y}; }
                    u32x4 w; w.x = cvt_pk_bf16(v0[0], v0[1]); w.y = cvt_pk_bf16(v0[2], v0[3]); w.z = cvt_pk_bf16(v1[0], v1[1]); w.w = cvt_pk_bf16(v1[2], v1[3]);
                    *(u32x4*)(rowp + bj * HALF) = w; } }
    }
};
struct EpiRes {
    static constexpr bool PERM = false, AFTER_DRAIN = false;
    const float* bp; const float* bs; float* out; int ld; int split;
    __device__ __forceinline__ void operator()(const f32x4 (&acc)[2][2][4][2], const Unit& u, int wr, int wc, int fr, int fq) const {
        const int row0 = u.pm * BM + wr * 64 + fr, col0 = u.pn * BM + wc * 32 + 4 * fq;
#pragma unroll
        for (int ai = 0; ai < 2; ++ai)
#pragma unroll
            for (int m = 0; m < 4; ++m) { const int row = row0 + ai * HALF + m * 16;
                const float* br = (row < split ? bp + (size_t)row * ld : bs + (size_t)(row - split) * ld) + col0; float* orow = out + (size_t)row * ld + col0;
#pragma unroll
                for (int bj = 0; bj < 2; ++bj)
#pragma unroll
                    for (int n = 0; n < 2; ++n) { const f32x4 b = *(const f32x4*)(br + bj * HALF + n * 16); *(f32x4*)(orow + bj * HALF + n * 16) = b + acc[ai][bj][m][n]; } }
    }
};

template <class Epi, class Sched, bool ALIGN_EPI = false, bool SP2 = false>
__device__ __forceinline__ void gemm_phase(PG8_LAS unsigned char* lds, const Gemm g, const Sched& S, const Epi& E) {
    const int tid = threadIdx.x, wid = __builtin_amdgcn_readfirstlane(tid >> 6), lane = tid & 63, wr = wid >> 2, wc = wid & 3, fr = lane & 15, fq = lane >> 4;
    const int K = g.K, nt = K / BK;
    unsigned voffA[2], voffB[2];
#pragma unroll
    for (int i = 0; i < 2; ++i) { int R, C; stage_rc(tid * 16 + i * 8192, R, C); const int Rb = Epi::PERM ? ((R & ~31) + perm32(R & 31)) : R;
        voffA[i] = (unsigned)(R * K + C) * 2u; voffB[i] = (unsigned)(Rb * K + C) * 2u; }
    const size_t kstep = (size_t)(BK * 2);
    const size_t hstep = (size_t)HALF * K * 2;
    const size_t tstep = 2 * hstep;
    const unsigned ldsw = (unsigned)wid * 1024u;
    const int aoff = lds_byte(wr * 64 + fr, fq * 8), boff = lds_byte(wc * 32 + fr, fq * 8);
#define PG8_SA(b, h) (((b) * 2 + (h)) * HTB)
#define PG8_SB(b, h) ((4 + (b) * 2 + (h)) * HTB)
#define PG8_STAGE(bufoff, gbase, voff) do { _Pragma("unroll") for (int _i = 0; _i < 2; ++_i) \
        __builtin_amdgcn_global_load_lds((const unsigned*)((const char*)(gbase) + (voff)[_i]), (PG8_LAS unsigned*)(lds + (bufoff) + ldsw + _i * 8192), 16, 0, 0); } while (0)
#define PG8_LDA(dst, b, h) do { _Pragma("unroll") for (int m = 0; m < 4; ++m) _Pragma("unroll") for (int k = 0; k < 2; ++k) dst[m][k] = *(const PG8_LAS bf16x8*)(lds + PG8_SA(b, h) + aoff + m * 2048 + k * 1024); } while (0)
#define PG8_LDB(dst, b, h) do { _Pragma("unroll") for (int n = 0; n < 2; ++n) _Pragma("unroll") for (int k = 0; k < 2; ++k) dst[n][k] = *(const PG8_LAS bf16x8*)(lds + PG8_SB(b, h) + boff + n * 2048 + k * 1024); } while (0)
#define PG8_MMA(ai, bj, At, Bt) do { __builtin_amdgcn_s_setprio(1); _Pragma("unroll") for (int m = 0; m < 4; ++m) _Pragma("unroll") for (int n = 0; n < 2; ++n) _Pragma("unroll") for (int k = 0; k < 2; ++k) \
        acc[ai][bj][m][n] = __builtin_amdgcn_mfma_f32_16x16x32_bf16(Bt[n][k], At[m][k], acc[ai][bj][m][n], 0, 0, 0); __builtin_amdgcn_s_setprio(0); } while (0)
#define PG8_WAIT_V(n) asm volatile("s_waitcnt vmcnt(" #n ")" ::: "memory")
#define PG8_WAIT_L(n) asm volatile("s_waitcnt lgkmcnt(" #n ")" ::: "memory")
#define PG8_BAR __builtin_amdgcn_s_barrier()
#define PG8_SCHED __builtin_amdgcn_sched_barrier(0)
    Unit cur, nxt; int ui = 0;
    if (!S.next(0, cur)) return;
    f32x4 acc[2][2][4][2];
#pragma unroll
    for (int a = 0; a < 2; ++a)
#pragma unroll
        for (int b = 0; b < 2; ++b)
#pragma unroll
            for (int m = 0; m < 4; ++m)
#pragma unroll
                for (int n = 0; n < 2; ++n) acc[a][b][m][n] = (f32x4){0.f, 0.f, 0.f, 0.f};
    bf16x8 At[4][2], B0[2][2], B1[2][2];
    const char* cA = (const char*)g.A + (size_t)cur.pm * tstep; const char* cB = (const char*)g.Bt + (size_t)cur.pn * tstep;
    S.a_ready(cur);
    if constexpr (SP2) {
        PG8_STAGE(PG8_SB(0, 0), cB, voffB); PG8_STAGE(PG8_SB(0, 1), cB + hstep, voffB); PG8_STAGE(PG8_SA(0, 0), cA, voffA); PG8_STAGE(PG8_SA(0, 1), cA + hstep, voffA);
        if (wr == 1) PG8_BAR;
        PG8_WAIT_V(2); PG8_BAR;
        PG8_STAGE(PG8_SB(1, 0), cB + kstep, voffB); PG8_STAGE(PG8_SA(1, 0), cA + kstep, voffA); PG8_STAGE(PG8_SB(1, 1), cB + hstep + kstep, voffB);
        PG8_WAIT_V(6); PG8_BAR;
    } else {
        PG8_STAGE(PG8_SB(0, 0), cB, voffB); PG8_STAGE(PG8_SA(0, 0), cA, voffA); PG8_STAGE(PG8_SB(0, 1), cB + hstep, voffB); PG8_STAGE(PG8_SA(0, 1), cA + hstep, voffA);
        if (wr == 1) PG8_BAR;
        PG8_WAIT_V(4); PG8_BAR;
        PG8_STAGE(PG8_SB(1, 0), cB + kstep, voffB); PG8_STAGE(PG8_SA(1, 0), cA + kstep, voffA); PG8_STAGE(PG8_SB(1, 1), cB + hstep + kstep, voffB);
        PG8_WAIT_V(6); PG8_BAR;
    }
    for (;;) {
        const bool has_next = S.next(ui + 1, nxt);
        const char* nA = has_next ? (const char*)g.A + (size_t)nxt.pm * tstep : cA; const char* nB = has_next ? (const char*)g.Bt + (size_t)nxt.pn * tstep : cB;
        for (int t = 0; t < nt; t += 2) {
            const bool last = (t == nt - 2);
            const char* a1 = cA + (size_t)(t + 1) * kstep;
            const char* a2 = last ? nA : cA + (size_t)(t + 2) * kstep; const char* b2 = last ? nB : cB + (size_t)(t + 2) * kstep;
            const char* a3 = a2 + kstep; const char* b3 = b2 + kstep;
            if (last && has_next) S.a_ready(nxt);
            if constexpr (SP2) {
            PG8_LDB(B0, 0, 0); PG8_LDB(B1, 0, 1); PG8_SCHED; PG8_LDA(At, 0, 0); PG8_STAGE(PG8_SA(1, 1), a1 + hstep, voffA);
            PG8_WAIT_V(8); PG8_WAIT_L(0); PG8_BAR; PG8_MMA(0, 0, At, B0); PG8_MMA(0, 1, At, B1); PG8_BAR; PG8_SCHED;
            PG8_LDA(At, 0, 1); PG8_STAGE(PG8_SB(0, 0), b2, voffB); PG8_STAGE(PG8_SB(0, 1), b2 + hstep, voffB); PG8_STAGE(PG8_SA(0, 0), a2, voffA);
            PG8_WAIT_V(8); PG8_WAIT_L(0); PG8_BAR; PG8_MMA(1, 0, At, B0); PG8_MMA(1, 1, At, B1); PG8_BAR; PG8_SCHED;
            PG8_LDB(B0, 1, 0); PG8_LDB(B1, 1, 1); PG8_SCHED; PG8_LDA(At, 1, 0); PG8_STAGE(PG8_SA(0, 1), a2 + hstep, voffA);
            PG8_WAIT_V(8); PG8_WAIT_L(0); PG8_BAR; PG8_MMA(0, 0, At, B0); PG8_MMA(0, 1, At, B1); PG8_BAR; PG8_SCHED;
            PG8_LDA(At, 1, 1); PG8_STAGE(PG8_SB(1, 0), b3, voffB); PG8_STAGE(PG8_SB(1, 1), b3 + hstep, voffB); PG8_STAGE(PG8_SA(1, 0), a3, voffA);
            PG8_WAIT_V(8); PG8_WAIT_L(0); PG8_BAR; PG8_MMA(1, 0, At, B0); PG8_MMA(1, 1, At, B1); PG8_BAR; PG8_SCHED;
            } else {
            PG8_LDB(B0, 0, 0); PG8_SCHED; PG8_LDA(At, 0, 0); PG8_STAGE(PG8_SA(1, 1), a1 + hstep, voffA);
            PG8_WAIT_L(8); PG8_BAR; PG8_WAIT_L(0); PG8_MMA(0, 0, At, B0); PG8_BAR; PG8_SCHED;
            PG8_LDB(B1, 0, 1); PG8_STAGE(PG8_SB(0, 0), b2, voffB);
            PG8_BAR; PG8_WAIT_L(0); PG8_MMA(0, 1, At, B1); PG8_BAR;
            PG8_LDA(At, 0, 1); PG8_STAGE(PG8_SA(0, 0), a2, voffA);
            PG8_BAR; PG8_WAIT_L(0); PG8_MMA(1, 0, At, B0); PG8_BAR; PG8_SCHED;
            PG8_STAGE(PG8_SB(0, 1), b2 + hstep, voffB);
            PG8_WAIT_V(6); PG8_BAR; PG8_MMA(1, 1, At, B1); PG8_BAR;
            PG8_LDB(B0, 1, 0); PG8_SCHED; PG8_LDA(At, 1, 0); PG8_STAGE(PG8_SA(0, 1), a2 + hstep, voffA);
            PG8_WAIT_L(8); PG8_BAR; PG8_WAIT_L(0); PG8_MMA(0, 0, At, B0); PG8_BAR; PG8_SCHED;
            PG8_LDB(B1, 1, 1); PG8_STAGE(PG8_SB(1, 0), b3, voffB);
            PG8_BAR; PG8_WAIT_L(0); PG8_MMA(0, 1, At, B1); PG8_BAR;
            PG8_LDA(At, 1, 1); PG8_STAGE(PG8_SA(1, 0), a3, voffA);
            PG8_BAR; PG8_WAIT_L(0); PG8_MMA(1, 0, At, B0); PG8_BAR; PG8_SCHED;
            PG8_STAGE(PG8_SB(1, 1), b3 + hstep, voffB);
            PG8_WAIT_V(6); PG8_BAR; PG8_MMA(1, 1, At, B1); PG8_BAR;
            }
        }
        if constexpr (ALIGN_EPI) { if (wr == 0) PG8_BAR; }
        if constexpr (!Epi::AFTER_DRAIN) { E(acc, cur, wr, wc, fr, fq); S.done(cur); }
        if (!has_next) break;
#pragma unroll
        for (int a = 0; a < 2; ++a)
#pragma unroll
            for (int b = 0; b < 2; ++b)
#pragma unroll
                for (int m = 0; m < 4; ++m)
#pragma unroll
                    for (int n = 0; n < 2; ++n) acc[a][b][m][n] = (f32x4){0.f, 0.f, 0.f, 0.f};
        cur = nxt; cA = nA; cB = nB; ++ui;
        if constexpr (ALIGN_EPI) { if (wr == 1) PG8_BAR; }
    }
    PG8_WAIT_V(0);
    if constexpr (!ALIGN_EPI) { if (wr == 0) PG8_BAR; }
    PG8_BAR;
    if constexpr (Epi::AFTER_DRAIN) { E.fused(acc, cur, wr, wc, fr, fq, lds, wid, lane); S.done(cur); }
#undef PG8_SA
#undef PG8_SB
#undef PG8_STAGE
#undef PG8_LDA
#undef PG8_LDB
#undef PG8_MMA
#undef PG8_WAIT_V
#undef PG8_WAIT_L
#undef PG8_BAR
#undef PG8_SCHED
}
}

#define GAS __attribute__((address_space(1)))
#define LAS __attribute__((address_space(3)))
typedef unsigned short bf16;
typedef unsigned v4u __attribute__((ext_vector_type(4)));
typedef float f32x4 __attribute__((ext_vector_type(4)));
typedef short bf16x8 __attribute__((ext_vector_type(8)));
typedef GAS unsigned gu32;
typedef GAS unsigned long long gu64;
#define RLX_AGENT __ATOMIC_RELAXED, __HIP_MEMORY_SCOPE_AGENT
#define LDS_WAIT() asm volatile("s_waitcnt lgkmcnt(0)" ::: "memory")
#define VM_WAIT() asm volatile("s_waitcnt vmcnt(0)" ::: "memory")
__device__ __forceinline__ unsigned long long rt() { return __builtin_amdgcn_s_memrealtime(); }

#define XB_TMO      128
#define XB_XCNT(j)  (256  + 64 * (j))
#define XB_XSUB(j)  (1280 + 64 * (j))
#define XB_XGEN(j)  (2304 + 64 * (j))
#define XB_TOP      3328
#define XB_TOPGEN   3392
#define XCD_BAR_WORDS 3456
#define XB_SPIN_CAP (1u << 18)

__device__ __forceinline__ unsigned xb_ld(unsigned* p)              { return __hip_atomic_load(p, __ATOMIC_RELAXED, __HIP_MEMORY_SCOPE_AGENT); }
__device__ __forceinline__ unsigned xb_add(unsigned* p, unsigned v) { return __hip_atomic_fetch_add(p, v, __ATOMIC_RELAXED, __HIP_MEMORY_SCOPE_AGENT); }
__device__ __forceinline__ unsigned xb_xcc_id() { return (unsigned)__builtin_amdgcn_s_getreg((3 << 11) | 20) & 0xFu; }
#define XB_SPIN(cond, bar) do { unsigned _sp = 0; while (cond) { __builtin_amdgcn_s_sleep(1); \
    if ((++_sp & 255u) == 0u) { if (xb_ld(&(bar)[XB_TMO])) break; if (_sp > XB_SPIN_CAP) { atomicAdd(&(bar)[XB_TMO], 1u); break; } } } } while (0)

struct XcdBarrier {
    unsigned* bar; unsigned x;
    volatile LAS unsigned* st;
};

__device__ __forceinline__ XcdBarrier xcd_barrier_post(unsigned* bar, volatile LAS unsigned* st) {
    XcdBarrier b; b.bar = bar; b.x = xb_xcc_id(); b.st = st;
    if (threadIdx.x == 0) (void)xb_add(&bar[XB_XCNT(b.x)], 1u);
    return b;
}
__device__ __forceinline__ void xcd_barrier_complete(unsigned* bar, unsigned x, unsigned& nloc, unsigned& nx) {
    const unsigned G = gridDim.x * gridDim.y * gridDim.z;
    unsigned sum, cnt, mine, sp = 0u;
    for (;;) {
        sum = 0u; cnt = 0u; mine = 0u;
#pragma unroll
        for (unsigned j = 0; j < 16; ++j) { const unsigned c = xb_ld(&bar[XB_XCNT(j)]); sum += c; cnt += (c > 0u) ? 1u : 0u; mine = (j == x) ? c : mine; }
        if (sum == G) break;
        __builtin_amdgcn_s_sleep(1);
        if ((++sp & 255u) == 0u) { if (xb_ld(&bar[XB_TMO])) break; if (sp > XB_SPIN_CAP) { atomicAdd(&bar[XB_TMO], 1u); break; } }
    }
    nloc = mine > 0u ? mine : 1u; nx = cnt > 0u ? cnt : 1u;
}

__device__ __forceinline__ void xcd_barrier(const XcdBarrier& b) {
    asm volatile("s_waitcnt vmcnt(0)" ::: "memory");
    __syncthreads();
    if (threadIdx.x == 0) {
        unsigned* bar = b.bar;
        __builtin_amdgcn_s_waitcnt(0);
        unsigned nloc = b.st[0], nx = b.st[1];
        if (nloc == 0u) { xcd_barrier_complete(bar, b.x, nloc, nx); b.st[0] = nloc; b.st[1] = nx; }
        const unsigned old = xb_add(&bar[XB_XSUB(b.x)], 1u);
        const unsigned gen = old / nloc;
        if (old + 1u == (gen + 1u) * nloc) {
            __builtin_amdgcn_fence(__ATOMIC_RELEASE, "agent");
            asm volatile("s_waitcnt vmcnt(0)" ::: "memory");
            const unsigned og = xb_add(&bar[XB_TOP], 1u);
            const unsigned tg = og / nx;
            if (og + 1u == (tg + 1u) * nx) xb_add(&bar[XB_TOPGEN], 1u);
            else XB_SPIN(xb_ld(&bar[XB_TOPGEN]) == tg, bar);
            __builtin_amdgcn_fence(__ATOMIC_ACQUIRE, "agent");
            xb_add(&bar[XB_XGEN(b.x)], 1u);
            asm volatile("s_waitcnt vmcnt(0)" ::: "memory");
        } else {
            XB_SPIN(xb_ld(&bar[XB_XGEN(b.x)]) == gen, bar);
            __builtin_amdgcn_fence(__ATOMIC_ACQUIRE, "agent");
            asm volatile("s_waitcnt vmcnt(0)" ::: "memory");
        }
    }
    __syncthreads();
}

constexpr int NWAVES = 8, NTHR = 512;
#ifndef MK_N_LAUNCHES
#define MK_N_LAUNCHES 18
#endif
constexpr int N_PHASES = 18;
constexpr int N_LAUNCHES = MK_N_LAUNCHES;
constexpr int D = 4096, MP = 8192, MS = 2048, M = MP + MS;
constexpr int CONVD = 2048, NPROJ = 9216, DFF = 11008, NUP = 22016, NGM = 8192;
constexpr int OFF_GB = 0, OFF_GC = 2048, OFF_HV = 4096, OFF_Q = 6144, OFF_K = 8192, OFF_V = 8704;
constexpr float RMS_EPS = 1e-6f, LN_EPS = 1e-5f;
constexpr size_t O_YP = 0, O_YS = O_YP + (size_t)MP * D, O_CP = O_YS + (size_t)MS * D, O_CS = O_CP + 4 * 2 * 2048, O_KP = O_CS + 32 * 2 * 2048, O_KS = O_KP + 4 * 128 * 512,
                 O_VP = O_KS + 32 * 128 * 512, O_VS = O_VP + 4 * 128 * 512, O_FP = O_VS + 32 * 128 * 512, O_FS = O_FP + (size_t)2 * 4 * 2 * NUP, O_GV = O_FS + (size_t)2 * 32 * 2 * NUP,
                 O_END = O_GV + (size_t)MS * D;
constexpr size_t MiB = 1u << 20;
constexpr size_t WS_CTL = 0, CTL_ZERO_BYTES = 1 * MiB;
constexpr size_t WS_WIN = 1 * MiB, WS_WOUT = WS_WIN + (size_t)NPROJ * D * 2, WS_WINC = WS_WOUT + (size_t)D * D * 2, WS_WOUTC = WS_WINC + (size_t)NGM * D * 2,
                 WS_WUP = WS_WOUTC + (size_t)D * D * 2, WS_WDN = WS_WUP + (size_t)2 * NUP * D * 2, WS_XN = WS_WDN + (size_t)2 * D * DFF * 2,
                 WS_PROJ = WS_XN + (size_t)M * D * 2, WS_MIX = WS_PROJ + (size_t)M * NPROJ * 2, WS_X = WS_MIX + (size_t)M * D * 2, WS_UP = WS_X + (size_t)M * D * 4,
                 WS_ACT = WS_UP + (size_t)M * NUP * 2, WS_Z = WS_ACT + (size_t)M * DFF * 2, WS_VLN = WS_Z + (size_t)M * NGM * 2, WS_END = WS_VLN + (size_t)M * D * 2;
constexpr int CW_BAR = 4096;
constexpr int RING_OFF = 0, RING_BYTES = 131072, LDSCTL_OFF = RING_BYTES, MISC_OFF = LDSCTL_OFF + 320, LDS_BYTES = 147456;

typedef unsigned short bf16;
typedef unsigned u32x4 __attribute__((ext_vector_type(4)));
typedef unsigned u32x2 __attribute__((ext_vector_type(2)));
typedef float f32x4 __attribute__((ext_vector_type(4)));
typedef float f32x16 __attribute__((ext_vector_type(16)));
typedef short bf16x8 __attribute__((ext_vector_type(8)));
typedef short s16x4 __attribute__((ext_vector_type(4)));
#define LDS_WAIT() asm volatile("s_waitcnt lgkmcnt(0)" ::: "memory")
#define MFMA32(a, b, c) __builtin_amdgcn_mfma_f32_32x32x16_bf16((a), (b), (c), 0, 0, 0)

struct Args {
    const float *x_p, *x_s, *st_conv, *cache_k, *cache_v, *st_ffn, *norm_mix, *norm_ffn, *norm_final, *w_in_ab, *conv_w_a, *sinks, *w_out_ab, *w_in_c, *ln_g, *ln_b, *w_s, *b_s, *w_out_c,
        *w_up, *conv_w_ffn, *conv_b_ffn, *w_down;
    float* out; unsigned char* ws; int ph_lo, ph_hi;
};

__device__ __forceinline__ float bflo(unsigned w) { return __uint_as_float(w << 16); }
__device__ __forceinline__ float bfhi(unsigned w) { return __uint_as_float(w & 0xffff0000u); }
__device__ __forceinline__ unsigned pk2(float lo, float hi) { return pg8::cvt_pk_bf16(lo, hi); }
__device__ __forceinline__ void unpack8(const u32x4 w, float (&f)[8]) { f[0] = bflo(w.x); f[1] = bfhi(w.x); f[2] = bflo(w.y); f[3] = bfhi(w.y); f[4] = bflo(w.z); f[5] = bfhi(w.z); f[6] = bflo(w.w); f[7] = bfhi(w.w); }
__device__ __forceinline__ u32x4 pack8(const float (&f)[8]) { u32x4 w; w.x = pk2(f[0], f[1]); w.y = pk2(f[2], f[3]); w.z = pk2(f[4], f[5]); w.w = pk2(f[6], f[7]); return w; }
__device__ __forceinline__ void load8f(const float* p, float (&f)[8]) { const f32x4 a = *(const f32x4*)p, b = *(const f32x4*)(p + 4); f[0] = a.x; f[1] = a.y; f[2] = a.z; f[3] = a.w; f[4] = b.x; f[5] = b.y; f[6] = b.z; f[7] = b.w; }
__device__ __forceinline__ void store8f(float* p, const float (&f)[8]) { *(f32x4*)p = (f32x4){f[0], f[1], f[2], f[3]}; *(f32x4*)(p + 4) = (f32x4){f[4], f[5], f[6], f[7]}; }
__device__ __forceinline__ float wave_sum(float v) {
#pragma unroll
    for (int o = 1; o < 64; o <<= 1) v += __shfl_xor(v, o);
    return v;
}
__device__ __forceinline__ int crow(int r, int hi) { return (r & 3) + 8 * (r >> 2) + 4 * hi; }

__device__ __forceinline__ void p0_transpose_item(const float* W, int K, int N, bf16* WT, LAS float* scr, int item, int lane) {
    const int nblk = N / 32, kb = item / nblk, nb = item % nblk, k0 = 64 * kb, n0 = 32 * nb;
#pragma unroll 8
    for (int i = 0; i < 32; ++i) { const int kk = 2 * i + (lane >> 5); scr[kk * 33 + (lane & 31)] = W[(size_t)(k0 + kk) * N + n0 + (lane & 31)]; }
    LDS_WAIT(); asm volatile("" ::: "memory");
    const int c = lane & 7;
#pragma unroll
    for (int j = 0; j < 4; ++j) { const int n = (lane >> 3) + 8 * j; const LAS float* s = scr + (8 * c) * 33 + n;
        u32x4 o; o.x = pk2(s[0 * 33], s[1 * 33]); o.y = pk2(s[2 * 33], s[3 * 33]); o.z = pk2(s[4 * 33], s[5 * 33]); o.w = pk2(s[6 * 33], s[7 * 33]);
        *(u32x4*)(WT + (size_t)(n0 + n) * K + k0 + 8 * c) = o; }
    LDS_WAIT(); asm volatile("" ::: "memory");
}
template <bool OUTF> __device__ __forceinline__ void rms_row(const float* xrow, const float* g, void* orow, int lane) {
    const f32x4* xr = (const f32x4*)xrow + lane;
    f32x4 v[16]; float s = 0.f;
#pragma unroll
    for (int j = 0; j < 16; ++j) { v[j] = xr[64 * j]; s += (v[j].x * v[j].x + v[j].y * v[j].y) + (v[j].z * v[j].z + v[j].w * v[j].w); }
    const float rstd = 1.0f / sqrtf(wave_sum(s) * (1.f / D) + RMS_EPS);
    const f32x4* gr = (const f32x4*)g + lane;
#pragma unroll
    for (int j = 0; j < 16; ++j) { const f32x4 y = v[j] * rstd * gr[64 * j];
        if (OUTF) ((f32x4*)orow + lane)[64 * j] = y;
        else { u32x2 w; w.x = pk2(y.x, y.y); w.y = pk2(y.z, y.w); ((u32x2*)orow + lane)[64 * j] = w; } }
}
struct Ctx { int tid, lane, wave, vcu, G; LAS unsigned char* lds; };

__device__ __forceinline__ void phase_rms(const Ctx& c, const float* xp, const float* xs, const float* g, bf16* XN) {
    const int gw = c.vcu * NWAVES + c.wave, NGW = c.G * NWAVES;
    for (int m = gw; m < M; m += NGW) { const float* xr = m < MP ? xp + (size_t)m * D : xs + (size_t)(m - MP) * D; rms_row<false>(xr, g, XN + (size_t)m * D, c.lane); }
}
__device__ __forceinline__ void phase_final(const Ctx& c, const float* X, const float* g, float* out) {
    const int gw = c.vcu * NWAVES + c.wave, NGW = c.G * NWAVES;
    for (int m = gw; m < M; m += NGW) rms_row<true>(X + (size_t)m * D, g, out + O_YP + (size_t)m * D, c.lane);
}
__device__ __forceinline__ void phase_prologue(const Ctx& c, const Args& a) {
    unsigned char* ws = a.ws;
    LAS float* scr = (LAS float*)(c.lds + RING_OFF + c.wave * 16384);
    const int gw = c.vcu * NWAVES + c.wave, NGW = c.G * NWAVES;
    constexpr int I_IN = (D / 64) * (NPROJ / 32), I_OUT = (D / 64) * (D / 32), I_INC = (D / 64) * (NGM / 32), I_UP = (D / 64) * (NUP / 32), I_DN = (DFF / 64) * (D / 32);
    constexpr int NITEMS = I_IN + 2 * I_OUT + I_INC + 2 * I_UP + 2 * I_DN;
    for (int it = gw; it < NITEMS; it += NGW) {
        int r = it;
        if (r < I_IN) { p0_transpose_item(a.w_in_ab, D, NPROJ, (bf16*)(ws + WS_WIN), scr, r, c.lane); continue; } r -= I_IN;
        if (r < I_OUT) { p0_transpose_item(a.w_out_ab, D, D, (bf16*)(ws + WS_WOUT), scr, r, c.lane); continue; } r -= I_OUT;
        if (r < I_UP) { p0_transpose_item(a.w_up, D, NUP, (bf16*)(ws + WS_WUP), scr, r, c.lane); continue; } r -= I_UP;
        if (r < I_DN) { p0_transpose_item(a.w_down, DFF, D, (bf16*)(ws + WS_WDN), scr, r, c.lane); continue; } r -= I_DN;
        if (r < I_INC) { p0_transpose_item(a.w_in_c, D, NGM, (bf16*)(ws + WS_WINC), scr, r, c.lane); continue; } r -= I_INC;
        if (r < I_OUT) { p0_transpose_item(a.w_out_c, D, D, (bf16*)(ws + WS_WOUTC), scr, r, c.lane); continue; } r -= I_OUT;
        if (r < I_UP) { p0_transpose_item(a.w_up + (size_t)D * NUP, D, NUP, (bf16*)(ws + WS_WUP) + (size_t)NUP * D, scr, r, c.lane); continue; } r -= I_UP;
        p0_transpose_item(a.w_down + (size_t)DFF * D, DFF, D, (bf16*)(ws + WS_WDN) + (size_t)D * DFF, scr, r, c.lane);
    }
    phase_rms(c, a.x_p, a.x_s, a.norm_mix, (bf16*)(ws + WS_XN));
}

__device__ __forceinline__ void mix0_conv(const Ctx& c, const Args& a) {
    const bf16* PROJ = (const bf16*)(a.ws + WS_PROJ); bf16* MIX = (bf16*)(a.ws + WS_MIX);
    const int gt = c.vcu * NTHR + c.tid, NT = c.G * NTHR;
    for (int it = gt; it < (M / 16) * 256; it += NT) {
        const int cc = it & 255, rb = it >> 8, r0 = rb * 16, ch = cc * 8;
        const bool smp = r0 >= MP; const int t0 = smp ? ((r0 - MP) & 63) : (r0 & 2047), T = smp ? 64 : 2048, b = smp ? ((r0 - MP) >> 6) : (r0 >> 11);
        float w0[8], w1[8], w2[8], p2[8], p1[8];
        load8f(a.conv_w_a + ch, w0); load8f(a.conv_w_a + CONVD + ch, w1); load8f(a.conv_w_a + 2 * CONVD + ch, w2);
        if (t0 == 0) {
            if (smp) { load8f(a.st_conv + (size_t)(b * 2 + 0) * CONVD + ch, p2); load8f(a.st_conv + (size_t)(b * 2 + 1) * CONVD + ch, p1); }
            else {
#pragma unroll
                for (int e = 0; e < 8; ++e) { p2[e] = 0.f; p1[e] = 0.f; } }
        } else {
            float gc[8], hv[8];
            const bf16* pr = PROJ + (size_t)(r0 - 2) * NPROJ + ch;
            unpack8(*(const u32x4*)(pr + OFF_GC), gc); unpack8(*(const u32x4*)(pr + OFF_HV), hv);
#pragma unroll
            for (int e = 0; e < 8; ++e) p2[e] = gc[e] * hv[e];
            pr += NPROJ;
            unpack8(*(const u32x4*)(pr + OFF_GC), gc); unpack8(*(const u32x4*)(pr + OFF_HV), hv);
#pragma unroll
            for (int e = 0; e < 8; ++e) p1[e] = gc[e] * hv[e];
        }
        float* so = a.out + (smp ? O_CS : O_CP) + (size_t)b * 2 * CONVD + ch;
#pragma unroll 4
        for (int i = 0; i < 16; ++i) {
            const bf16* pr = PROJ + (size_t)(r0 + i) * NPROJ + ch;
            float gb[8], gc[8], hv[8], cur[8], o[8];
            unpack8(*(const u32x4*)(pr + OFF_GB), gb); unpack8(*(const u32x4*)(pr + OFF_GC), gc); unpack8(*(const u32x4*)(pr + OFF_HV), hv);
#pragma unroll
            for (int e = 0; e < 8; ++e) { cur[e] = gc[e] * hv[e]; o[e] = gb[e] * (w0[e] * p2[e] + w1[e] * p1[e] + w2[e] * cur[e]); }
            *(u32x4*)(MIX + (size_t)(r0 + i) * D + ch) = pack8(o);
            const int j = t0 + i - (T - 2);
            if (j >= 0) store8f(so + (size_t)j * CONVD, cur);
#pragma unroll
            for (int e = 0; e < 8; ++e) { p2[e] = p1[e]; p1[e] = cur[e]; }
        }
    }
}
__device__ __forceinline__ void mix0_kvstate(const Ctx& c, const Args& a) {
    const bf16* PROJ = (const bf16*)(a.ws + WS_PROJ);
    const int gt = c.vcu * NTHR + c.tid, NT = c.G * NTHR;
    constexpr int NP = 4 * 128 * 64, NS = 32 * 128 * 64;
    for (int it = gt; it < 2 * (NP + NS); it += NT) {
        const int isv = it >= (NP + NS); int r = isv ? it - (NP + NS) : it;
        const int off = isv ? OFF_V : OFF_K; float f[8]; float* o;
        if (r < NP) { const int e8 = r & 63, j = (r >> 6) & 127, b = r >> 13;
            unpack8(*(const u32x4*)(PROJ + (size_t)(b * 2048 + 1920 + j) * NPROJ + off + e8 * 8), f);
            o = a.out + (isv ? O_VP : O_KP) + (size_t)r * 8;
        } else { r -= NP; const int e8 = r & 63, j = (r >> 6) & 127, b = r >> 13;
            if (j < 64) load8f((isv ? a.cache_v : a.cache_k) + ((size_t)(b * 128 + 64 + j) * 512 + e8 * 8), f);
            else unpack8(*(const u32x4*)(PROJ + (size_t)(MP + b * 64 + (j - 64)) * NPROJ + off + e8 * 8), f);
            o = a.out + (isv ? O_VS : O_KS) + (size_t)r * 8;
        }
        store8f(o, f);
    }
}
constexpr int KS_PITCH = 72, VT_PITCH = 200;
__device__ __forceinline__ void attn_unit(const Ctx& c, const Args& a, int unit) {
    const bf16* PROJ = (const bf16*)(a.ws + WS_PROJ); bf16* MIX = (bf16*)(a.ws + WS_MIX);
    const int tid = c.tid, wid = c.wave, lane = c.lane, l32 = lane & 31, hi = lane >> 5;
    const int ch = unit >> 3, kvh = unit & 7;
    LAS bf16* Ks = (LAS bf16*)(c.lds + RING_OFF); LAS bf16* Vt = (LAS bf16*)(c.lds + RING_OFF + 192 * KS_PITCH * 2);
    const bool smp = ch >= 128; int b, qrow0, jmin;
    if (!smp) { b = ch >> 5; const int cq = ch & 31; qrow0 = b * 2048 + cq * 64; jmin = cq >= 2 ? 0 : (2 - cq) * 64; } else { b = ch - 128; qrow0 = MP + b * 64; jmin = 0; }
#pragma unroll
    for (int i = 0; i < 3; ++i) {
        const int ci = tid + NTHR * i, j = ci >> 3, cc = ci & 7; u32x4 kv, vv;
        if (j < jmin) { kv = (u32x4){0u, 0u, 0u, 0u}; vv = kv; }
        else if (smp && j < 128) { float f[8]; const size_t o = ((size_t)(b * 128 + j) * 8 + kvh) * 64 + cc * 8; load8f(a.cache_k + o, f); kv = pack8(f); load8f(a.cache_v + o, f); vv = pack8(f); }
        else { const int row = smp ? (MP + b * 64 + (j - 128)) : (qrow0 - 128 + j); const bf16* p = PROJ + (size_t)row * NPROJ + kvh * 64 + cc * 8;
            kv = *(const u32x4*)(p + OFF_K); vv = *(const u32x4*)(p + OFF_V); }
        *(LAS u32x4*)(Ks + j * KS_PITCH + cc * 8) = kv;
        LAS bf16* vt = Vt + (cc * 8) * VT_PITCH + j;
        vt[0 * VT_PITCH] = (bf16)(vv.x & 0xffffu); vt[1 * VT_PITCH] = (bf16)(vv.x >> 16); vt[2 * VT_PITCH] = (bf16)(vv.y & 0xffffu); vt[3 * VT_PITCH] = (bf16)(vv.y >> 16);
        vt[4 * VT_PITCH] = (bf16)(vv.z & 0xffffu); vt[5 * VT_PITCH] = (bf16)(vv.z >> 16); vt[6 * VT_PITCH] = (bf16)(vv.w & 0xffffu); vt[7 * VT_PITCH] = (bf16)(vv.w >> 16);
    }
    __syncthreads();
    const int h = kvh * 4 + (wid >> 1), tq = 32 * (wid & 1) + l32;
    bf16x8 qf[4];
    { const bf16* qp = PROJ + (size_t)(qrow0 + tq) * NPROJ + OFF_Q + h * 64 + 8 * hi;
#pragma unroll
      for (int ks = 0; ks < 4; ++ks) { float f[8]; unpack8(*(const u32x4*)(qp + 16 * ks), f);
#pragma unroll
          for (int e = 0; e < 8; ++e) f[e] *= 0.125f;
          qf[ks] = __builtin_bit_cast(bf16x8, pack8(f)); } }
    const float slope = exp2f(-0.25f * (float)(h + 1)), sink = a.sinks[h];
    const float t0 = (float)(tq + 128 - 4 * hi);
    const int kb0 = jmin >> 5;
    float mx = sink;
#pragma unroll
    for (int kb = 0; kb < 6; ++kb) {
        if (kb >= kb0) { f32x16 acc;
#pragma unroll
            for (int r = 0; r < 16; ++r) acc[r] = 0.f;
#pragma unroll
            for (int ks = 0; ks < 4; ++ks) { const bf16x8 kf = *(const LAS bf16x8*)(Ks + (32 * kb + l32) * KS_PITCH + 16 * ks + 8 * hi); acc = MFMA32(kf, qf[ks], acc); }
#pragma unroll
            for (int r = 0; r < 16; ++r) { const float dist = fabsf(t0 - (float)(32 * kb + (r & 3) + 8 * (r >> 2))); mx = fmaxf(mx, acc[r] - slope * dist); }
        }
        __builtin_amdgcn_sched_barrier(0);
    }
    mx = fmaxf(mx, __shfl_xor(mx, 32));
    f32x16 o0, o1; float sum = 0.f;
#pragma unroll
    for (int r = 0; r < 16; ++r) { o0[r] = 0.f; o1[r] = 0.f; }
#pragma unroll
    for (int kb = 0; kb < 6; ++kb) {
        if (kb >= kb0) { f32x16 acc;
#pragma unroll
            for (int r = 0; r < 16; ++r) acc[r] = 0.f;
#pragma unroll
            for (int ks = 0; ks < 4; ++ks) { const bf16x8 kf = *(const LAS bf16x8*)(Ks + (32 * kb + l32) * KS_PITCH + 16 * ks + 8 * hi); acc = MFMA32(kf, qf[ks], acc); }
            float p[16];
#pragma unroll
            for (int r = 0; r < 16; ++r) { const float dist = fabsf(t0 - (float)(32 * kb + (r & 3) + 8 * (r >> 2))); p[r] = __expf(acc[r] - slope * dist - mx); sum += p[r]; }
#pragma unroll
            for (int s = 0; s < 2; ++s) {
                u32x4 pw; pw.x = pk2(p[8 * s + 0], p[8 * s + 1]); pw.y = pk2(p[8 * s + 2], p[8 * s + 3]); pw.z = pk2(p[8 * s + 4], p[8 * s + 5]); pw.w = pk2(p[8 * s + 6], p[8 * s + 7]);
                const LAS bf16* vp = Vt + l32 * VT_PITCH + 32 * kb + 16 * s + 4 * hi;
                const s16x4 a0 = *(const LAS s16x4*)vp, a1 = *(const LAS s16x4*)(vp + 8), b0 = *(const LAS s16x4*)(vp + 32 * VT_PITCH), b1 = *(const LAS s16x4*)(vp + 32 * VT_PITCH + 8);
                o0 = MFMA32(__builtin_shufflevector(a0, a1, 0, 1, 2, 3, 4, 5, 6, 7), __builtin_bit_cast(bf16x8, pw), o0);
                o1 = MFMA32(__builtin_shufflevector(b0, b1, 0, 1, 2, 3, 4, 5, 6, 7), __builtin_bit_cast(bf16x8, pw), o1); }
        }
        __builtin_amdgcn_sched_barrier(0);
    }
    sum += __shfl_xor(sum, 32);
    const float inv = 1.0f / (sum + __expf(sink - mx));
    bf16* op = MIX + (size_t)(qrow0 + tq) * D + CONVD + h * 64 + 4 * hi;
#pragma unroll
    for (int g = 0; g < 4; ++g) { u32x2 w; w.x = pk2(o0[4 * g] * inv, o0[4 * g + 1] * inv); w.y = pk2(o0[4 * g + 2] * inv, o0[4 * g + 3] * inv); *(u32x2*)(op + 8 * g) = w;
        w.x = pk2(o1[4 * g] * inv, o1[4 * g + 1] * inv); w.y = pk2(o1[4 * g + 2] * inv, o1[4 * g + 3] * inv); *(u32x2*)(op + 32 + 8 * g) = w; }
    __syncthreads();
}
__device__ __forceinline__ void phase_mix0(const Ctx& c, const Args& a) {
    for (int u = c.vcu; u < 160 * 8; u += c.G) attn_unit(c, a, u);
    mix0_conv(c, a);
    mix0_kvstate(c, a);
}

__device__ __forceinline__ void phase_ffnconv(const Ctx& c, const Args& a, int layer) {
    const bf16* UP = (const bf16*)(a.ws + WS_UP); bf16* ACT = (bf16*)(a.ws + WS_ACT);
    const float* cw = a.conv_w_ffn + (size_t)layer * 3 * NUP; const float* cb = a.conv_b_ffn + (size_t)layer * NUP;
    const int gt = c.vcu * NTHR + c.tid, NT = c.G * NTHR;
    constexpr int NCH = DFF / 8;
    for (int it = gt; it < (M / 16) * NCH; it += NT) {
        const int cc = it % NCH, rb = it / NCH, r0 = rb * 16, ch = cc * 8;
        const bool smp = r0 >= MP; const int t0 = smp ? ((r0 - MP) & 63) : (r0 & 2047), T = smp ? 64 : 2048, b = smp ? ((r0 - MP) >> 6) : (r0 >> 11);
        float wg0[8], wg1[8], wg2[8], wu0[8], wu1[8], wu2[8], bg[8], bu[8], g2[8], g1[8], u2[8], u1[8];
        load8f(cw + ch, wg0); load8f(cw + NUP + ch, wg1); load8f(cw + 2 * NUP + ch, wg2); load8f(cw + DFF + ch, wu0); load8f(cw + NUP + DFF + ch, wu1); load8f(cw + 2 * NUP + DFF + ch, wu2);
        load8f(cb + ch, bg); load8f(cb + DFF + ch, bu);
        if (t0 == 0) {
            if (smp) { const float* sp = a.st_ffn + ((size_t)(layer * 32 + b) * 2) * NUP + ch; load8f(sp, g2); load8f(sp + DFF, u2); load8f(sp + NUP, g1); load8f(sp + NUP + DFF, u1); }
            else {
#pragma unroll
                for (int e = 0; e < 8; ++e) { g2[e] = 0.f; g1[e] = 0.f; u2[e] = 0.f; u1[e] = 0.f; } }
        } else {
            const bf16* pr = UP + (size_t)(r0 - 2) * NUP + ch;
            unpack8(*(const u32x4*)pr, g2); unpack8(*(const u32x4*)(pr + DFF), u2); pr += NUP; unpack8(*(const u32x4*)pr, g1); unpack8(*(const u32x4*)(pr + DFF), u1);
        }
        float* so = a.out + (smp ? O_FS + (size_t)(layer * 32 + b) * 2 * NUP : O_FP + (size_t)(layer * 4 + b) * 2 * NUP) + ch;
#pragma unroll 2
        for (int i = 0; i < 16; ++i) {
            const bf16* pr = UP + (size_t)(r0 + i) * NUP + ch;
            float g0[8], u0[8], o[8];
            unpack8(*(const u32x4*)pr, g0); unpack8(*(const u32x4*)(pr + DFF), u0);
#pragma unroll
            for (int e = 0; e < 8; ++e) { const float cg = wg0[e] * g2[e] + wg1[e] * g1[e] + wg2[e] * g0[e] + bg[e], cu = wu0[e] * u2[e] + wu1[e] * u1[e] + wu2[e] * u0[e] + bu[e];
                o[e] = cg / (1.0f + __expf(-cg)) * cu; }
            *(u32x4*)(ACT + (size_t)(r0 + i) * DFF + ch) = pack8(o);
            const int j = t0 + i - (T - 2);
            if (j >= 0) { store8f(so + (size_t)j * NUP, g0); store8f(so + (size_t)j * NUP + DFF, u0); }
#pragma unroll
            for (int e = 0; e < 8; ++e) { g2[e] = g1[e]; g1[e] = g0[e]; u2[e] = u1[e]; u1[e] = u0[e]; }
        }
    }
}
__device__ __forceinline__ void phase_ln(const Ctx& c, const Args& a) {
    const bf16* Z = (const bf16*)(a.ws + WS_Z); bf16* VLN = (bf16*)(a.ws + WS_VLN);
    const int gw = c.vcu * NWAVES + c.wave, NGW = c.G * NWAVES, lane = c.lane;
    for (int m = gw; m < M; m += NGW) {
        const bf16* vr = Z + (size_t)m * NGM + D;
        float f[8][8]; float s = 0.f;
#pragma unroll
        for (int j = 0; j < 8; ++j) { unpack8(*(const u32x4*)(vr + (lane + 64 * j) * 8), f[j]);
#pragma unroll
            for (int e = 0; e < 8; ++e) s += f[j][e]; }
        const float mean = wave_sum(s) * (1.f / D); float q = 0.f;
#pragma unroll
        for (int j = 0; j < 8; ++j)
#pragma unroll
            for (int e = 0; e < 8; ++e) { f[j][e] -= mean; q += f[j][e] * f[j][e]; }
        const float rstd = 1.0f / sqrtf(wave_sum(q) * (1.f / D) + LN_EPS);
#pragma unroll
        for (int j = 0; j < 8; ++j) { const int col = (lane + 64 * j) * 8; float g[8], bb[8], y[8]; load8f(a.ln_g + col, g); load8f(a.ln_b + col, bb);
#pragma unroll
            for (int e = 0; e < 8; ++e) y[e] = f[j][e] * rstd * g[e] + bb[e];
            *(u32x4*)(VLN + (size_t)m * D + col) = pack8(y);
            if (m >= MP) store8f(a.out + O_GV + (size_t)(m - MP) * D + col, y); }
    }
}
constexpr int SG_PITCH = 136;
__device__ __forceinline__ void sgu_unit(const Ctx& c, const Args& a, int unit) {
    const bf16* Z = (const bf16*)(a.ws + WS_Z); const bf16* VLN = (const bf16*)(a.ws + WS_VLN); bf16* MIX = (bf16*)(a.ws + WS_MIX);
    const int tid = c.tid, wid = c.wave, lane = c.lane, l32 = lane & 31, hi = lane >> 5;
    int g, r0, nt;
    if (unit < 1024) { g = unit & 15; r0 = (unit >> 4) * 128; nt = 4; } else { const int u2 = unit - 1024; g = u2 & 15; r0 = MP + (u2 >> 4) * 64; nt = 2; }
    LAS bf16* VT = (LAS bf16*)(c.lds + RING_OFF);
    for (int i = 0; i < 2 * nt; ++i) { const int ci = tid + NTHR * i, s = ci >> 5, cc = ci & 31;
        const u32x4 v = *(const u32x4*)(VLN + (size_t)(r0 + s) * D + g * 256 + cc * 8);
        LAS bf16* vt = VT + (cc * 8) * SG_PITCH + s;
        vt[0 * SG_PITCH] = (bf16)(v.x & 0xffffu); vt[1 * SG_PITCH] = (bf16)(v.x >> 16); vt[2 * SG_PITCH] = (bf16)(v.y & 0xffffu); vt[3 * SG_PITCH] = (bf16)(v.y >> 16);
        vt[4 * SG_PITCH] = (bf16)(v.z & 0xffffu); vt[5 * SG_PITCH] = (bf16)(v.z >> 16); vt[6 * SG_PITCH] = (bf16)(v.w & 0xffffu); vt[7 * SG_PITCH] = (bf16)(v.w >> 16); }
    __syncthreads();
    f32x16 acc[4];
#pragma unroll
    for (int tb = 0; tb < 4; ++tb)
#pragma unroll
        for (int r = 0; r < 16; ++r) acc[tb][r] = 0.f;
    const float* wsg = a.w_s + (size_t)g * 128 * 128;
#pragma unroll
    for (int ks = 0; ks < 8; ++ks) {
        if (ks < 2 * nt) {
            const bf16x8 bfr = *(const LAS bf16x8*)(VT + (32 * wid + l32) * SG_PITCH + 16 * ks + 8 * hi);
#pragma unroll
            for (int tb = 0; tb < 4; ++tb) {
                if (tb >= (ks >> 1) && tb < nt) {
                    const int t = 32 * tb + l32, s0 = 16 * ks + 8 * hi; float w[8]; load8f(wsg + (size_t)t * 128 + s0, w);
#pragma unroll
                    for (int e = 0; e < 8; ++e) w[e] = (s0 + e <= t) ? w[e] : 0.f;
                    acc[tb] = MFMA32(__builtin_bit_cast(bf16x8, pack8(w)), bfr, acc[tb]);
                }
            }
        }
    }
    const int col = g * 256 + 32 * wid + l32;
#pragma unroll
    for (int tb = 0; tb < 4; ++tb) {
        if (tb < nt) {
#pragma unroll
            for (int r = 0; r < 16; ++r) { const int t = 32 * tb + crow(r, hi); const size_t row = (size_t)(r0 + t);
                const float u = __uint_as_float((unsigned)Z[row * NGM + col] << 16);
                const float val = (acc[tb][r] + a.b_s[g * 128 + t]) * u;
                MIX[row * D + col] = (bf16)(pk2(val, 0.f) & 0xffffu); }
        }
    }
    __syncthreads();
}
__global__ void __launch_bounds__(NTHR, 2) mk_fwd(Args a) {
    extern __shared__ __attribute__((aligned(16))) unsigned char lds[];
    Ctx c; c.lds = (LAS unsigned char*)lds; c.tid = threadIdx.x; c.lane = c.tid & 63; c.wave = __builtin_amdgcn_readfirstlane(c.tid >> 6);
    c.G = gridDim.x; { const int bx = blockIdx.x; c.vcu = (c.G % 8 == 0) ? (bx % 8) * (c.G / 8) + bx / 8 : bx; }
    volatile LAS unsigned* MISC = (volatile LAS unsigned*)(c.lds + MISC_OFF);
    for (int u = c.tid; u < (LDS_BYTES - LDSCTL_OFF) / 4; u += NTHR) ((LAS unsigned*)(c.lds + LDSCTL_OFF))[u] = 0u;
    __syncthreads();
    unsigned char* ws = a.ws;
    unsigned* ctl = (unsigned*)(ws + WS_CTL);
    XcdBarrier bar; bar.bar = ctl + CW_BAR; bar.x = 0; bar.st = nullptr;
    if (N_LAUNCHES == 1) bar = xcd_barrier_post(ctl + CW_BAR, MISC + 8);
#define GRID_BAR() do { if (N_LAUNCHES == 1) xcd_barrier(bar); } while (0)
    const int lo = a.ph_lo, hi = a.ph_hi;
#define IN(k) (lo <= (k) && (k) < hi)
#define BOTH(k) (IN(k) && IN((k) + 1))
    bf16* XN = (bf16*)(ws + WS_XN); bf16* PROJ = (bf16*)(ws + WS_PROJ); bf16* MIX = (bf16*)(ws + WS_MIX); float* X = (float*)(ws + WS_X);
    bf16* UP = (bf16*)(ws + WS_UP); bf16* ACT = (bf16*)(ws + WS_ACT); bf16* Z = (bf16*)(ws + WS_Z);
    LAS unsigned char* ring = c.lds + RING_OFF;
    const int bx = (int)blockIdx.x;

    if (IN(0)) { phase_prologue(c, a); if (BOTH(0)) GRID_BAR(); }
    if (IN(1)) {
        pg8::Gemm g{XN, (const bf16*)(ws + WS_WIN), M, NPROJ, D}; pg8::StaticOrder S; S.init(M, NPROJ, c.G, bx); pg8::EpiBf16<0> E{PROJ, NPROJ};
        pg8::gemm_phase<pg8::EpiBf16<0>, pg8::StaticOrder, true, true>(ring, g, S, E);
        if (BOTH(1)) GRID_BAR(); }
    if (IN(2)) { phase_mix0(c, a); if (BOTH(2)) GRID_BAR(); }
    if (IN(3)) {
        pg8::Gemm g{MIX, (const bf16*)(ws + WS_WOUT), M, D, D}; pg8::StaticOrder S; S.init(M, D, c.G, bx); pg8::EpiRes E{a.x_p, a.x_s, X, D, MP};
        pg8::gemm_phase<pg8::EpiRes, pg8::StaticOrder, true, true>(ring, g, S, E);
        if (BOTH(3)) GRID_BAR(); }
    if (IN(4)) { phase_rms(c, X, X + (size_t)MP * D, a.norm_ffn, XN); if (BOTH(4)) GRID_BAR(); }
    if (IN(5)) {
        pg8::Gemm g{XN, (const bf16*)(ws + WS_WUP), M, NUP, D}; pg8::StaticOrder S; S.init(M, NUP, c.G, bx); pg8::EpiBf16<0> E{UP, NUP};
        pg8::gemm_phase<pg8::EpiBf16<0>, pg8::StaticOrder, true, true>(ring, g, S, E);
        if (BOTH(5)) GRID_BAR(); }
    if (IN(6)) { phase_ffnconv(c, a, 0); if (BOTH(6)) GRID_BAR(); }
    if (IN(7)) {
        pg8::Gemm g{ACT, (const bf16*)(ws + WS_WDN), M, D, DFF}; pg8::StaticOrder S; S.init(M, D, c.G, bx); pg8::EpiRes E{X, X + (size_t)MP * D, X, D, MP};
        pg8::gemm_phase<pg8::EpiRes, pg8::StaticOrder, true, true>(ring, g, S, E);
        if (BOTH(7)) GRID_BAR(); }
    if (IN(8)) { phase_rms(c, X, X + (size_t)MP * D, a.norm_mix + D, XN); if (BOTH(8)) GRID_BAR(); }
    if (IN(9)) {
        pg8::Gemm g{XN, (const bf16*)(ws + WS_WINC), M, NGM, D}; pg8::StaticOrder S; S.init(M, NGM, c.G, bx); pg8::EpiBf16<1> E{Z, NGM};
        pg8::gemm_phase<pg8::EpiBf16<1>, pg8::StaticOrder, true, true>(ring, g, S, E);
        if (BOTH(9)) GRID_BAR(); }
    if (IN(10)) { phase_ln(c, a); if (BOTH(10)) GRID_BAR(); }
    if (IN(11)) { for (int u = c.vcu; u < 1024 + 512; u += c.G) sgu_unit(c, a, u); if (BOTH(11)) GRID_BAR(); }
    if (IN(12)) {
        pg8::Gemm g{MIX, (const bf16*)(ws + WS_WOUTC), M, D, D}; pg8::StaticOrder S; S.init(M, D, c.G, bx); pg8::EpiRes E{X, X + (size_t)MP * D, X, D, MP};
        pg8::gemm_phase<pg8::EpiRes, pg8::StaticOrder, true, true>(ring, g, S, E);
        if (BOTH(12)) GRID_BAR(); }
    if (IN(13)) { phase_rms(c, X, X + (size_t)MP * D, a.norm_ffn + D, XN); if (BOTH(13)) GRID_BAR(); }
    if (IN(14)) {
        pg8::Gemm g{XN, (const bf16*)(ws + WS_WUP) + (size_t)NUP * D, M, NUP, D}; pg8::StaticOrder S; S.init(M, NUP, c.G, bx); pg8::EpiBf16<0> E{UP, NUP};
        pg8::gemm_phase<pg8::EpiBf16<0>, pg8::StaticOrder, true, true>(ring, g, S, E);
        if (BOTH(14)) GRID_BAR(); }
    if (IN(15)) { phase_ffnconv(c, a, 1); if (BOTH(15)) GRID_BAR(); }
    if (IN(16)) {
        pg8::Gemm g{ACT, (const bf16*)(ws + WS_WDN) + (size_t)D * DFF, M, D, DFF}; pg8::StaticOrder S; S.init(M, D, c.G, bx); pg8::EpiRes E{X, X + (size_t)MP * D, X, D, MP};
        pg8::gemm_phase<pg8::EpiRes, pg8::StaticOrder, true, true>(ring, g, S, E);
        if (BOTH(16)) GRID_BAR(); }
    if (IN(17)) { phase_final(c, X, a.norm_final, a.out); }
#undef IN
#undef BOTH
}

extern "C" void kernel_launch(void* const* d_in, const int* in_sizes, int n_in, void* d_out, int out_size, void* d_ws, size_t ws_size, hipStream_t stream) {
    static int grid = 0;
    if (grid == 0) {
        if (n_in != 23 || in_sizes[0] != MP * D || (size_t)out_size != O_END || ws_size < WS_END) {
            fprintf(stderr, "kernel_launch: shape mismatch: n_in %d in0 %d out %d (want %zu) ws %zu (want %zu); nothing launched\n", n_in, n_in > 0 ? in_sizes[0] : -1, out_size, (size_t)O_END, ws_size, (size_t)WS_END); grid = -1; return; }
        int dev = 0, cus = 0, per_cu = 0;
        if (hipGetDevice(&dev) != hipSuccess || hipDeviceGetAttribute(&cus, hipDeviceAttributeMultiprocessorCount, dev) != hipSuccess) { grid = -1; return; }
        if (hipFuncSetAttribute((const void*)mk_fwd, hipFuncAttributeMaxDynamicSharedMemorySize, LDS_BYTES) != hipSuccess) { fprintf(stderr, "kernel_launch: hipFuncSetAttribute failed\n"); grid = -1; return; }
        if (hipOccupancyMaxActiveBlocksPerMultiprocessor(&per_cu, (const void*)mk_fwd, NTHR, LDS_BYTES) != hipSuccess || per_cu < 1) fprintf(stderr, "kernel_launch: occupancy query reports %d blocks per CU\n", per_cu);
        (void)hipGetLastError();
        grid = cus;
    }
    if (grid < 0) return;
    if (hipMemsetAsync((char*)d_ws + WS_CTL, 0, CTL_ZERO_BYTES, stream) != hipSuccess) { fprintf(stderr, "kernel_launch: memset failed\n"); return; }
    Args a{};
    const float* const* in = (const float* const*)d_in;
    a.x_p = in[0]; a.x_s = in[1]; a.st_conv = in[2]; a.cache_k = in[3]; a.cache_v = in[4]; a.st_ffn = in[5]; a.norm_mix = in[6]; a.norm_ffn = in[7]; a.norm_final = in[8]; a.w_in_ab = in[9];
    a.conv_w_a = in[10]; a.sinks = in[11]; a.w_out_ab = in[12]; a.w_in_c = in[13]; a.ln_g = in[14]; a.ln_b = in[15]; a.w_s = in[16]; a.b_s = in[17]; a.w_out_c = in[18]; a.w_up = in[19];
    a.conv_w_ffn = in[20]; a.conv_b_ffn = in[21]; a.w_down = in[22];
    a.out = (float*)d_out; a.ws = (unsigned char*)d_ws;
    for (int li = 0; li < N_LAUNCHES; ++li) {
        a.ph_lo = (N_LAUNCHES == 1) ? 0 : li; a.ph_hi = (N_LAUNCHES == 1) ? N_PHASES : li + 1;
        hipLaunchKernelGGL(mk_fwd, dim3(grid), dim3(NTHR), LDS_BYTES, stream, a);
        const hipError_t le = hipPeekAtLastError();
        if (le != hipSuccess) { fprintf(stderr, "kernel_launch: launch %d failed: %s\n", li, hipGetErrorName(le)); break; }
    }
}
```

```cpp
#include <hip/hip_runtime.h>
#include <cstdio>
#include <cstdint>
namespace pg8 {
#define PG8_LAS __attribute__((address_space(3)))
typedef unsigned short bf16_t;
typedef short bf16x8 __attribute__((ext_vector_type(8)));
typedef float f32x4 __attribute__((ext_vector_type(4)));
typedef unsigned u32x4 __attribute__((ext_vector_type(4)));
typedef unsigned u32x2 __attribute__((ext_vector_type(2)));
constexpr int BM = 256, BK = 64, HALF = 128, HTB = HALF * BK * 2  , STAGE_BYTES = 8 * HTB, NXCD = 8, WGM = 8;

__host__ __device__ __forceinline__ int lds_byte(int r, int c) { const int st = (r >> 4) * 2 + (c >> 5), rr = r & 15, cc = c & 31, ob = rr * 64 + cc * 2; return st * 1024 + (ob ^ (((ob >> 9) & 1) << 5)); }
__host__ __device__ __forceinline__ void stage_rc(int b, int& R, int& C) { const int st = b / 1024, sb = b % 1024, swz = sb ^ (((sb >> 9) & 1) << 5); R = (st >> 1) * 16 + swz / 64; C = (st & 1) * 32 + (swz % 64) / 2; }
__host__ __device__ __forceinline__ int perm32(int rho) { const int n = rho >> 4, i = rho & 15; return 8 * (i >> 2) + 4 * n + (i & 3); }

struct Unit { int pm, pn, k0, nt, role, par; };
struct Gemm { const bf16_t* A; const bf16_t* Bt; int M, N, K; };

struct SkOrder {
    int nM, nN, T, q, R, nDP, rem, xcd, rank, c; bool sk;
    __device__ __forceinline__ void init(int M, int N, int K, int G, int c_, bool gs = false, int Ra = 0) { gsync = gs; nM = M / BM; nN = N / BM; T = K / BK; q = (nM * nN) / NXCD; R = Ra > 0 ? Ra : G / NXCD; c = c_; xcd = c_ % NXCD; rank = c_ / NXCD;
        nDP = q / R; rem = q - nDP * R; sk = rem > 0 && 2 * rem <= R && (T % 4) == 0; }
    bool bst = false;
    bool gsync;
    __device__ __forceinline__ void unit_of(int id, Unit& u) const {
        if (gsync) { const int x = id / q, j = id - x * q, gi = j / nN, ig = x * nN + (j - gi * nN); u.pm = gi * WGM + (ig & (WGM - 1)); u.pn = ig / WGM; }
        else if (bst) {
            const int bs = 4 * nM, blk = id / bs, r = id - blk * bs, nb = (nN - 4 * blk) < 4 ? (nN - 4 * blk) : 4, gsz8 = 8 * nb, g = r / gsz8, rr = r - g * gsz8; u.pm = 8 * g + (rr & 7); u.pn = 4 * blk + (rr >> 3); }
        else { const int nig = WGM * nN, gid = id / nig, fm = gid * WGM, gsz = (nM - fm) < WGM ? (nM - fm) : WGM; u.pm = fm + ((id % nig) % gsz); u.pn = (id % nig) / gsz; } }
    __device__ __forceinline__ bool next(int i, Unit& u) const {
        if (rank >= R) return false;
        if (i < nDP) { unit_of(xcd * q + i * R + rank, u); u.k0 = 0; u.nt = T; u.role = 0; return true; }
        if (i > nDP) return false;
        if (sk) { if (rank >= 2 * rem) return false; unit_of(xcd * q + nDP * R + (rank >> 1), u); u.nt = T / 2; u.k0 = (rank & 1) * (T / 2); u.role = (rank & 1) ? 1 : 2; return true; }
        if (rank >= rem) return false;
        unit_of(xcd * q + nDP * R + rank, u); u.k0 = 0; u.nt = T; u.role = 0; return true;
    }
};
struct SkShare { float* slab; unsigned* flags; unsigned* tmo; };

__device__ __forceinline__ unsigned cvt_pk_bf16(float lo, float hi) { unsigned r; asm volatile("v_cvt_pk_bf16_f32 %0, %1, %2" : "=v"(r) : "v"(lo), "v"(hi)); return r; }
typedef float f32x2 __attribute__((ext_vector_type(2)));
__device__ __forceinline__ f32x2 gelu_pk(f32x2 v) {
    const f32x2 av = __builtin_elementwise_abs(v), d = av * 0.2316418882f + 1.0f;
    f32x2 t; t.x = __builtin_amdgcn_rcpf(d.x); t.y = __builtin_amdgcn_rcpf(d.y);
    f32x2 q = t * 0.5307027145f + (-0.7265760135f); q = q * t + 0.7107068705f; q = q * t + (-0.142248368f); q = q * t + 0.127414796f; q = q * t;
    const f32x2 s = (v * v) * (-0.72134752044f);
    f32x2 e; e.x = __builtin_amdgcn_exp2f(s.x); e.y = __builtin_amdgcn_exp2f(s.y);
    const f32x2 m = v * (q * e), r = v - m;
    f32x2 o; o.x = v.x < 0.f ? m.x : r.x; o.y = v.y < 0.f ? m.y : r.y; return o;
}

template <int ACT, bool RSTD, bool LNS> struct EpiBf16 {
    static constexpr bool PERM = true, AFTER_DRAIN = false, ONE_FINISH = false;
    bf16_t* O; int ldc; const float* rs; PG8_LAS float* tab; f32x2* ls; int lns_pn0;
    __device__ __forceinline__ void prep(const Unit& u, int tid) const {
        if constexpr (RSTD) {
            const int t_ = (int)threadIdx.x, row = t_ >> 1, h = t_ & 1; const f32x4* p = (const f32x4*)(rs + ((size_t)(u.pm * BM + row)) * 128 + h * 64);
            f32x4 s4 = p[0];
#pragma unroll
            for (int j = 1; j < 16; ++j) s4 += p[j];
            float s = (s4.x + s4.y) + (s4.z + s4.w); s += __shfl_xor(s, 1);
            if (h == 0) tab[u.par * BM + row] = 1.0f / sqrtf(s * (1.0f / 4096.0f) + 1e-6f);
        }
    }
    template <int MASK = 3> __device__ __forceinline__ void run(const f32x4 (&acc)[2][2][4][2], const Unit& u, int wr, int wc, int fr, int fq) const {
        const int row0 = u.pm * BM + wr * 64 + fr; const int col0 = u.pn * BM + wc * 32 + 8 * fq;
#pragma unroll
        for (int ai = 0; ai < 2; ++ai)
#pragma unroll
            for (int m = 0; m < 4; ++m) { const int row = row0 + ai * HALF + m * 16; bf16_t* rowp = O + (size_t)row * ldc + col0;
                float sc = 1.0f; if constexpr (RSTD) sc = tab[u.par * BM + wr * 64 + fr + ai * HALF + m * 16];
#pragma unroll
                for (int bj = 0; bj < 2; ++bj) { if (!((MASK >> bj) & 1)) continue; f32x4 v0 = acc[ai][bj][m][0] * sc, v1 = acc[ai][bj][m][1] * sc;
                    if (ACT == 1) { f32x2 a = gelu_pk((f32x2){v0[0], v0[1]}), b = gelu_pk((f32x2){v0[2], v0[3]}), c = gelu_pk((f32x2){v1[0], v1[1]}), d = gelu_pk((f32x2){v1[2], v1[3]});
                        v0 = (f32x4){a.x, a.y, b.x, b.y}; v1 = (f32x4){c.x, c.y, d.x, d.y}; }
                    u32x4 w; w.x = cvt_pk_bf16(v0[0], v0[1]); w.y = cvt_pk_bf16(v0[2], v0[3]); w.z = cvt_pk_bf16(v1[0], v1[1]); w.w = cvt_pk_bf16(v1[2], v1[3]);
                    *(u32x4*)(rowp + bj * HALF) = w;
                    if constexpr (LNS) { if (u.pn >= lns_pn0) {
                        float s1 = ((v0[0] + v0[1]) + (v0[2] + v0[3])) + ((v1[0] + v1[1]) + (v1[2] + v1[3]));
                        float s2 = ((v0[0] * v0[0] + v0[1] * v0[1]) + (v0[2] * v0[2] + v0[3] * v0[3])) + ((v1[0] * v1[0] + v1[1] * v1[1]) + (v1[2] * v1[2] + v1[3] * v1[3]));
                        s1 += __shfl_xor(s1, 16); s2 += __shfl_xor(s2, 16); s1 += __shfl_xor(s1, 32); s2 += __shfl_xor(s2, 32);
                        if (fq == 0) ls[(size_t)row * 128 + (u.pn - lns_pn0) * 8 + wc * 2 + bj] = (f32x2){s1, s2}; } }
                } }
    }
};
template <bool BASEF32, bool STATS> struct EpiRes {
    static constexpr bool PERM = true, AFTER_DRAIN = false, ONE_FINISH = false;
    const float* bp; const float* bs; bf16_t* xn; float* rs; int ld; int split;
    __device__ __forceinline__ void prep(const Unit&, int) const {}
    template <int MASK = 3> __device__ __forceinline__ void run(const f32x4 (&acc)[2][2][4][2], const Unit& u, int wr, int wc, int fr, int fq) const {
        const int row0 = u.pm * BM + wr * 64 + fr, col0 = u.pn * BM + wc * 32 + 8 * fq;
#pragma unroll
        for (int ai = 0; ai < 2; ++ai) {
            f32x4 b[4][2][2];
#pragma unroll
            for (int m = 0; m < 4; ++m) { const int row = row0 + ai * HALF + m * 16;
#pragma unroll
                for (int bj = 0; bj < 2; ++bj) { if (!((MASK >> bj) & 1)) continue;
                    if constexpr (BASEF32) { const float* br = (row < split ? bp + (size_t)row * ld : bs + (size_t)(row - split) * ld) + col0 + bj * HALF; b[m][bj][0] = *(const f32x4*)br; b[m][bj][1] = *(const f32x4*)(br + 4); }
                    else { const u32x4 w = *(const u32x4*)(xn + (size_t)row * ld + col0 + bj * HALF);
                        b[m][bj][0] = (f32x4){__uint_as_float(w.x << 16), __uint_as_float(w.x & 0xffff0000u), __uint_as_float(w.y << 16), __uint_as_float(w.y & 0xffff0000u)};
                        b[m][bj][1] = (f32x4){__uint_as_float(w.z << 16), __uint_as_float(w.z & 0xffff0000u), __uint_as_float(w.w << 16), __uint_as_float(w.w & 0xffff0000u)}; } } }
            asm volatile("" ::: "memory");
#pragma unroll
            for (int m = 0; m < 4; ++m) { const int row = row0 + ai * HALF + m * 16;
#pragma unroll
                for (int bj = 0; bj < 2; ++bj) { if (!((MASK >> bj) & 1)) continue;
                    const f32x4 o0 = b[m][bj][0] + acc[ai][bj][m][0], o1 = b[m][bj][1] + acc[ai][bj][m][1];
                    u32x4 w; w.x = cvt_pk_bf16(o0[0], o0[1]); w.y = cvt_pk_bf16(o0[2], o0[3]); w.z = cvt_pk_bf16(o1[0], o1[1]); w.w = cvt_pk_bf16(o1[2], o1[3]);
                    *(u32x4*)(xn + (size_t)row * ld + col0 + bj * HALF) = w;
                    if constexpr (STATS) {
                        float ss = ((o0[0] * o0[0] + o0[1] * o0[1]) + (o0[2] * o0[2] + o0[3] * o0[3])) + ((o1[0] * o1[0] + o1[1] * o1[1]) + (o1[2] * o1[2] + o1[3] * o1[3]));
                        ss += __shfl_xor(ss, 16); ss += __shfl_xor(ss, 32);
                        if (fq == 0) rs[(size_t)row * 128 + u.pn * 8 + wc * 2 + bj] = ss; }
                } }
            asm volatile("" ::: "memory");
        }
    }
};

struct EpiConvGate {
    static constexpr bool PERM = true, AFTER_DRAIN = false, ONE_FINISH = true;
    bf16_t* act; const float* rs; PG8_LAS float* tab; PG8_LAS bf16_t* bnd; const float* cw; const float* cb; const float* st; float* side; float* out_p; float* out_s;
    static constexpr int NUPC = 22016, DFFC = 11008, MPT = 32;
    __device__ __forceinline__ void prep(const Unit& u, int tid) const {
        const int t_ = (int)threadIdx.x, row = t_ >> 1, h = t_ & 1; const f32x4* p = (const f32x4*)(rs + ((size_t)(u.pm * BM + row)) * 128 + h * 64);
        f32x4 s4 = p[0];
#pragma unroll
        for (int j = 1; j < 16; ++j) s4 += p[j];
        float s = (s4.x + s4.y) + (s4.z + s4.w); s += __shfl_xor(s, 1);
        if (h == 0) tab[u.par * BM + row] = 1.0f / sqrtf(s * (1.0f / 4096.0f) + 1e-6f);
    }
    static __device__ __forceinline__ float dpp_shr1(float old, float v) { return __builtin_bit_cast(float, __builtin_amdgcn_update_dpp(__builtin_bit_cast(int, old), __builtin_bit_cast(int, v), 0x111, 0xf, 0xf, false)); }
    static __device__ __forceinline__ float dpp_shr2(float old, float v) { return __builtin_bit_cast(float, __builtin_amdgcn_update_dpp(__builtin_bit_cast(int, old), __builtin_bit_cast(int, v), 0x112, 0xf, 0xf, false)); }
    static __device__ __forceinline__ float dpp_ror1(float v) { return __builtin_bit_cast(float, __builtin_amdgcn_update_dpp(0, __builtin_bit_cast(int, v), 0x121, 0xf, 0xf, false)); }
    static __device__ __forceinline__ float dpp_ror2(float v) { return __builtin_bit_cast(float, __builtin_amdgcn_update_dpp(0, __builtin_bit_cast(int, v), 0x122, 0xf, 0xf, false)); }
    static __device__ __forceinline__ f32x4 bf4(unsigned lo, unsigned hi) { return (f32x4){__uint_as_float(lo << 16), __uint_as_float(lo & 0xffff0000u), __uint_as_float(hi << 16), __uint_as_float(hi & 0xffff0000u)}; }
    template <class T> static __device__ __forceinline__ T* at(const void* base, unsigned off) { return (T*)((const char*)base + off); }
    static __device__ __forceinline__ void taps(const f32x4& cv, const f32x4& f1, const f32x4& f2, f32x4& p1, f32x4& p2) {
#pragma unroll
        for (int e = 0; e < 4; ++e) { p1[e] = dpp_shr1(f1[e], cv[e]); p2[e] = dpp_shr2(f2[e], cv[e]); } }
    template <int AH> __device__ __forceinline__ void half_pass(const f32x4 (&acc)[2][2][4][2], const Unit& u, int wr, int fr, int lcol8, int lch, bool smp, bool seq0, int bj) const {
        const unsigned o_act = (unsigned)(fr * DFFC + lch) * 2u, o_w = (unsigned)lch * 4u;
        const unsigned o_row = (unsigned)((fr < 2 ? fr : fr - 12) * NUPC + lch) * 4u;
        const unsigned o_st = (unsigned)((fr - 14) * NUPC + lch) * 4u;
        const int cg = u.pn * 128 + 64 * bj, cu = cg + DFFC;
        const f32x4 wg0 = *at<const f32x4>(cw + cg, o_w), wg1 = *at<const f32x4>(cw + NUPC + cg, o_w), wg2 = *at<const f32x4>(cw + 2 * NUPC + cg, o_w), bg = *at<const f32x4>(cb + cg, o_w);
        const f32x4 wu0 = *at<const f32x4>(cw + cu, o_w), wu1 = *at<const f32x4>(cw + NUPC + cu, o_w), wu2 = *at<const f32x4>(cw + 2 * NUPC + cu, o_w), bu = *at<const f32x4>(cb + cu, o_w);
#pragma unroll
        for (int ai = 0; ai < 2; ++ai) { f32x4 pvg = (f32x4){0.f, 0.f, 0.f, 0.f}, pvu = pvg;
#pragma unroll
            for (int m = 0; m < 4; ++m) { const int rtu = ai * HALF + wr * 64 + m * 16, g16 = ai * 8 + wr * 4 + m;
                const float sc = tab[u.par * BM + rtu + fr];
                const bool deferred = !smp && !seq0 && g16 == 0 && fr < 2;
                const f32x4 vg_raw = acc[ai][AH][m][0] * sc, vu_raw = acc[ai][AH][m][1] * sc;
                f32x4 f1g, f2g, f1u, f2u;
                if (m == 0) { f32x4 q14g, q15g, q14u, q15u;
                    if (smp || g16 == 0) {
                        if (smp) { const float* sp = st + ((size_t)(((u.pm - MPT) * 4 + (g16 >> 2)) * 2)) * NUPC; q14g = *at<const f32x4>(sp + cg, o_w); q15g = *at<const f32x4>(sp + NUPC + cg, o_w); q14u = *at<const f32x4>(sp + cu, o_w); q15u = *at<const f32x4>(sp + NUPC + cu, o_w); }
                        else { q14g = (f32x4){0.f, 0.f, 0.f, 0.f}; q15g = q14g; q14u = q14g; q15u = q14g; }
                    } else { typedef unsigned u32x4a __attribute__((ext_vector_type(4), may_alias));
                        const PG8_LAS bf16_t* bp = bnd + (((g16 - 1) * 2) * 2 + bj) * 128 + lcol8;
                        const u32x4a a14 = *(const PG8_LAS u32x4a*)(bp), a15 = *(const PG8_LAS u32x4a*)(bp + 256);
                        q14g = bf4(a14.x, a14.y); q14u = bf4(a14.z, a14.w); q15g = bf4(a15.x, a15.y); q15u = bf4(a15.z, a15.w); }
                    f1g = q15g; f1u = q15u;
#pragma unroll
                    for (int e = 0; e < 4; ++e) { f2g[e] = fr == 0 ? q14g[e] : q15g[e]; f2u[e] = fr == 0 ? q14u[e] : q15u[e]; }
                } else {
#pragma unroll
                    for (int e = 0; e < 4; ++e) { f1g[e] = dpp_ror1(pvg[e]); f2g[e] = dpp_ror2(pvg[e]); f1u[e] = dpp_ror1(pvu[e]); f2u[e] = dpp_ror2(pvu[e]); } }
                f32x4 p1, p2; taps(vg_raw, f1g, f2g, p1, p2);
                const f32x4 vg = wg0 * p2 + wg1 * p1 + wg2 * vg_raw + bg;
                taps(vu_raw, f1u, f2u, p1, p2);
                const f32x4 vu = wu0 * p2 + wu1 * p1 + wu2 * vu_raw + bu;
                if (!deferred) { f32x4 o;
#pragma unroll
                    for (int e = 0; e < 4; ++e) o[e] = vg[e] * __builtin_amdgcn_rcpf(1.0f + __expf(-vg[e])) * vu[e];
                    f32x2 w; w.x = __builtin_bit_cast(float, cvt_pk_bf16(o[0], o[1])); w.y = __builtin_bit_cast(float, cvt_pk_bf16(o[2], o[3]));
                    *at<f32x2>(act + ((size_t)(u.pm * BM + rtu)) * DFFC + cg, o_act) = w; }
                if (!smp) {
                    if ((g16 == 0 && fr < 2) || (g16 == 15 && fr >= 14)) { float* sp = side + ((size_t)(u.pm * 4)) * NUPC; *at<f32x4>(sp + cg, o_row) = vg_raw; *at<f32x4>(sp + cu, o_row) = vu_raw; }
                    if (g16 == 15 && fr >= 14 && (u.pm & 7) == 7) { float* op = out_p + ((size_t)((u.pm >> 3) * 2)) * NUPC; *at<f32x4>(op + cg, o_st) = vg_raw; *at<f32x4>(op + cu, o_st) = vu_raw; }
                } else if (m == 3 && fr >= 14) { float* op = out_s + ((size_t)(((u.pm - MPT) * 4 + (g16 >> 2)) * 2)) * NUPC; *at<f32x4>(op + cg, o_st) = vg_raw; *at<f32x4>(op + cu, o_st) = vu_raw; }
                pvg = vg_raw; pvu = vu_raw;
                asm volatile("" ::: "memory");
            }
        }
    }
    template <int AH> __device__ __forceinline__ void image(const f32x4 (&acc)[2][2][4][2], const Unit& u, int wr, int fr, int lcol8, int bj) const {
#pragma unroll
        for (int ai = 0; ai < 2; ++ai) { constexpr int m = 3; const float sc = tab[u.par * BM + ai * HALF + wr * 64 + m * 16 + fr]; const int g16 = ai * 8 + wr * 4 + m;
            if (fr >= 14) { const f32x4 v0 = acc[ai][AH][m][0] * sc, v1 = acc[ai][AH][m][1] * sc;
                u32x4 w; w.x = cvt_pk_bf16(v0[0], v0[1]); w.y = cvt_pk_bf16(v0[2], v0[3]); w.z = cvt_pk_bf16(v1[0], v1[1]); w.w = cvt_pk_bf16(v1[2], v1[3]);
                typedef unsigned u32x4a __attribute__((ext_vector_type(4), may_alias)); *(PG8_LAS u32x4a*)(bnd + ((g16 * 2 + (fr - 14)) * 2 + bj) * 128 + lcol8) = w; } }
    }
    template <int MASK = 3> __device__ __forceinline__ void run(const f32x4 (&acc)[2][2][4][2], const Unit& u, int wr, int wc, int fr_, int fq_) const {
        int fr = fr_, fq = fq_; asm volatile("" : "+v"(fr), "+v"(fq));
        const int lcol8 = wc * 32 + 8 * fq, lch = wc * 16 + 4 * fq;
        const bool smp = u.pm >= MPT, seq0 = !smp && (u.pm & 7) == 0;
        image<0>(acc, u, wr, fr, lcol8, 0); image<1>(acc, u, wr, fr, lcol8, 1);
        asm volatile("s_waitcnt lgkmcnt(0)" ::: "memory"); __builtin_amdgcn_s_barrier(); asm volatile("" ::: "memory");
        half_pass<0>(acc, u, wr, fr, lcol8, lch, smp, seq0, 0);
        half_pass<1>(acc, u, wr, fr, lcol8, lch, smp, seq0, 1);
    }
    __device__ __forceinline__ void run_half(const f32x4 (&acc)[2][2][4][2], const Unit& u, int wr, int wc, int fr_, int fq_, int bj) const {
        int fr = fr_, fq = fq_; asm volatile("" : "+v"(fr), "+v"(fq));
        const int lcol8 = wc * 32 + 8 * fq, lch = wc * 16 + 4 * fq;
        const bool smp = u.pm >= MPT, seq0 = !smp && (u.pm & 7) == 0;
        image<0>(acc, u, wr, fr, lcol8, bj);
        asm volatile("s_waitcnt lgkmcnt(0)" ::: "memory"); __builtin_amdgcn_s_barrier(); asm volatile("" ::: "memory");
        half_pass<0>(acc, u, wr, fr, lcol8, lch, smp, seq0, bj);
    }
};

template <int MY, class Epi>
__device__ __forceinline__ void sk_finish(f32x4 (&acc)[2][2][4][2], const Unit& cur, int me, int pc, const SkShare& sk, const Epi& E, int tid, int lane, int wr, int wc, int fr, int fq) {
    int tid2 = tid; asm volatile("" : "+v"(tid2));
    const __amdgpu_buffer_rsrc_t rs = __builtin_amdgcn_make_buffer_rsrc(sk.slab + (size_t)me * 65536, 0, 262144, 0x00020000);
#pragma unroll
    for (int a = 0; a < 2; ++a)
#pragma unroll
        for (int m = 0; m < 4; ++m)
#pragma unroll
            for (int n = 0; n < 2; ++n) __builtin_amdgcn_raw_buffer_store_b128(__builtin_bit_cast(u32x4, acc[a][1 - MY][m][n]), rs, (unsigned)(((a * 4 + m) * 2 + n) * 512 + tid2) * 16u, 0, 16);
    asm volatile("s_waitcnt vmcnt(0)" ::: "memory");
    if (lane == 0) __hip_atomic_fetch_add(sk.flags + 16 * me, 1u, __ATOMIC_RELAXED, __HIP_MEMORY_SCOPE_AGENT);
    unsigned spins = 0;
    while ((unsigned)__builtin_amdgcn_readfirstlane(__hip_atomic_load(sk.flags + 16 * pc, __ATOMIC_RELAXED, __HIP_MEMORY_SCOPE_AGENT)) < 8u) {
        __builtin_amdgcn_s_sleep(1);
        if ((++spins & 255u) == 0u) { if (__builtin_amdgcn_readfirstlane(__hip_atomic_load(sk.tmo, __ATOMIC_RELAXED, __HIP_MEMORY_SCOPE_AGENT)) != 0u) break;
            if (spins > (1u << 20)) { if (lane == 0) __hip_atomic_store(sk.tmo, 1u, __ATOMIC_RELAXED, __HIP_MEMORY_SCOPE_AGENT); break; } } }
    __builtin_amdgcn_fence(__ATOMIC_ACQUIRE, "agent");
    asm volatile("s_waitcnt vmcnt(0)" ::: "memory");
    const f32x4* sp = (const f32x4*)(sk.slab + (size_t)pc * 65536) + tid2;
#pragma unroll
    for (int a = 0; a < 2; ++a) {
        f32x4 p[8];
#pragma unroll
        for (int j = 0; j < 8; ++j) p[j] = sp[(a * 8 + j) * 512];
#pragma unroll
        for (int m = 0; m < 4; ++m) { acc[a][MY][m][0] += p[2 * m]; acc[a][MY][m][1] += p[2 * m + 1]; }
        asm volatile("" : "+v"(acc[a][MY][0][0]), "+v"(acc[a][MY][0][1]), "+v"(acc[a][MY][1][0]), "+v"(acc[a][MY][1][1]), "+v"(acc[a][MY][2][0]), "+v"(acc[a][MY][2][1]), "+v"(acc[a][MY][3][0]), "+v"(acc[a][MY][3][1]) :: "memory"); }
    E.template run<(1 << MY)>(acc, cur, wr, wc, fr, fq);
}
__device__ __forceinline__ void sk_exchange(f32x4 (&acc)[2][2][4][2], int me, int pc, const SkShare& sk, int tid, int lane) {
    int tid2 = tid; asm volatile("" : "+v"(tid2));
    const __amdgpu_buffer_rsrc_t rs = __builtin_amdgcn_make_buffer_rsrc(sk.slab + (size_t)me * 65536, 0, 262144, 0x00020000);
#pragma unroll
    for (int a = 0; a < 2; ++a)
#pragma unroll
        for (int m = 0; m < 4; ++m)
#pragma unroll
            for (int n = 0; n < 2; ++n) __builtin_amdgcn_raw_buffer_store_b128(__builtin_bit_cast(u32x4, acc[a][1][m][n]), rs, (unsigned)(((a * 4 + m) * 2 + n) * 512 + tid2) * 16u, 0, 16);
    asm volatile("s_waitcnt vmcnt(0)" ::: "memory");
    if (lane == 0) __hip_atomic_fetch_add(sk.flags + 16 * me, 1u, __ATOMIC_RELAXED, __HIP_MEMORY_SCOPE_AGENT);
    unsigned spins = 0;
    while ((unsigned)__builtin_amdgcn_readfirstlane(__hip_atomic_load(sk.flags + 16 * pc, __ATOMIC_RELAXED, __HIP_MEMORY_SCOPE_AGENT)) < 8u) {
        __builtin_amdgcn_s_sleep(1);
        if ((++spins & 255u) == 0u) { if (__builtin_amdgcn_readfirstlane(__hip_atomic_load(sk.tmo, __ATOMIC_RELAXED, __HIP_MEMORY_SCOPE_AGENT)) != 0u) break;
            if (spins > (1u << 20)) { if (lane == 0) __hip_atomic_store(sk.tmo, 1u, __ATOMIC_RELAXED, __HIP_MEMORY_SCOPE_AGENT); break; } } }
    __builtin_amdgcn_fence(__ATOMIC_ACQUIRE, "agent");
    asm volatile("s_waitcnt vmcnt(0)" ::: "memory");
    const f32x4* sp = (const f32x4*)(sk.slab + (size_t)pc * 65536) + tid2;
#pragma unroll
    for (int a = 0; a < 2; ++a)
#pragma unroll
        for (int mm = 0; mm < 4; mm += 2) {
            const f32x4 p0 = sp[(a * 8 + 2 * mm + 0) * 512], p1 = sp[(a * 8 + 2 * mm + 1) * 512], p2 = sp[(a * 8 + 2 * mm + 2) * 512], p3 = sp[(a * 8 + 2 * mm + 3) * 512];
            acc[a][0][mm][0] += p0; acc[a][0][mm][1] += p1; acc[a][0][mm + 1][0] += p2; acc[a][0][mm + 1][1] += p3;
            asm volatile("" : "+v"(acc[a][0][mm][0]), "+v"(acc[a][0][mm][1]), "+v"(acc[a][0][mm + 1][0]), "+v"(acc[a][0][mm + 1][1]) :: "memory"); }
}
template <class Epi, class Sched, bool ALIGN_EPI = false, bool SP2 = false>
__device__ __forceinline__ void gemm_phase(PG8_LAS unsigned char* lds, const Gemm g, Sched& S, const Epi& E, const SkShare sk) {
    const int tid = threadIdx.x, wid = __builtin_amdgcn_readfirstlane(tid >> 6), lane = tid & 63, wr = wid >> 2, wc = wid & 3, fr = lane & 15, fq = lane >> 4;
    const int K = g.K;
    unsigned voffA[2], voffB[2];
#pragma unroll
    for (int i = 0; i < 2; ++i) { int R, C; stage_rc(tid * 16 + i * 8192, R, C); const int Rb = Epi::PERM ? ((R & ~31) + perm32(R & 31)) : R;
        voffA[i] = (unsigned)(R * K + C) * 2u; voffB[i] = (unsigned)(Rb * K + C) * 2u; }
    const size_t kstep = (size_t)(BK * 2);
    const size_t hstep = (size_t)HALF * K * 2;
    const size_t tstep = 2 * hstep;
    const unsigned ldsw = (unsigned)wid * 1024u;
    const int aoff = lds_byte(wr * 64 + fr, fq * 8), boff = lds_byte(wc * 32 + fr, fq * 8);
#define PG8_SA(b, h) (((b) * 2 + (h)) * HTB)
#define PG8_SB(b, h) ((4 + (b) * 2 + (h)) * HTB)
#define PG8_STAGE(bufoff, gbase, voff) do { _Pragma("unroll") for (int _i = 0; _i < 2; ++_i) \
        __builtin_amdgcn_global_load_lds((const unsigned*)((const char*)(gbase) + (voff)[_i]), (PG8_LAS unsigned*)(lds + (bufoff) + ldsw + _i * 8192), 16, 0, 0); } while (0)
#define PG8_LDA(dst, b, h) do { _Pragma("unroll") for (int m = 0; m < 4; ++m) _Pragma("unroll") for (int k = 0; k < 2; ++k) dst[m][k] = *(const PG8_LAS bf16x8*)(lds + PG8_SA(b, h) + aoff + m * 2048 + k * 1024); } while (0)
#define PG8_LDB(dst, b, h) do { _Pragma("unroll") for (int n = 0; n < 2; ++n) _Pragma("unroll") for (int k = 0; k < 2; ++k) dst[n][k] = *(const PG8_LAS bf16x8*)(lds + PG8_SB(b, h) + boff + n * 2048 + k * 1024); } while (0)
#define PG8_MMA(ai, bj, At, Bt) do { __builtin_amdgcn_s_setprio(1); _Pragma("unroll") for (int m = 0; m < 4; ++m) _Pragma("unroll") for (int n = 0; n < 2; ++n) _Pragma("unroll") for (int k = 0; k < 2; ++k) \
        acc[ai][bj][m][n] = __builtin_amdgcn_mfma_f32_16x16x32_bf16(Bt[n][k], At[m][k], acc[ai][bj][m][n], 0, 0, 0); __builtin_amdgcn_s_setprio(0); } while (0)
#define PG8_WAIT_V(n) asm volatile("s_waitcnt vmcnt(" #n ")" ::: "memory")
#define PG8_WAIT_L(n) asm volatile("s_waitcnt lgkmcnt(" #n ")" ::: "memory")
#define PG8_BAR __builtin_amdgcn_s_barrier()
#define PG8_SCHED __builtin_amdgcn_sched_barrier(0)
    Unit cur, nxt; int ui = 0;
    if (!S.next(0, cur)) return;
    cur.par = 0; E.prep(cur, tid);
    f32x4 acc[2][2][4][2];
#pragma unroll
    for (int a = 0; a < 2; ++a)
#pragma unroll
        for (int b = 0; b < 2; ++b)
#pragma unroll
            for (int m = 0; m < 4; ++m)
#pragma unroll
                for (int n = 0; n < 2; ++n) acc[a][b][m][n] = (f32x4){0.f, 0.f, 0.f, 0.f};
    bf16x8 At[4][2], B0[2][2], B1[2][2];
    const char* cA = (const char*)g.A + (size_t)cur.pm * tstep + (size_t)cur.k0 * kstep; const char* cB = (const char*)g.Bt + (size_t)cur.pn * tstep + (size_t)cur.k0 * kstep;
    if constexpr (SP2) {
        PG8_STAGE(PG8_SB(0, 0), cB, voffB); PG8_STAGE(PG8_SB(0, 1), cB + hstep, voffB); PG8_STAGE(PG8_SA(0, 0), cA, voffA); PG8_STAGE(PG8_SA(0, 1), cA + hstep, voffA);
        if (wr == 1) PG8_BAR;
        PG8_WAIT_V(2); PG8_BAR;
        PG8_STAGE(PG8_SB(1, 0), cB + kstep, voffB); PG8_STAGE(PG8_SA(1, 0), cA + kstep, voffA); PG8_STAGE(PG8_SB(1, 1), cB + hstep + kstep, voffB);
        PG8_WAIT_V(6); PG8_BAR;
    } else {
        PG8_STAGE(PG8_SB(0, 0), cB, voffB); PG8_STAGE(PG8_SA(0, 0), cA, voffA); PG8_STAGE(PG8_SB(0, 1), cB + hstep, voffB); PG8_STAGE(PG8_SA(0, 1), cA + hstep, voffA);
        if (wr == 1) PG8_BAR;
        PG8_WAIT_V(4); PG8_BAR;
        PG8_STAGE(PG8_SB(1, 0), cB + kstep, voffB); PG8_STAGE(PG8_SA(1, 0), cA + kstep, voffA); PG8_STAGE(PG8_SB(1, 1), cB + hstep + kstep, voffB);
        PG8_WAIT_V(6); PG8_BAR;
    }
    for (;;) {
        const bool has_next = S.next(ui + 1, nxt); nxt.par = (has_next && nxt.pm != cur.pm) ? (cur.par ^ 1) : cur.par;
        const char* nA = has_next ? (const char*)g.A + (size_t)nxt.pm * tstep + (size_t)nxt.k0 * kstep : cA; const char* nB = has_next ? (const char*)g.Bt + (size_t)nxt.pn * tstep + (size_t)nxt.k0 * kstep : cB;
        const int nt = cur.nt;
        for (int t = 0; t < nt; t += 2) {
            const bool last = (t == nt - 2);
            const char* a1 = cA + (size_t)(t + 1) * kstep;
            const char* a2 = last ? nA : cA + (size_t)(t + 2) * kstep; const char* b2 = last ? nB : cB + (size_t)(t + 2) * kstep;
            const char* a3 = a2 + kstep; const char* b3 = b2 + kstep;
            if constexpr (SP2) {
            PG8_LDB(B0, 0, 0); PG8_LDB(B1, 0, 1); PG8_SCHED; PG8_LDA(At, 0, 0); PG8_STAGE(PG8_SA(1, 1), a1 + hstep, voffA);
            PG8_WAIT_V(8); PG8_WAIT_L(0); PG8_BAR; PG8_MMA(0, 0, At, B0); PG8_MMA(0, 1, At, B1); PG8_BAR; PG8_SCHED;
            PG8_LDA(At, 0, 1); PG8_STAGE(PG8_SB(0, 0), b2, voffB); PG8_STAGE(PG8_SB(0, 1), b2 + hstep, voffB); PG8_STAGE(PG8_SA(0, 0), a2, voffA);
            PG8_WAIT_V(8); PG8_WAIT_L(0); PG8_BAR; PG8_MMA(1, 0, At, B0); PG8_MMA(1, 1, At, B1); PG8_BAR; PG8_SCHED;
            PG8_LDB(B0, 1, 0); PG8_LDB(B1, 1, 1); PG8_SCHED; PG8_LDA(At, 1, 0); PG8_STAGE(PG8_SA(0, 1), a2 + hstep, voffA);
            PG8_WAIT_V(8); PG8_WAIT_L(0); PG8_BAR; PG8_MMA(0, 0, At, B0); PG8_MMA(0, 1, At, B1); PG8_BAR; PG8_SCHED;
            PG8_LDA(At, 1, 1); PG8_STAGE(PG8_SB(1, 0), b3, voffB); PG8_STAGE(PG8_SB(1, 1), b3 + hstep, voffB); PG8_STAGE(PG8_SA(1, 0), a3, voffA);
            PG8_WAIT_V(8); PG8_WAIT_L(0); PG8_BAR; PG8_MMA(1, 0, At, B0); PG8_MMA(1, 1, At, B1); PG8_BAR; PG8_SCHED;
            } else {
            PG8_LDB(B0, 0, 0); PG8_SCHED; PG8_LDA(At, 0, 0); PG8_STAGE(PG8_SA(1, 1), a1 + hstep, voffA);
            PG8_WAIT_L(8); PG8_BAR; PG8_WAIT_L(0); PG8_MMA(0, 0, At, B0); PG8_BAR; PG8_SCHED;
            PG8_LDB(B1, 0, 1); PG8_STAGE(PG8_SB(0, 0), b2, voffB);
            PG8_BAR; PG8_WAIT_L(0); PG8_MMA(0, 1, At, B1); PG8_BAR;
            PG8_LDA(At, 0, 1); PG8_STAGE(PG8_SA(0, 0), a2, voffA);
            PG8_BAR; PG8_WAIT_L(0); PG8_MMA(1, 0, At, B0); PG8_BAR; PG8_SCHED;
            PG8_STAGE(PG8_SB(0, 1), b2 + hstep, voffB);
            PG8_WAIT_V(6); PG8_BAR; PG8_MMA(1, 1, At, B1); PG8_BAR;
            PG8_LDB(B0, 1, 0); PG8_SCHED; PG8_LDA(At, 1, 0); PG8_STAGE(PG8_SA(0, 1), a2 + hstep, voffA);
            PG8_WAIT_L(8); PG8_BAR; PG8_WAIT_L(0); PG8_MMA(0, 0, At, B0); PG8_BAR; PG8_SCHED;
            PG8_LDB(B1, 1, 1); PG8_STAGE(PG8_SB(1, 0), b3, voffB);
            PG8_BAR; PG8_WAIT_L(0); PG8_MMA(0, 1, At, B1); PG8_BAR;
            PG8_LDA(At, 1, 1); PG8_STAGE(PG8_SA(1, 0), a3, voffA);
            PG8_BAR; PG8_WAIT_L(0); PG8_MMA(1, 0, At, B0); PG8_BAR; PG8_SCHED;
            PG8_STAGE(PG8_SB(1, 1), b3 + hstep, voffB);
            PG8_WAIT_V(6); PG8_BAR; PG8_MMA(1, 1, At, B1); PG8_BAR;
            }
        }
        if constexpr (ALIGN_EPI) { if (wr == 0) PG8_BAR; }
        if (cur.role != 0) break;
        E.template run<3>(acc, cur, wr, wc, fr, fq);
        if (!has_next) break;
        if (nxt.pm != cur.pm) E.prep(nxt, tid);
#pragma unroll
        for (int a = 0; a < 2; ++a)
#pragma unroll
            for (int b = 0; b < 2; ++b)
#pragma unroll
                for (int m = 0; m < 4; ++m)
#pragma unroll
                    for (int n = 0; n < 2; ++n) acc[a][b][m][n] = (f32x4){0.f, 0.f, 0.f, 0.f};
        cur = nxt; cA = nA; cB = nB; ++ui;
        if constexpr (ALIGN_EPI) { if (wr == 1) PG8_BAR; }
    }
    PG8_WAIT_V(0);
    if constexpr (!ALIGN_EPI) { if (wr == 0) PG8_BAR; }
    PG8_BAR;
    if constexpr (Epi::ONE_FINISH) {
        if (cur.role != 0) { const int my = cur.role == 2 ? 0 : 1;
            if (my == 1) {
#pragma unroll
                for (int a = 0; a < 2; ++a)
#pragma unroll
                    for (int m = 0; m < 4; ++m)
#pragma unroll
                        for (int n = 0; n < 2; ++n) { const f32x4 t = acc[a][0][m][n]; acc[a][0][m][n] = acc[a][1][m][n]; acc[a][1][m][n] = t; } }
            sk_exchange(acc, S.c, my == 0 ? S.c + NXCD : S.c - NXCD, sk, tid, lane);
            E.run_half(acc, cur, wr, wc, fr, fq, my); }
    } else {
        if (cur.role == 2) sk_finish<0>(acc, cur, S.c, S.c + NXCD, sk, E, tid, lane, wr, wc, fr, fq);
        else if (cur.role == 1) sk_finish<1>(acc, cur, S.c, S.c - NXCD, sk, E, tid, lane, wr, wc, fr, fq);
    }
#undef PG8_SA
#undef PG8_SB
#undef PG8_STAGE
#undef PG8_LDA
#undef PG8_LDB
#undef PG8_MMA
#undef PG8_WAIT_V
#undef PG8_WAIT_L
#undef PG8_BAR
#undef PG8_SCHED
}
}

#define GAS __attribute__((address_space(1)))
#define LAS __attribute__((address_space(3)))
typedef unsigned short bf16;
typedef unsigned v4u __attribute__((ext_vector_type(4)));
typedef float f32x4 __attribute__((ext_vector_type(4)));
typedef short bf16x8 __attribute__((ext_vector_type(8)));
typedef GAS unsigned gu32;
typedef GAS unsigned long long gu64;
#define RLX_AGENT __ATOMIC_RELAXED, __HIP_MEMORY_SCOPE_AGENT
#define LDS_WAIT() asm volatile("s_waitcnt lgkmcnt(0)" ::: "memory")
#define VM_WAIT() asm volatile("s_waitcnt vmcnt(0)" ::: "memory")
__device__ __forceinline__ unsigned long long rt() { return __builtin_amdgcn_s_memrealtime(); }

#define XB_TMO      128
#define XB_XCNT(j)  (256  + 64 * (j))
#define XB_XSUB(j)  (1280 + 64 * (j))
#define XB_XGEN(j)  (2304 + 64 * (j))
#define XB_TOP      3328
#define XB_TOPGEN   3392
#define XCD_BAR_WORDS 3456
#define XB_SPIN_CAP (1u << 18)

__device__ __forceinline__ unsigned xb_ld(unsigned* p)              { return __hip_atomic_load(p, __ATOMIC_RELAXED, __HIP_MEMORY_SCOPE_AGENT); }
__device__ __forceinline__ unsigned xb_add(unsigned* p, unsigned v) { return __hip_atomic_fetch_add(p, v, __ATOMIC_RELAXED, __HIP_MEMORY_SCOPE_AGENT); }
__device__ __forceinline__ unsigned xb_xcc_id() { return (unsigned)__builtin_amdgcn_s_getreg((3 << 11) | 20) & 0xFu; }
#define XB_SPIN(cond, bar) do { unsigned _sp = 0; while (cond) { __builtin_amdgcn_s_sleep(1); \
    if ((++_sp & 255u) == 0u) { if (xb_ld(&(bar)[XB_TMO])) break; if (_sp > XB_SPIN_CAP) { atomicAdd(&(bar)[XB_TMO], 1u); break; } } } } while (0)

struct XcdBarrier {
    unsigned* bar; unsigned x;
    volatile LAS unsigned* st;
};

__device__ __forceinline__ XcdBarrier xcd_barrier_post(unsigned* bar, volatile LAS unsigned* st) {
    XcdBarrier b; b.bar = bar; b.x = xb_xcc_id(); b.st = st;
    if (threadIdx.x == 0) (void)xb_add(&bar[XB_XCNT(b.x)], 1u);
    return b;
}
__device__ __forceinline__ void xcd_barrier_complete(unsigned* bar, unsigned x, unsigned& nloc, unsigned& nx) {
    const unsigned G = gridDim.x * gridDim.y * gridDim.z;
    unsigned sum, cnt, mine, sp = 0u;
    for (;;) {
        sum = 0u; cnt = 0u; mine = 0u;
#pragma unroll
        for (unsigned j = 0; j < 16; ++j) { const unsigned c = xb_ld(&bar[XB_XCNT(j)]); sum += c; cnt += (c > 0u) ? 1u : 0u; mine = (j == x) ? c : mine; }
        if (sum == G) break;
        __builtin_amdgcn_s_sleep(1);
        if ((++sp & 255u) == 0u) { if (xb_ld(&bar[XB_TMO])) break; if (sp > XB_SPIN_CAP) { atomicAdd(&bar[XB_TMO], 1u); break; } }
    }
    nloc = mine > 0u ? mine : 1u; nx = cnt > 0u ? cnt : 1u;
}

__device__ __forceinline__ void xcd_barrier(const XcdBarrier& b) {
    asm volatile("s_waitcnt vmcnt(0)" ::: "memory");
    __syncthreads();
    if (threadIdx.x == 0) {
        unsigned* bar = b.bar;
        __builtin_amdgcn_s_waitcnt(0);
        unsigned nloc = b.st[0], nx = b.st[1];
        if (nloc == 0u) { xcd_barrier_complete(bar, b.x, nloc, nx); b.st[0] = nloc; b.st[1] = nx; }
        const unsigned old = xb_add(&bar[XB_XSUB(b.x)], 1u);
        const unsigned gen = old / nloc;
        if (old + 1u == (gen + 1u) * nloc) {
            __builtin_amdgcn_fence(__ATOMIC_RELEASE, "agent");
            asm volatile("s_waitcnt vmcnt(0)" ::: "memory");
            const unsigned og = xb_add(&bar[XB_TOP], 1u);
            const unsigned tg = og / nx;
            if (og + 1u == (tg + 1u) * nx) xb_add(&bar[XB_TOPGEN], 1u);
            else XB_SPIN(xb_ld(&bar[XB_TOPGEN]) == tg, bar);
            __builtin_amdgcn_fence(__ATOMIC_ACQUIRE, "agent");
            xb_add(&bar[XB_XGEN(b.x)], 1u);
            asm volatile("s_waitcnt vmcnt(0)" ::: "memory");
        } else {
            XB_SPIN(xb_ld(&bar[XB_XGEN(b.x)]) == gen, bar);
            __builtin_amdgcn_fence(__ATOMIC_ACQUIRE, "agent");
            asm volatile("s_waitcnt vmcnt(0)" ::: "memory");
        }
    }
    __syncthreads();
}

constexpr int NWAVES = 8, NTHR = 512;
#ifndef MK_N_LAUNCHES
#define MK_N_LAUNCHES 1
#endif
constexpr int N_PHASES = 18;
constexpr int N_LAUNCHES = MK_N_LAUNCHES;
constexpr int D = 4096, MP = 8192, MS = 2048, M = MP + MS;
constexpr int CONVD = 2048, NPROJ = 9216, DFF = 11008, NUP = 22016, NGM = 8192;
constexpr int OFF_GB = 0, OFF_GC = 2048, OFF_HV = 4096, OFF_Q = 6144, OFF_K = 8192, OFF_V = 8704;
constexpr float RMS_EPS = 1e-6f, LN_EPS = 1e-5f;
constexpr size_t O_YP = 0, O_YS = O_YP + (size_t)MP * D, O_CP = O_YS + (size_t)MS * D, O_CS = O_CP + 4 * 2 * 2048, O_KP = O_CS + 32 * 2 * 2048, O_KS = O_KP + 4 * 128 * 512,
                 O_VP = O_KS + 32 * 128 * 512, O_VS = O_VP + 4 * 128 * 512, O_FP = O_VS + 32 * 128 * 512, O_FS = O_FP + (size_t)2 * 4 * 2 * NUP, O_GV = O_FS + (size_t)2 * 32 * 2 * NUP,
                 O_END = O_GV + (size_t)MS * D;
constexpr size_t MiB = 1u << 20;
constexpr size_t WS_CTL = 0, CTL_ZERO_BYTES = 1 * MiB;
constexpr size_t WS_WIN = 1 * MiB, WS_WOUT = WS_WIN + (size_t)NPROJ * D * 2, WS_WINC = WS_WOUT + (size_t)D * D * 2, WS_WOUTC = WS_WINC + (size_t)NGM * D * 2,
                 WS_WUP = WS_WOUTC + (size_t)D * D * 2, WS_WDN = WS_WUP + (size_t)2 * NUP * D * 2, WS_XN = WS_WDN + (size_t)2 * D * DFF * 2,
                 WS_PROJ = WS_XN + (size_t)M * D * 2, WS_MIX = WS_PROJ + (size_t)M * NPROJ * 2, WS_X = WS_MIX + (size_t)M * D * 2, WS_UP = WS_X + (size_t)M * D * 4,
                 WS_ACT = WS_UP + (size_t)M * NUP * 2, WS_Z = WS_ACT + (size_t)M * DFF * 2, WS_VLN = WS_Z + (size_t)M * NGM * 2, WS_RS = WS_VLN + (size_t)M * D * 2, WS_LS = WS_RS + (size_t)M * 128 * 4, WS_RSTD = WS_LS + (size_t)M * 128 * 8, WS_SLAB = WS_RSTD + (size_t)M * 4, WS_SIDE = WS_SLAB + (size_t)2 * 256 * 262144, WS_END = WS_SIDE + (size_t)32 * 4 * NUP * 4;
constexpr int CW_BAR = 4096, CW_SK = 16384;
constexpr int RING_OFF = 0, RING_BYTES = 131072, LDSCTL_OFF = RING_BYTES, MISC_OFF = LDSCTL_OFF + 320, TAB_OFF = LDSCTL_OFF + 1024  , BND_OFF = TAB_OFF + 2048  , LDS_BYTES = BND_OFF + 16384;

typedef unsigned short bf16;
typedef unsigned u32x4 __attribute__((ext_vector_type(4)));
typedef unsigned u32x2 __attribute__((ext_vector_type(2)));
typedef float f32x4 __attribute__((ext_vector_type(4)));
typedef float f32x16 __attribute__((ext_vector_type(16)));
typedef short bf16x8 __attribute__((ext_vector_type(8)));
typedef short s16x4 __attribute__((ext_vector_type(4)));
#define LDS_WAIT() asm volatile("s_waitcnt lgkmcnt(0)" ::: "memory")
#define MFMA32(a, b, c) __builtin_amdgcn_mfma_f32_32x32x16_bf16((a), (b), (c), 0, 0, 0)

struct Args {
    const float *x_p, *x_s, *st_conv, *cache_k, *cache_v, *st_ffn, *norm_mix, *norm_ffn, *norm_final, *w_in_ab, *conv_w_a, *sinks, *w_out_ab, *w_in_c, *ln_g, *ln_b, *w_s, *b_s, *w_out_c,
        *w_up, *conv_w_ffn, *conv_b_ffn, *w_down;
    float* out; unsigned char* ws; int ph_lo, ph_hi;
};

__device__ __forceinline__ float bflo(unsigned w) { return __uint_as_float(w << 16); }
__device__ __forceinline__ float bfhi(unsigned w) { return __uint_as_float(w & 0xffff0000u); }
__device__ __forceinline__ unsigned pk2(float lo, float hi) { return pg8::cvt_pk_bf16(lo, hi); }
__device__ __forceinline__ void unpack8(const u32x4 w, float (&f)[8]) { f[0] = bflo(w.x); f[1] = bfhi(w.x); f[2] = bflo(w.y); f[3] = bfhi(w.y); f[4] = bflo(w.z); f[5] = bfhi(w.z); f[6] = bflo(w.w); f[7] = bfhi(w.w); }
__device__ __forceinline__ u32x4 pack8(const float (&f)[8]) { u32x4 w; w.x = pk2(f[0], f[1]); w.y = pk2(f[2], f[3]); w.z = pk2(f[4], f[5]); w.w = pk2(f[6], f[7]); return w; }
__device__ __forceinline__ void load8f(const float* p, float (&f)[8]) { const f32x4 a = *(const f32x4*)p, b = *(const f32x4*)(p + 4); f[0] = a.x; f[1] = a.y; f[2] = a.z; f[3] = a.w; f[4] = b.x; f[5] = b.y; f[6] = b.z; f[7] = b.w; }
__device__ __forceinline__ void store8f(float* p, const float (&f)[8]) { *(f32x4*)p = (f32x4){f[0], f[1], f[2], f[3]}; *(f32x4*)(p + 4) = (f32x4){f[4], f[5], f[6], f[7]}; }
__device__ __forceinline__ float wave_sum(float v) {
#pragma unroll
    for (int o = 1; o < 64; o <<= 1) v += __shfl_xor(v, o);
    return v;
}
__device__ __forceinline__ int crow(int r, int hi) { return (r & 3) + 8 * (r >> 2) + 4 * hi; }

__device__ __forceinline__ void p0_load_item(const float* W, const float* gain, int N, int item, int lane, f32x4 (&v)[8]) {
    const int nblk = N / 32, kb = item / nblk, nb = item % nblk;
    const float* src = W + (size_t)(64 * kb + 8 * (lane >> 3)) * N + 32 * nb + 4 * (lane & 7);
#pragma unroll
    for (int i = 0; i < 8; ++i) v[i] = __builtin_nontemporal_load((const f32x4*)(src + (size_t)i * N));
    if (gain) { float gk[8]; load8f(gain + 64 * kb + 8 * (lane >> 3), gk);
#pragma unroll
        for (int i = 0; i < 8; ++i) v[i] = v[i] * gk[i]; }
}
template <bool PERMUP> __device__ __forceinline__ void p0_store_item(bf16* WT, int K, int N, int item, int lane, const f32x4 (&v)[8]) {
    const int nblk = N / 32, kb = item / nblk, nb = item % nblk;
    int rowb = 32 * nb + 4 * (lane & 7);
    if (PERMUP) { const int s0 = 32 * nb, hf = s0 >= DFF ? 1 : 0, ch = s0 - hf * DFF + 4 * (lane & 7), t = ch >> 7, ct = ch & 127;
        rowb = 256 * t + 128 * (ct >> 6) + 32 * ((ct >> 4) & 3) + 8 * ((ct >> 2) & 3) + 4 * hf; }
    bf16* dst = WT + (size_t)rowb * K + 64 * kb + 8 * (lane >> 3);
#pragma unroll
    for (int j = 0; j < 4; ++j) { u32x4 o; o.x = pk2(v[0][j], v[1][j]); o.y = pk2(v[2][j], v[3][j]); o.z = pk2(v[4][j], v[5][j]); o.w = pk2(v[6][j], v[7][j]);
        *(u32x4*)(dst + (size_t)j * K) = o; }
}
template <int NI, bool PERMUP = false> __device__ __forceinline__ void p0_transpose(const float* W, const float* gain, int K, int N, bf16* WT, int gw, int NGW, int lane) {
    const int nitems = (K / 64) * (N / 32);
    for (int it = gw; it < nitems; it += NI * NGW) {
        f32x4 v[NI][8];
#pragma unroll
        for (int j = 0; j < NI; ++j) { const int itj = it + j * NGW; if (itj < nitems) p0_load_item(W, gain, N, itj, lane, v[j]); }
#pragma unroll
        for (int j = 0; j < NI; ++j) { const int itj = it + j * NGW; if (itj < nitems) p0_store_item<PERMUP>(WT, K, N, itj, lane, v[j]); }
    }
}
__device__ __forceinline__ void final_row2(const float* x0, const float* x1, const float* rs0, const float* rs1, const float* g, float* o0, float* o1, bool two, int lane) {
    const float s = wave_sum(rs0[lane] + rs0[64 + lane]), t = wave_sum(rs1[lane] + rs1[64 + lane]);
    const float ra = 1.0f / sqrtf(s * (1.f / D) + RMS_EPS), rb = 1.0f / sqrtf(t * (1.f / D) + RMS_EPS);
    const f32x4* xr0 = (const f32x4*)x0 + lane; const f32x4* xr1 = (const f32x4*)x1 + lane; const f32x4* gr = (const f32x4*)g + lane;
#pragma unroll
    for (int j = 0; j < 16; ++j) { const f32x4 gg = gr[64 * j]; const f32x4 y = __builtin_nontemporal_load(xr0 + 64 * j) * ra * gg; __builtin_nontemporal_store(y, (f32x4*)o0 + lane + 64 * j);
        if (two) { const f32x4 z = __builtin_nontemporal_load(xr1 + 64 * j) * rb * gg; __builtin_nontemporal_store(z, (f32x4*)o1 + lane + 64 * j); } }
}
template <bool OUTF> __device__ __forceinline__ void rms_row2(const float* x0, const float* x1, const float* g, void* o0, void* o1, bool two, int lane) {
    const f32x4* xr0 = (const f32x4*)x0 + lane; const f32x4* xr1 = (const f32x4*)x1 + lane;
    f32x4 v[16], w[16]; float s = 0.f, t = 0.f;
#pragma unroll
    for (int j = 0; j < 16; ++j) v[j] = OUTF ? __builtin_nontemporal_load(xr0 + 64 * j) : xr0[64 * j];
    if (two) {
#pragma unroll
        for (int j = 0; j < 16; ++j) w[j] = OUTF ? __builtin_nontemporal_load(xr1 + 64 * j) : xr1[64 * j];
    } else {
#pragma unroll
        for (int j = 0; j < 16; ++j) w[j] = (f32x4){0.f, 0.f, 0.f, 0.f};
    }
#pragma unroll
    for (int j = 0; j < 16; ++j) { s += (v[j].x * v[j].x + v[j].y * v[j].y) + (v[j].z * v[j].z + v[j].w * v[j].w); t += (w[j].x * w[j].x + w[j].y * w[j].y) + (w[j].z * w[j].z + w[j].w * w[j].w); }
    const float rs = 1.0f / sqrtf(wave_sum(s) * (1.f / D) + RMS_EPS), rt = 1.0f / sqrtf(wave_sum(t) * (1.f / D) + RMS_EPS);
    const f32x4* gr = (const f32x4*)g + lane;
#pragma unroll
    for (int j = 0; j < 16; ++j) { const f32x4 gg = gr[64 * j]; const f32x4 y = v[j] * rs * gg, z = w[j] * rt * gg;
        if (OUTF) { __builtin_nontemporal_store(y, (f32x4*)o0 + lane + 64 * j); if (two) __builtin_nontemporal_store(z, (f32x4*)o1 + lane + 64 * j); }
        else { u32x2 a; a.x = pk2(y.x, y.y); a.y = pk2(y.z, y.w); ((u32x2*)o0 + lane)[64 * j] = a; if (two) { u32x2 b; b.x = pk2(z.x, z.y); b.y = pk2(z.z, z.w); ((u32x2*)o1 + lane)[64 * j] = b; } } }
}
struct Ctx { int tid, lane, wave, vcu, G; LAS unsigned char* lds; };

__device__ __forceinline__ void phase_rms(const Ctx& c, const float* xp, const float* xs, const float* g, bf16* XN) {
    const int gw = c.vcu * NWAVES + c.wave, NGW = c.G * NWAVES;
    for (int m = gw; m < M; m += 2 * NGW) { const int m2 = m + NGW; const bool two = m2 < M; const int mm = two ? m2 : m;
        const float* x0 = m < MP ? xp + (size_t)m * D : xs + (size_t)(m - MP) * D; const float* x1 = mm < MP ? xp + (size_t)mm * D : xs + (size_t)(mm - MP) * D;
        rms_row2<false>(x0, x1, g, XN + (size_t)m * D, XN + (size_t)mm * D, two, c.lane); }
}
__device__ __forceinline__ void phase_final(const Ctx& c, const bf16* X, const float* RS, const float* g, float* out) {
    const int rpbn = (M + c.G - 1) / c.G, r0 = c.vcu * rpbn, rpb = r0 >= M ? 0 : (M - r0 < rpbn ? M - r0 : rpbn);
    LAS float* tab = (LAS float*)(c.lds + TAB_OFF);
    for (int r = c.wave; r < rpb; r += NWAVES) { const float* rs = RS + (size_t)(r0 + r) * 128; const float s = wave_sum(rs[c.lane] + rs[64 + c.lane]); if (c.lane == 0) tab[r] = 1.0f / sqrtf(s * (1.f / D) + RMS_EPS); }
    __syncthreads();
    const u32x4* xp = (const u32x4*)(X + (size_t)r0 * D); float* op = out + O_YP + (size_t)r0 * D;
    const int n8 = rpb * (D / 8);
    for (int i0 = c.tid; i0 < n8; i0 += 16 * NTHR) {
        u32x4 v[16];
#pragma unroll
        for (int j = 0; j < 16; ++j) { const int i = i0 + j * NTHR; if (i < n8) v[j] = __builtin_nontemporal_load(xp + i); }
#pragma unroll
        for (int j = 0; j < 16; ++j) { const int i = i0 + j * NTHR; if (i < n8) { const float rs = tab[i >> 9]; float f[8], gg[8]; unpack8(v[j], f); load8f(g + (i & 511) * 8, gg);
#pragma unroll
                for (int e = 0; e < 8; ++e) f[e] = f[e] * rs * gg[e];
                __builtin_nontemporal_store((f32x4){f[0], f[1], f[2], f[3]}, (f32x4*)(op + (size_t)i * 8)); __builtin_nontemporal_store((f32x4){f[4], f[5], f[6], f[7]}, (f32x4*)(op + (size_t)i * 8 + 4)); } }
    }
    __syncthreads();
}
template <int NI> __device__ __forceinline__ void convert_weights(const Args& a, int which, int gw, int NGW, int lane) {
    unsigned char* ws = a.ws;
    if (which & 1) p0_transpose<NI>(a.w_in_ab, nullptr, D, NPROJ, (bf16*)(ws + WS_WIN), gw, NGW, lane);
    if (which & 2) p0_transpose<NI>(a.w_out_ab, nullptr, D, D, (bf16*)(ws + WS_WOUT), gw, NGW, lane);
    if (which & 4) p0_transpose<NI, true>(a.w_up, a.norm_ffn, D, NUP, (bf16*)(ws + WS_WUP), gw, NGW, lane);
    if (which & 8) p0_transpose<NI>(a.w_down, nullptr, DFF, D, (bf16*)(ws + WS_WDN), gw, NGW, lane);
    if (which & 16) p0_transpose<NI>(a.w_in_c, a.norm_mix + D, D, NGM, (bf16*)(ws + WS_WINC), gw, NGW, lane);
    if (which & 32) p0_transpose<NI>(a.w_out_c, nullptr, D, D, (bf16*)(ws + WS_WOUTC), gw, NGW, lane);
    if (which & 64) p0_transpose<NI, true>(a.w_up + (size_t)D * NUP, a.norm_ffn + D, D, NUP, (bf16*)(ws + WS_WUP) + (size_t)NUP * D, gw, NGW, lane);
    if (which & 128) p0_transpose<NI>(a.w_down + (size_t)DFF * D, nullptr, DFF, D, (bf16*)(ws + WS_WDN) + (size_t)D * DFF, gw, NGW, lane);
}
__device__ __forceinline__ void phase_prologue(const Ctx& c, const Args& a) {
#ifndef MK_BST
#define MK_BST true
#endif
#ifndef MK_P2_CONV
#define MK_P2_CONV 254
#endif
    convert_weights<2>(a, 255 & ~MK_P2_CONV, c.vcu * NWAVES + c.wave, c.G * NWAVES, c.lane);
    phase_rms(c, a.x_p, a.x_s, a.norm_mix, (bf16*)(a.ws + WS_XN));
}

__device__ __forceinline__ void mix0_conv(const Ctx& c, const Args& a) {
    const bf16* PROJ = (const bf16*)(a.ws + WS_PROJ); bf16* MIX = (bf16*)(a.ws + WS_MIX);
    const int gt = c.vcu * NTHR + c.tid, NT = c.G * NTHR;
    for (int it = gt; it < (M / 16) * 256; it += NT) {
        const int cc = it & 255, rb = it >> 8, r0 = rb * 16, ch = cc * 8;
        const bool smp = r0 >= MP; const int t0 = smp ? ((r0 - MP) & 63) : (r0 & 2047), T = smp ? 64 : 2048, b = smp ? ((r0 - MP) >> 6) : (r0 >> 11);
        float w0[8], w1[8], w2[8], p2[8], p1[8];
        load8f(a.conv_w_a + ch, w0); load8f(a.conv_w_a + CONVD + ch, w1); load8f(a.conv_w_a + 2 * CONVD + ch, w2);
        if (t0 == 0) {
            if (smp) { load8f(a.st_conv + (size_t)(b * 2 + 0) * CONVD + ch, p2); load8f(a.st_conv + (size_t)(b * 2 + 1) * CONVD + ch, p1); }
            else {
#pragma unroll
                for (int e = 0; e < 8; ++e) { p2[e] = 0.f; p1[e] = 0.f; } }
        } else {
            float gc[8], hv[8];
            const bf16* pr = PROJ + (size_t)(r0 - 2) * NPROJ + ch;
            unpack8(*(const u32x4*)(pr + OFF_GC), gc); unpack8(*(const u32x4*)(pr + OFF_HV), hv);
#pragma unroll
            for (int e = 0; e < 8; ++e) p2[e] = gc[e] * hv[e];
            pr += NPROJ;
            unpack8(*(const u32x4*)(pr + OFF_GC), gc); unpack8(*(const u32x4*)(pr + OFF_HV), hv);
#pragma unroll
            for (int e = 0; e < 8; ++e) p1[e] = gc[e] * hv[e];
        }
        float* so = a.out + (smp ? O_CS : O_CP) + (size_t)b * 2 * CONVD + ch;
#pragma unroll 1
        for (int i0 = 0; i0 < 16; i0 += 8) {
            u32x4 rb[8], rc[8], rh[8];
#pragma unroll
            for (int i = 0; i < 8; ++i) { const bf16* pr = PROJ + (size_t)(r0 + i0 + i) * NPROJ + ch; rb[i] = *(const u32x4*)(pr + OFF_GB); rc[i] = *(const u32x4*)(pr + OFF_GC); rh[i] = *(const u32x4*)(pr + OFF_HV); }
#pragma unroll
            for (int i = 0; i < 8; ++i) {
                float gb[8], gc[8], hv[8], cur[8], o[8];
                unpack8(rb[i], gb); unpack8(rc[i], gc); unpack8(rh[i], hv);
#pragma unroll
                for (int e = 0; e < 8; ++e) { cur[e] = gc[e] * hv[e]; o[e] = gb[e] * (w0[e] * p2[e] + w1[e] * p1[e] + w2[e] * cur[e]); }
                *(u32x4*)(MIX + (size_t)(r0 + i0 + i) * D + ch) = pack8(o);
                const int j = t0 + i0 + i - (T - 2);
                if (j >= 0) store8f(so + (size_t)j * CONVD, cur);
#pragma unroll
                for (int e = 0; e < 8; ++e) { p2[e] = p1[e]; p1[e] = cur[e]; }
            }
        }
    }
}
__device__ __forceinline__ void mix0_kvstate(const Ctx& c, const Args& a) {
    const bf16* PROJ = (const bf16*)(a.ws + WS_PROJ);
    const int gt = c.vcu * NTHR + c.tid, NT = c.G * NTHR;
    constexpr int NP = 4 * 128 * 64, NS = 32 * 128 * 64;
    for (int it = gt; it < 2 * (NP + NS); it += NT) {
        const int isv = it >= (NP + NS); int r = isv ? it - (NP + NS) : it;
        const int off = isv ? OFF_V : OFF_K; float f[8]; float* o;
        if (r < NP) { const int e8 = r & 63, j = (r >> 6) & 127, b = r >> 13;
            unpack8(*(const u32x4*)(PROJ + (size_t)(b * 2048 + 1920 + j) * NPROJ + off + e8 * 8), f);
            o = a.out + (isv ? O_VP : O_KP) + (size_t)r * 8;
        } else { r -= NP; const int e8 = r & 63, j = (r >> 6) & 127, b = r >> 13;
            if (j < 64) load8f((isv ? a.cache_v : a.cache_k) + ((size_t)(b * 128 + 64 + j) * 512 + e8 * 8), f);
            else unpack8(*(const u32x4*)(PROJ + (size_t)(MP + b * 64 + (j - 64)) * NPROJ + off + e8 * 8), f);
            o = a.out + (isv ? O_VS : O_KS) + (size_t)r * 8;
        }
        store8f(o, f);
    }
}
constexpr int KS_PITCH = 72, VT_PITCH = 200;
__device__ __forceinline__ void attn_unit(const Ctx& c, const Args& a, int unit) {
    const bf16* PROJ = (const bf16*)(a.ws + WS_PROJ); bf16* MIX = (bf16*)(a.ws + WS_MIX);
    const int tid = c.tid, wid = c.wave, lane = c.lane, l32 = lane & 31, hi = lane >> 5;
    const int ch = unit >> 3, kvh = unit & 7;
    LAS bf16* Ks = (LAS bf16*)(c.lds + RING_OFF); LAS bf16* Vt = (LAS bf16*)(c.lds + RING_OFF + 192 * KS_PITCH * 2);
    const bool smp = ch >= 128; int b, qrow0, jmin;
    if (!smp) { b = ch >> 5; const int cq = ch & 31; qrow0 = b * 2048 + cq * 64; jmin = cq >= 2 ? 0 : (2 - cq) * 64; } else { b = ch - 128; qrow0 = MP + b * 64; jmin = 0; }
    const int h = kvh * 4 + (wid >> 1), tq = 32 * (wid & 1) + l32;
    u32x4 qraw[4];
    { const bf16* qp = PROJ + (size_t)(qrow0 + tq) * NPROJ + OFF_Q + h * 64 + 8 * hi;
#pragma unroll
      for (int ks = 0; ks < 4; ++ks) qraw[ks] = *(const u32x4*)(qp + 16 * ks); }
#pragma unroll
    for (int i = 0; i < 3; ++i) {
        const int ci = tid + NTHR * i, j = ci >> 3, cc = ci & 7; u32x4 kv, vv;
        if (j < jmin) { kv = (u32x4){0u, 0u, 0u, 0u}; vv = kv; }
        else if (smp && j < 128) { float f[8]; const size_t o = ((size_t)(b * 128 + j) * 8 + kvh) * 64 + cc * 8; load8f(a.cache_k + o, f); kv = pack8(f); load8f(a.cache_v + o, f); vv = pack8(f); }
        else { const int row = smp ? (MP + b * 64 + (j - 128)) : (qrow0 - 128 + j); const bf16* p = PROJ + (size_t)row * NPROJ + kvh * 64 + cc * 8;
            kv = *(const u32x4*)(p + OFF_K); vv = *(const u32x4*)(p + OFF_V); }
        *(LAS u32x4*)(Ks + j * KS_PITCH + cc * 8) = kv;
        LAS bf16* vt = Vt + (cc * 8) * VT_PITCH + ((((j >> 2) ^ cc)) << 2) + (j & 3);
        vt[0 * VT_PITCH] = (bf16)(vv.x & 0xffffu); vt[1 * VT_PITCH] = (bf16)(vv.x >> 16); vt[2 * VT_PITCH] = (bf16)(vv.y & 0xffffu); vt[3 * VT_PITCH] = (bf16)(vv.y >> 16);
        vt[4 * VT_PITCH] = (bf16)(vv.z & 0xffffu); vt[5 * VT_PITCH] = (bf16)(vv.z >> 16); vt[6 * VT_PITCH] = (bf16)(vv.w & 0xffffu); vt[7 * VT_PITCH] = (bf16)(vv.w >> 16);
    }
    __syncthreads();
    bf16x8 qf[4];
#pragma unroll
    for (int ks = 0; ks < 4; ++ks) { float f[8]; unpack8(qraw[ks], f);
#pragma unroll
        for (int e = 0; e < 8; ++e) f[e] *= 0.125f;
        qf[ks] = __builtin_bit_cast(bf16x8, pack8(f)); }
    const float slope = exp2f(-0.25f * (float)(h + 1)), sink = a.sinks[h];
    const float t0 = (float)(tq + 128 - 4 * hi);
    const int kb0 = jmin >> 5;
    float mx = sink;
#pragma unroll
    for (int kb = 0; kb < 6; ++kb) {
        if (kb >= kb0) { f32x16 acc;
#pragma unroll
            for (int r = 0; r < 16; ++r) acc[r] = 0.f;
#pragma unroll
            for (int ks = 0; ks < 4; ++ks) { const bf16x8 kf = *(const LAS bf16x8*)(Ks + (32 * kb + l32) * KS_PITCH + 16 * ks + 8 * hi); acc = MFMA32(kf, qf[ks], acc); }
#pragma unroll
            for (int r = 0; r < 16; ++r) { const float dist = fabsf(t0 - (float)(32 * kb + (r & 3) + 8 * (r >> 2))); mx = fmaxf(mx, acc[r] - slope * dist); }
        }
        __builtin_amdgcn_sched_barrier(0);
    }
    mx = fmaxf(mx, __shfl_xor(mx, 32));
    f32x16 o0, o1; float sum = 0.f;
#pragma unroll
    for (int r = 0; r < 16; ++r) { o0[r] = 0.f; o1[r] = 0.f; }
#pragma unroll
    for (int kb = 0; kb < 6; ++kb) {
        if (kb >= kb0) { f32x16 acc;
#pragma unroll
            for (int r = 0; r < 16; ++r) acc[r] = 0.f;
#pragma unroll
            for (int ks = 0; ks < 4; ++ks) { const bf16x8 kf = *(const LAS bf16x8*)(Ks + (32 * kb + l32) * KS_PITCH + 16 * ks + 8 * hi); acc = MFMA32(kf, qf[ks], acc); }
            float p[16];
#pragma unroll
            for (int r = 0; r < 16; ++r) { const float dist = fabsf(t0 - (float)(32 * kb + (r & 3) + 8 * (r >> 2))); p[r] = __expf(acc[r] - slope * dist - mx); sum += p[r]; }
#pragma unroll
            for (int s = 0; s < 2; ++s) {
                u32x4 pw; pw.x = pk2(p[8 * s + 0], p[8 * s + 1]); pw.y = pk2(p[8 * s + 2], p[8 * s + 3]); pw.z = pk2(p[8 * s + 4], p[8 * s + 5]); pw.w = pk2(p[8 * s + 6], p[8 * s + 7]);
                const int k0 = l32 >> 3, x0 = 4 * s + hi, x1 = x0 + 2;
                const LAS bf16* vp = Vt + l32 * VT_PITCH + 32 * kb;
                const s16x4 a0 = *(const LAS s16x4*)(vp + ((x0 ^ k0) << 2)), a1 = *(const LAS s16x4*)(vp + ((x1 ^ k0) << 2)), b0 = *(const LAS s16x4*)(vp + 32 * VT_PITCH + ((x0 ^ k0 ^ 4) << 2)), b1 = *(const LAS s16x4*)(vp + 32 * VT_PITCH + ((x1 ^ k0 ^ 4) << 2));
                o0 = MFMA32(__builtin_shufflevector(a0, a1, 0, 1, 2, 3, 4, 5, 6, 7), __builtin_bit_cast(bf16x8, pw), o0);
                o1 = MFMA32(__builtin_shufflevector(b0, b1, 0, 1, 2, 3, 4, 5, 6, 7), __builtin_bit_cast(bf16x8, pw), o1); }
        }
        __builtin_amdgcn_sched_barrier(0);
    }
    sum += __shfl_xor(sum, 32);
    const float inv = 1.0f / (sum + __expf(sink - mx));
    bf16* op = MIX + (size_t)(qrow0 + tq) * D + CONVD + h * 64 + 4 * hi;
#pragma unroll
    for (int g = 0; g < 4; ++g) { u32x2 w; w.x = pk2(o0[4 * g] * inv, o0[4 * g + 1] * inv); w.y = pk2(o0[4 * g + 2] * inv, o0[4 * g + 3] * inv); *(u32x2*)(op + 8 * g) = w;
        w.x = pk2(o1[4 * g] * inv, o1[4 * g + 1] * inv); w.y = pk2(o1[4 * g + 2] * inv, o1[4 * g + 3] * inv); *(u32x2*)(op + 32 + 8 * g) = w; }
    __syncthreads();
}
__device__ __forceinline__ void phase_mix0(const Ctx& c, const Args& a) {
    if (c.vcu & 1) { convert_weights<2>(a, MK_P2_CONV, c.vcu * NWAVES + c.wave, c.G * NWAVES, c.lane); mix0_conv(c, a); mix0_kvstate(c, a); }
    for (int u = c.vcu; u < 160 * 8; u += c.G) attn_unit(c, a, u);
    if (!(c.vcu & 1)) { convert_weights<2>(a, MK_P2_CONV, c.vcu * NWAVES + c.wave, c.G * NWAVES, c.lane); mix0_conv(c, a); mix0_kvstate(c, a); }
}

__device__ __forceinline__ void phase_ffnfix(const Ctx& c, const Args& a, int layer) {
    const float* SIDE = (const float*)(a.ws + WS_SIDE); bf16* ACT = (bf16*)(a.ws + WS_ACT);
    const float* cw = a.conv_w_ffn + (size_t)layer * 3 * NUP; const float* cb = a.conv_b_ffn + (size_t)layer * NUP;
    const int gt = c.vcu * NTHR + c.tid, NT = c.G * NTHR; constexpr int NCH = DFF / 8;
    for (int it = gt; it < 32 * 2 * NCH; it += NT) {
        const int cc = it % NCH, tr = it / NCH, r = tr & 1, pm = tr >> 1, ch = cc * 8;
        if ((pm & 7) == 0) continue;
        const float* s2 = r == 0 ? SIDE + ((size_t)((pm - 1) * 4 + 2)) * NUP : SIDE + ((size_t)((pm - 1) * 4 + 3)) * NUP;
        const float* s1 = r == 0 ? SIDE + ((size_t)((pm - 1) * 4 + 3)) * NUP : SIDE + ((size_t)(pm * 4 + 0)) * NUP;
        const float* s0 = SIDE + ((size_t)(pm * 4 + r)) * NUP;
        float wg0[8], wg1[8], wg2[8], wu0[8], wu1[8], wu2[8], bg[8], bu[8], g2[8], g1[8], g0[8], u2[8], u1[8], u0[8], o[8];
        load8f(cw + ch, wg0); load8f(cw + NUP + ch, wg1); load8f(cw + 2 * NUP + ch, wg2); load8f(cw + DFF + ch, wu0); load8f(cw + NUP + DFF + ch, wu1); load8f(cw + 2 * NUP + DFF + ch, wu2);
        load8f(cb + ch, bg); load8f(cb + DFF + ch, bu);
        load8f(s2 + ch, g2); load8f(s2 + DFF + ch, u2); load8f(s1 + ch, g1); load8f(s1 + DFF + ch, u1); load8f(s0 + ch, g0); load8f(s0 + DFF + ch, u0);
#pragma unroll
        for (int e = 0; e < 8; ++e) { const float cg = wg0[e] * g2[e] + wg1[e] * g1[e] + wg2[e] * g0[e] + bg[e], cu = wu0[e] * u2[e] + wu1[e] * u1[e] + wu2[e] * u0[e] + bu[e];
            o[e] = cg / (1.0f + __expf(-cg)) * cu; }
        *(u32x4*)(ACT + (size_t)(pm * 256 + r) * DFF + ch) = pack8(o);
    }
}
constexpr int SG_PITCH = 136, SO_PITCH = 264;
constexpr int WL_OFF = 256 * SG_PITCH * 2, WL_PITCH = 136;
__device__ __forceinline__ void sgu_load_w(const Ctx& c, const Args& a, int g) {
    LAS bf16* WL = (LAS bf16*)(c.lds + RING_OFF + WL_OFF); const float* wsg = a.w_s + (size_t)g * 128 * 128;
#pragma unroll
    for (int i = 0; i < 8; ++i) { const int ci = c.tid + NTHR * i, t = ci >> 5, s0 = (ci & 31) * 4; const f32x4 w = *(const f32x4*)(wsg + (size_t)t * 128 + s0);
        u32x2 o; o.x = pk2(s0 + 0 <= t ? w.x : 0.f, s0 + 1 <= t ? w.y : 0.f); o.y = pk2(s0 + 2 <= t ? w.z : 0.f, s0 + 3 <= t ? w.w : 0.f);
        *(LAS u32x2*)(WL + t * WL_PITCH + s0) = o; }
}
__device__ __forceinline__ void sgu_unit(const Ctx& c, const Args& a, int unit, int& gcur) {
    const bf16* Z = (const bf16*)(a.ws + WS_Z); bf16* MIX = (bf16*)(a.ws + WS_MIX);
    const int tid = c.tid, wid = c.wave, lane = c.lane, l32 = lane & 31, hi = lane >> 5;
    int g, r0, nt;
    if (unit < 1024) { g = unit & 15; r0 = (unit >> 4) * 128; nt = 4; } else { const int u2 = unit - 1024; g = u2 & 15; r0 = MP + (u2 >> 4) * 64; nt = 2; }
    LAS bf16* VT = (LAS bf16*)(c.lds + RING_OFF); const LAS bf16* WL = (const LAS bf16*)(c.lds + RING_OFF + WL_OFF);
    LAS float* lnt = (LAS float*)(c.lds + TAB_OFF);
    const int cc = tid & 31, col = g * 256 + cc * 8;
    u32x4 zv[8], zu[8];
#pragma unroll
    for (int i = 0; i < 8; ++i) if (i < 2 * nt) { const bf16* zp = Z + (size_t)(r0 + (tid >> 5) + 16 * i) * NGM + col; zv[i] = *(const u32x4*)(zp + D); zu[i] = *(const u32x4*)zp; }
    float gg[8], bb[8]; load8f(a.ln_g + col, gg); load8f(a.ln_b + col, bb);
    if (g != gcur) { sgu_load_w(c, a, g); gcur = g; }
    { const int row = tid >> 2, qd = tid & 3;
      if (row < 32 * nt) { const f32x4* p = (const f32x4*)((const float*)(a.ws + WS_LS) + ((size_t)(r0 + row) * 128 + qd * 32) * 2);
          f32x4 s4 = p[0];
#pragma unroll
          for (int j = 1; j < 16; ++j) s4 += p[j];
          float s1 = s4.x + s4.z, s2 = s4.y + s4.w; s1 += __shfl_xor(s1, 1); s2 += __shfl_xor(s2, 1); s1 += __shfl_xor(s1, 2); s2 += __shfl_xor(s2, 2);
          const float mean = s1 * (1.f / D), var = fmaxf(s2 * (1.f / D) - mean * mean, 0.f);
          if (qd == 0) { lnt[2 * row] = mean; lnt[2 * row + 1] = 1.0f / sqrtf(var + LN_EPS); } } }
    __syncthreads();
#pragma unroll
    for (int i = 0; i < 8; ++i) if (i < 2 * nt) { const int s = (tid >> 5) + 16 * i;
        float f[8]; unpack8(zv[i], f);
        const float mean = lnt[2 * s], rstd = lnt[2 * s + 1];
#pragma unroll
        for (int e = 0; e < 8; ++e) f[e] = (f[e] - mean) * rstd * gg[e] + bb[e];
        if (r0 >= MP) store8f(a.out + O_GV + (size_t)(r0 - MP + s) * D + col, f);
        const u32x4 v = pack8(f);
        LAS bf16* vt = VT + (cc * 8) * SG_PITCH + ((((s >> 3) ^ cc) & 15) << 3) + (s & 7);
        vt[0 * SG_PITCH] = (bf16)(v.x & 0xffffu); vt[1 * SG_PITCH] = (bf16)(v.x >> 16); vt[2 * SG_PITCH] = (bf16)(v.y & 0xffffu); vt[3 * SG_PITCH] = (bf16)(v.y >> 16);
        vt[4 * SG_PITCH] = (bf16)(v.z & 0xffffu); vt[5 * SG_PITCH] = (bf16)(v.z >> 16); vt[6 * SG_PITCH] = (bf16)(v.w & 0xffffu); vt[7 * SG_PITCH] = (bf16)(v.w >> 16); }
    __syncthreads();
    f32x16 acc[4];
#pragma unroll
    for (int tb = 0; tb < 4; ++tb)
#pragma unroll
        for (int r = 0; r < 16; ++r) acc[tb][r] = 0.f;
#pragma unroll
    for (int ks = 0; ks < 8; ++ks) {
        if (ks < 2 * nt) {
            const bf16x8 bfr = *(const LAS bf16x8*)(VT + (32 * wid + l32) * SG_PITCH + ((((2 * ks + hi) ^ ((32 * wid + l32) >> 3)) & 15) << 3));
#pragma unroll
            for (int tb = 0; tb < 4; ++tb) {
                if (tb >= (ks >> 1) && tb < nt) { const bf16x8 afr = *(const LAS bf16x8*)(WL + (32 * tb + l32) * WL_PITCH + 16 * ks + 8 * hi); acc[tb] = MFMA32(afr, bfr, acc[tb]); }
            }
        }
    }
    __syncthreads();
    LAS bf16* SO = (LAS bf16*)(c.lds + RING_OFF);
#pragma unroll
    for (int tb = 0; tb < 4; ++tb) {
        if (tb < nt) {
#pragma unroll
            for (int r = 0; r < 16; ++r) { const int t = 32 * tb + crow(r, hi);
                SO[t * SO_PITCH + 32 * wid + l32] = (bf16)(pk2(acc[tb][r] + a.b_s[g * 128 + t], 0.f) & 0xffffu); }
        }
    }
    __syncthreads();
#pragma unroll
    for (int i = 0; i < 8; ++i) if (i < 2 * nt) { const int t = (tid >> 5) + 16 * i;
        float sv[8], uv[8], o[8]; unpack8(*(const LAS u32x4*)(SO + t * SO_PITCH + cc * 8), sv); unpack8(zu[i], uv);
#pragma unroll
        for (int e = 0; e < 8; ++e) o[e] = sv[e] * uv[e];
        *(u32x4*)(MIX + (size_t)(r0 + t) * D + col) = pack8(o); }
    __syncthreads();
}
__global__ void __launch_bounds__(NTHR, 2) mk_fwd(Args a) {
    extern __shared__ __attribute__((aligned(16))) unsigned char lds[];
    Ctx c; c.lds = (LAS unsigned char*)lds; c.tid = threadIdx.x; c.lane = c.tid & 63; c.wave = __builtin_amdgcn_readfirstlane(c.tid >> 6);
    c.G = gridDim.x; { const int bx = blockIdx.x; c.vcu = (c.G % 8 == 0) ? (bx % 8) * (c.G / 8) + bx / 8 : bx; }
    volatile LAS unsigned* MISC = (volatile LAS unsigned*)(c.lds + MISC_OFF);
    for (int u = c.tid; u < (LDS_BYTES - LDSCTL_OFF) / 4; u += NTHR) ((LAS unsigned*)(c.lds + LDSCTL_OFF))[u] = 0u;
    __syncthreads();
    unsigned char* ws = a.ws;
    unsigned* ctl = (unsigned*)(ws + WS_CTL);
    XcdBarrier bar; bar.bar = ctl + CW_BAR; bar.x = 0; bar.st = nullptr;
    if (N_LAUNCHES == 1) bar = xcd_barrier_post(ctl + CW_BAR, MISC + 8);
#define GRID_BAR() do { if (N_LAUNCHES == 1) xcd_barrier(bar); } while (0)
    const int lo = a.ph_lo, hi = a.ph_hi;
#define IN(k) (lo <= (k) && (k) < hi)
#define BOTH(k) (IN(k) && IN((k) + 1))
    bf16* XN = (bf16*)(ws + WS_XN); bf16* PROJ = (bf16*)(ws + WS_PROJ); bf16* MIX = (bf16*)(ws + WS_MIX);
    bf16* UP = (bf16*)(ws + WS_UP); bf16* ACT = (bf16*)(ws + WS_ACT); bf16* Z = (bf16*)(ws + WS_Z);
    LAS unsigned char* ring = c.lds + RING_OFF;
    float* RS = (float*)(ws + WS_RS); pg8::f32x2* LS = (pg8::f32x2*)(ws + WS_LS); LAS float* tab = (LAS float*)(c.lds + TAB_OFF);
#define SKS(gi) (pg8::SkShare{(float*)(ws + WS_SLAB) + (size_t)((gi) & 1) * 256 * 65536, ctl + CW_SK + (gi) * 256 * 16, ctl})
    const int bx = (int)blockIdx.x;

    if (IN(0)) { phase_prologue(c, a); if (BOTH(0)) GRID_BAR(); }
    if (IN(1)) {
        pg8::Gemm g{XN, (const bf16*)(ws + WS_WIN), M, NPROJ, D}; pg8::SkOrder S; S.init(M, NPROJ, D, c.G, bx, false); pg8::EpiBf16<0, false, false> E{PROJ, NPROJ, nullptr, nullptr, nullptr, 0};
        pg8::gemm_phase<pg8::EpiBf16<0, false, false>, pg8::SkOrder, true, true>(ring, g, S, E, SKS(0));
        if (BOTH(1)) GRID_BAR(); }
    if (IN(2)) { phase_mix0(c, a); if (BOTH(2)) GRID_BAR(); }
    if (IN(3)) {
        pg8::Gemm g{MIX, (const bf16*)(ws + WS_WOUT), M, D, D}; pg8::SkOrder S; S.init(M, D, D, c.G, bx, false); pg8::EpiRes<true, true> E{a.x_p, a.x_s, XN, RS, D, MP};
        pg8::gemm_phase<pg8::EpiRes<true, true>, pg8::SkOrder, true, true>(ring, g, S, E, SKS(1));
        if (BOTH(3)) GRID_BAR(); }
    if (IN(5)) {
        pg8::Gemm g{XN, (const bf16*)(ws + WS_WUP), M, NUP, D}; pg8::SkOrder S; S.init(M, NUP, D, c.G, bx, false); S.bst = MK_BST; pg8::EpiConvGate E{ACT, RS, tab, (LAS bf16*)(c.lds + BND_OFF), a.conv_w_ffn + (size_t)0 * 3 * NUP, a.conv_b_ffn + (size_t)0 * NUP, a.st_ffn + (size_t)0 * 32 * 2 * NUP, (float*)(ws + WS_SIDE), a.out + O_FP + (size_t)0 * 4 * 2 * NUP, a.out + O_FS + (size_t)0 * 32 * 2 * NUP};
        pg8::gemm_phase<pg8::EpiConvGate, pg8::SkOrder, true, true>(ring, g, S, E, SKS(2));
        if (BOTH(5)) GRID_BAR(); }
    if (IN(6)) { phase_ffnfix(c, a, 0); if (BOTH(6)) GRID_BAR(); }
    if (IN(7)) {
        pg8::Gemm g{ACT, (const bf16*)(ws + WS_WDN), M, D, DFF}; pg8::SkOrder S; S.init(M, D, DFF, c.G, bx, true); pg8::EpiRes<false, true> E{nullptr, nullptr, XN, RS, D, MP};
        pg8::gemm_phase<pg8::EpiRes<false, true>, pg8::SkOrder, true, true>(ring, g, S, E, SKS(3));
        if (BOTH(7)) GRID_BAR(); }
    if (IN(9)) {
        pg8::Gemm g{XN, (const bf16*)(ws + WS_WINC), M, NGM, D}; pg8::SkOrder S; S.init(M, NGM, D, c.G, bx, false); pg8::EpiBf16<1, true, true> E{Z, NGM, RS, tab, LS, 16};
        pg8::gemm_phase<pg8::EpiBf16<1, true, true>, pg8::SkOrder, true, true>(ring, g, S, E, SKS(4));
        if (BOTH(9)) GRID_BAR(); }
    if (IN(11)) { int gcur = -1; for (int u = c.vcu; u < 1024 + 512; u += c.G) sgu_unit(c, a, u, gcur); if (BOTH(11)) GRID_BAR(); }
    if (IN(12)) {
        pg8::Gemm g{MIX, (const bf16*)(ws + WS_WOUTC), M, D, D}; pg8::SkOrder S; S.init(M, D, D, c.G, bx, false); pg8::EpiRes<false, true> E{nullptr, nullptr, XN, RS, D, MP};
        pg8::gemm_phase<pg8::EpiRes<false, true>, pg8::SkOrder, true, true>(ring, g, S, E, SKS(5));
        if (BOTH(12)) GRID_BAR(); }
    if (IN(14)) {
        pg8::Gemm g{XN, (const bf16*)(ws + WS_WUP) + (size_t)NUP * D, M, NUP, D}; pg8::SkOrder S; S.init(M, NUP, D, c.G, bx, false); S.bst = MK_BST; pg8::EpiConvGate E{ACT, RS, tab, (LAS bf16*)(c.lds + BND_OFF), a.conv_w_ffn + (size_t)1 * 3 * NUP, a.conv_b_ffn + (size_t)1 * NUP, a.st_ffn + (size_t)1 * 32 * 2 * NUP, (float*)(ws + WS_SIDE), a.out + O_FP + (size_t)1 * 4 * 2 * NUP, a.out + O_FS + (size_t)1 * 32 * 2 * NUP};
        pg8::gemm_phase<pg8::EpiConvGate, pg8::SkOrder, true, true>(ring, g, S, E, SKS(6));
        if (BOTH(14)) GRID_BAR(); }
    if (IN(15)) { phase_ffnfix(c, a, 1); if (BOTH(15)) GRID_BAR(); }
    if (IN(16)) {
        pg8::Gemm g{ACT, (const bf16*)(ws + WS_WDN) + (size_t)D * DFF, M, D, DFF}; pg8::SkOrder S; S.init(M, D, DFF, c.G, bx, true); pg8::EpiRes<false, true> E{nullptr, nullptr, XN, RS, D, MP};
        pg8::gemm_phase<pg8::EpiRes<false, true>, pg8::SkOrder, true, true>(ring, g, S, E, SKS(7));
        if (BOTH(16)) GRID_BAR(); }
    if (IN(17)) { phase_final(c, XN, RS, a.norm_final, a.out); }
#undef IN
#undef BOTH
}

extern "C" void kernel_launch(void* const* d_in, const int* in_sizes, int n_in, void* d_out, int out_size, void* d_ws, size_t ws_size, hipStream_t stream) {
    static int grid = 0;
    if (grid == 0) {
        if (n_in != 23 || in_sizes[0] != MP * D || (size_t)out_size != O_END || ws_size < WS_END) {
            fprintf(stderr, "kernel_launch: shape mismatch: n_in %d in0 %d out %d (want %zu) ws %zu (want %zu); nothing launched\n", n_in, n_in > 0 ? in_sizes[0] : -1, out_size, (size_t)O_END, ws_size, (size_t)WS_END); grid = -1; return; }
        int dev = 0, cus = 0, per_cu = 0;
        if (hipGetDevice(&dev) != hipSuccess || hipDeviceGetAttribute(&cus, hipDeviceAttributeMultiprocessorCount, dev) != hipSuccess) { grid = -1; return; }
        if (hipFuncSetAttribute((const void*)mk_fwd, hipFuncAttributeMaxDynamicSharedMemorySize, LDS_BYTES) != hipSuccess) { fprintf(stderr, "kernel_launch: hipFuncSetAttribute failed\n"); grid = -1; return; }
        if (hipOccupancyMaxActiveBlocksPerMultiprocessor(&per_cu, (const void*)mk_fwd, NTHR, LDS_BYTES) != hipSuccess || per_cu < 1) fprintf(stderr, "kernel_launch: occupancy query reports %d blocks per CU\n", per_cu);
        (void)hipGetLastError();
        grid = cus;
    }
    if (grid < 0) return;
    if (hipMemsetAsync((char*)d_ws + WS_CTL, 0, CTL_ZERO_BYTES, stream) != hipSuccess) { fprintf(stderr, "kernel_launch: memset failed\n"); return; }
    Args a{};
    const float* const* in = (const float* const*)d_in;
    a.x_p = in[0]; a.x_s = in[1]; a.st_conv = in[2]; a.cache_k = in[3]; a.cache_v = in[4]; a.st_ffn = in[5]; a.norm_mix = in[6]; a.norm_ffn = in[7]; a.norm_final = in[8]; a.w_in_ab = in[9];
    a.conv_w_a = in[10]; a.sinks = in[11]; a.w_out_ab = in[12]; a.w_in_c = in[13]; a.ln_g = in[14]; a.ln_b = in[15]; a.w_s = in[16]; a.b_s = in[17]; a.w_out_c = in[18]; a.w_up = in[19];
    a.conv_w_ffn = in[20]; a.conv_b_ffn = in[21]; a.w_down = in[22];
    a.out = (float*)d_out; a.ws = (unsigned char*)d_ws;
    for (int li = 0; li < N_LAUNCHES; ++li) {
        a.ph_lo = (N_LAUNCHES == 1) ? 0 : li; a.ph_hi = (N_LAUNCHES == 1) ? N_PHASES : li + 1;
        hipLaunchKernelGGL(mk_fwd, dim3(grid), dim3(NTHR), LDS_BYTES, stream, a);
        const hipError_t le = hipPeekAtLastError();
        if (le != hipSuccess) { fprintf(stderr, "kernel_launch: launch %d failed: %s\n", li, hipGetErrorName(le)); break; }
    }
}
```

```cpp
#include <hip/hip_runtime.h>
#include <cstdio>
#include <cstdint>
namespace pg8 {
#define PG8_LAS __attribute__((address_space(3)))
typedef unsigned short bf16_t;
typedef short bf16x8 __attribute__((ext_vector_type(8)));
typedef float f32x4 __attribute__((ext_vector_type(4)));
typedef unsigned u32x4 __attribute__((ext_vector_type(4)));
typedef unsigned u32x2 __attribute__((ext_vector_type(2)));
constexpr int BM = 256, BK = 64, HALF = 128, HTB = HALF * BK * 2  , STAGE_BYTES = 8 * HTB, NXCD = 8, WGM = 8;

__host__ __device__ __forceinline__ int lds_byte(int r, int c) { const int st = (r >> 4) * 2 + (c >> 5), rr = r & 15, cc = c & 31, ob = rr * 64 + cc * 2; return st * 1024 + (ob ^ (((ob >> 9) & 1) << 5)); }
__host__ __device__ __forceinline__ void stage_rc(int b, int& R, int& C) { const int st = b / 1024, sb = b % 1024, swz = sb ^ (((sb >> 9) & 1) << 5); R = (st >> 1) * 16 + swz / 64; C = (st & 1) * 32 + (swz % 64) / 2; }
__host__ __device__ __forceinline__ int perm32(int rho) { const int n = rho >> 4, i = rho & 15; return 8 * (i >> 2) + 4 * n + (i & 3); }

struct Unit { int pm, pn, k0, nt, role, par; };
struct Gemm { const bf16_t* A; const bf16_t* Bt; int M, N, K; };

struct SkOrder {
    int nM, nN, T, q, R, nDP, rem, xcd, rank, c; bool sk;
    __device__ __forceinline__ void init(int M, int N, int K, int G, int c_, bool gs = false, int Ra = 0) { gsync = gs; nM = M / BM; nN = N / BM; T = K / BK; q = (nM * nN) / NXCD; R = Ra > 0 ? Ra : G / NXCD; c = c_; xcd = c_ % NXCD; rank = c_ / NXCD;
        nDP = q / R; rem = q - nDP * R; sk = rem > 0 && 2 * rem <= R && (T % 4) == 0; }
    bool quad = false;
    bool gsync;
    __device__ __forceinline__ void unit_of(int id, Unit& u) const {
        if (quad) {
            const int x = id / q, j = id - x * q, b = x & 3, h = x >> 2, hr = nM / 2, r = j >> 5, jj = j & 31, full = hr >> 3;
            if (r < full) { u.pm = hr * h + 8 * r + (jj & 7); u.pn = 4 * b + (jj >> 3); } else { const int rest = hr - 8 * full; u.pm = hr * h + 8 * full + (jj % rest); u.pn = 4 * b + (jj / rest); } }
        else if (gsync) { const int x = id / q, j = id - x * q, gi = j / nN, ig = x * nN + (j - gi * nN); u.pm = gi * WGM + (ig & (WGM - 1)); u.pn = ig / WGM; }
        else { const int nig = WGM * nN, gid = id / nig, fm = gid * WGM, gsz = (nM - fm) < WGM ? (nM - fm) : WGM; u.pm = fm + ((id % nig) % gsz); u.pn = (id % nig) / gsz; } }
    __device__ __forceinline__ bool next(int i, Unit& u) const {
        if (rank >= R) return false;
        if (i < nDP) { unit_of(xcd * q + i * R + rank, u); u.k0 = 0; u.nt = T; u.role = 0; return true; }
        if (i > nDP) return false;
        if (sk) { if (rank >= 2 * rem) return false; unit_of(xcd * q + nDP * R + (rank >> 1), u); u.nt = T / 2; u.k0 = (rank & 1) * (T / 2); u.role = (rank & 1) ? 1 : 2; return true; }
        if (rank >= rem) return false;
        unit_of(xcd * q + nDP * R + rank, u); u.k0 = 0; u.nt = T; u.role = 0; return true;
    }
};
struct SkShare { float* slab; unsigned* flags; unsigned* tmo; };

__device__ __forceinline__ unsigned cvt_pk_bf16(float lo, float hi) { unsigned r; asm volatile("v_cvt_pk_bf16_f32 %0, %1, %2" : "=v"(r) : "v"(lo), "v"(hi)); return r; }
typedef float f32x2 __attribute__((ext_vector_type(2)));
__device__ __forceinline__ f32x2 gelu_pk(f32x2 v) {
    const f32x2 av = __builtin_elementwise_abs(v), d = av * 0.2316418882f + 1.0f;
    f32x2 t; t.x = __builtin_amdgcn_rcpf(d.x); t.y = __builtin_amdgcn_rcpf(d.y);
    f32x2 q = t * 0.5307027145f + (-0.7265760135f); q = q * t + 0.7107068705f; q = q * t + (-0.142248368f); q = q * t + 0.127414796f; q = q * t;
    const f32x2 s = (v * v) * (-0.72134752044f);
    f32x2 e; e.x = __builtin_amdgcn_exp2f(s.x); e.y = __builtin_amdgcn_exp2f(s.y);
    const f32x2 m = v * (q * e), r = v - m;
    f32x2 o; o.x = v.x < 0.f ? m.x : r.x; o.y = v.y < 0.f ? m.y : r.y; return o;
}

template <int ACT, bool RSTD, bool LNS> struct EpiBf16 {
    static constexpr bool PERM = true, AFTER_DRAIN = false, ONE_FINISH = false;
    bf16_t* O; int ldc; const float* rs; PG8_LAS float* tab; f32x2* ls; int lns_pn0;
    __device__ __forceinline__ void prep(const Unit& u, int tid) const {
        if constexpr (RSTD) {
            const int t_ = (int)threadIdx.x, row = t_ >> 1, h = t_ & 1; const f32x4* p = (const f32x4*)(rs + ((size_t)(u.pm * BM + row)) * 128 + h * 64);
            f32x4 s4 = p[0];
#pragma unroll
            for (int j = 1; j < 16; ++j) s4 += p[j];
            float s = (s4.x + s4.y) + (s4.z + s4.w); s += __shfl_xor(s, 1);
            if (h == 0) tab[u.par * BM + row] = 1.0f / sqrtf(s * (1.0f / 4096.0f) + 1e-6f);
        }
    }
    template <int MASK = 3> __device__ __forceinline__ void run(const f32x4 (&acc)[2][2][4][2], const Unit& u, int wr, int wc, int fr, int fq) const {
        const int row0 = u.pm * BM + wr * 64 + fr; const int col0 = u.pn * BM + wc * 32 + 8 * fq;
#pragma unroll
        for (int ai = 0; ai < 2; ++ai)
#pragma unroll
            for (int m = 0; m < 4; ++m) { const int row = row0 + ai * HALF + m * 16; bf16_t* rowp = O + (size_t)row * ldc + col0;
                float sc = 1.0f; if constexpr (RSTD) sc = tab[u.par * BM + wr * 64 + fr + ai * HALF + m * 16];
#pragma unroll
                for (int bj = 0; bj < 2; ++bj) { if (!((MASK >> bj) & 1)) continue; f32x4 v0 = acc[ai][bj][m][0] * sc, v1 = acc[ai][bj][m][1] * sc;
                    if (ACT == 1) { f32x2 a = gelu_pk((f32x2){v0[0], v0[1]}), b = gelu_pk((f32x2){v0[2], v0[3]}), c = gelu_pk((f32x2){v1[0], v1[1]}), d = gelu_pk((f32x2){v1[2], v1[3]});
                        v0 = (f32x4){a.x, a.y, b.x, b.y}; v1 = (f32x4){c.x, c.y, d.x, d.y}; }
                    u32x4 w; w.x = cvt_pk_bf16(v0[0], v0[1]); w.y = cvt_pk_bf16(v0[2], v0[3]); w.z = cvt_pk_bf16(v1[0], v1[1]); w.w = cvt_pk_bf16(v1[2], v1[3]);
                    *(u32x4*)(rowp + bj * HALF) = w;
                    if constexpr (LNS) { if (u.pn >= lns_pn0) {
                        float s1 = ((v0[0] + v0[1]) + (v0[2] + v0[3])) + ((v1[0] + v1[1]) + (v1[2] + v1[3]));
                        float s2 = ((v0[0] * v0[0] + v0[1] * v0[1]) + (v0[2] * v0[2] + v0[3] * v0[3])) + ((v1[0] * v1[0] + v1[1] * v1[1]) + (v1[2] * v1[2] + v1[3] * v1[3]));
                        s1 += __shfl_xor(s1, 16); s2 += __shfl_xor(s2, 16); s1 += __shfl_xor(s1, 32); s2 += __shfl_xor(s2, 32);
                        if (fq == 0) ls[(size_t)row * 128 + (u.pn - lns_pn0) * 8 + wc * 2 + bj] = (f32x2){s1, s2}; } }
                } }
    }
};
template <bool BASEF32, bool STATS> struct EpiRes {
    static constexpr bool PERM = true, AFTER_DRAIN = false, ONE_FINISH = false;
    const float* bp; const float* bs; bf16_t* xn; float* rs; int ld; int split;
    __device__ __forceinline__ void prep(const Unit&, int) const {}
    template <int MASK = 3> __device__ __forceinline__ void run(const f32x4 (&acc)[2][2][4][2], const Unit& u, int wr, int wc, int fr, int fq) const {
        const int row0 = u.pm * BM + wr * 64 + fr, col0 = u.pn * BM + wc * 32 + 8 * fq;
#pragma unroll
        for (int ai = 0; ai < 2; ++ai) {
            f32x4 b[4][2][2];
#pragma unroll
            for (int m = 0; m < 4; ++m) { const int row = row0 + ai * HALF + m * 16;
#pragma unroll
                for (int bj = 0; bj < 2; ++bj) { if (!((MASK >> bj) & 1)) continue;
                    if constexpr (BASEF32) { const float* br = (row < split ? bp + (size_t)row * ld : bs + (size_t)(row - split) * ld) + col0 + bj * HALF; b[m][bj][0] = *(const f32x4*)br; b[m][bj][1] = *(const f32x4*)(br + 4); }
                    else { const u32x4 w = *(const u32x4*)(xn + (size_t)row * ld + col0 + bj * HALF);
                        b[m][bj][0] = (f32x4){__uint_as_float(w.x << 16), __uint_as_float(w.x & 0xffff0000u), __uint_as_float(w.y << 16), __uint_as_float(w.y & 0xffff0000u)};
                        b[m][bj][1] = (f32x4){__uint_as_float(w.z << 16), __uint_as_float(w.z & 0xffff0000u), __uint_as_float(w.w << 16), __uint_as_float(w.w & 0xffff0000u)}; } } }
            asm volatile("" ::: "memory");
#pragma unroll
            for (int m = 0; m < 4; ++m) { const int row = row0 + ai * HALF + m * 16;
#pragma unroll
                for (int bj = 0; bj < 2; ++bj) { if (!((MASK >> bj) & 1)) continue;
                    const f32x4 o0 = b[m][bj][0] + acc[ai][bj][m][0], o1 = b[m][bj][1] + acc[ai][bj][m][1];
                    u32x4 w; w.x = cvt_pk_bf16(o0[0], o0[1]); w.y = cvt_pk_bf16(o0[2], o0[3]); w.z = cvt_pk_bf16(o1[0], o1[1]); w.w = cvt_pk_bf16(o1[2], o1[3]);
                    *(u32x4*)(xn + (size_t)row * ld + col0 + bj * HALF) = w;
                    if constexpr (STATS) {
                        float ss = ((o0[0] * o0[0] + o0[1] * o0[1]) + (o0[2] * o0[2] + o0[3] * o0[3])) + ((o1[0] * o1[0] + o1[1] * o1[1]) + (o1[2] * o1[2] + o1[3] * o1[3]));
                        ss += __shfl_xor(ss, 16); ss += __shfl_xor(ss, 32);
                        if (fq == 0) rs[(size_t)row * 128 + u.pn * 8 + wc * 2 + bj] = ss; }
                } }
            asm volatile("" ::: "memory");
        }
    }
};

struct EpiConvGate {
    static constexpr bool PERM = true, AFTER_DRAIN = false, ONE_FINISH = true;
    bf16_t* act; const float* rs; PG8_LAS float* tab; PG8_LAS bf16_t* bnd; const float* cw; const float* cb; const float* st; float* side; float* out_p; float* out_s;
    static constexpr int NUPC = 22016, DFFC = 11008, MPT = 32;
    __device__ __forceinline__ void prep(const Unit& u, int tid) const {
        const int t_ = (int)threadIdx.x, row = t_ >> 1, h = t_ & 1; const f32x4* p = (const f32x4*)(rs + ((size_t)(u.pm * BM + row)) * 128 + h * 64);
        f32x4 s4 = p[0];
#pragma unroll
        for (int j = 1; j < 16; ++j) s4 += p[j];
        float s = (s4.x + s4.y) + (s4.z + s4.w); s += __shfl_xor(s, 1);
        if (h == 0) tab[u.par * BM + row] = 1.0f / sqrtf(s * (1.0f / 4096.0f) + 1e-6f);
    }
    static __device__ __forceinline__ float dpp_shr1(float old, float v) { return __builtin_bit_cast(float, __builtin_amdgcn_update_dpp(__builtin_bit_cast(int, old), __builtin_bit_cast(int, v), 0x111, 0xf, 0xf, false)); }
    static __device__ __forceinline__ float dpp_shr2(float old, float v) { return __builtin_bit_cast(float, __builtin_amdgcn_update_dpp(__builtin_bit_cast(int, old), __builtin_bit_cast(int, v), 0x112, 0xf, 0xf, false)); }
    static __device__ __forceinline__ float dpp_ror1(float v) { return __builtin_bit_cast(float, __builtin_amdgcn_update_dpp(0, __builtin_bit_cast(int, v), 0x121, 0xf, 0xf, false)); }
    static __device__ __forceinline__ float dpp_ror2(float v) { return __builtin_bit_cast(float, __builtin_amdgcn_update_dpp(0, __builtin_bit_cast(int, v), 0x122, 0xf, 0xf, false)); }
    static __device__ __forceinline__ f32x4 bf4(unsigned lo, unsigned hi) { return (f32x4){__uint_as_float(lo << 16), __uint_as_float(lo & 0xffff0000u), __uint_as_float(hi << 16), __uint_as_float(hi & 0xffff0000u)}; }
    template <class T> static __device__ __forceinline__ T* at(const void* base, unsigned off) { return (T*)((const char*)base + off); }
    static __device__ __forceinline__ void taps(const f32x4& cv, const f32x4& f1, const f32x4& f2, f32x4& p1, f32x4& p2) {
#pragma unroll
        for (int e = 0; e < 4; ++e) { p1[e] = dpp_shr1(f1[e], cv[e]); p2[e] = dpp_shr2(f2[e], cv[e]); } }
    template <int AH> __device__ __forceinline__ void half_pass(const f32x4 (&acc)[2][2][4][2], const Unit& u, int wr, int fr, int lcol8, int lch, bool smp, bool seq0, int bj) const {
        const unsigned o_act = (unsigned)(fr * DFFC + lch) * 2u, o_w = (unsigned)lch * 4u;
        const unsigned o_row = (unsigned)((fr < 2 ? fr : fr - 12) * NUPC + lch) * 4u;
        const unsigned o_st = (unsigned)((fr - 14) * NUPC + lch) * 4u;
        const int cg = u.pn * 128 + 64 * bj, cu = cg + DFFC;
        const f32x4 wg0 = *at<const f32x4>(cw + cg, o_w), wg1 = *at<const f32x4>(cw + NUPC + cg, o_w), wg2 = *at<const f32x4>(cw + 2 * NUPC + cg, o_w), bg = *at<const f32x4>(cb + cg, o_w);
        const f32x4 wu0 = *at<const f32x4>(cw + cu, o_w), wu1 = *at<const f32x4>(cw + NUPC + cu, o_w), wu2 = *at<const f32x4>(cw + 2 * NUPC + cu, o_w), bu = *at<const f32x4>(cb + cu, o_w);
#pragma unroll
        for (int ai = 0; ai < 2; ++ai) { f32x4 pvg = (f32x4){0.f, 0.f, 0.f, 0.f}, pvu = pvg;
#pragma unroll
            for (int m = 0; m < 4; ++m) { const int rtu = ai * HALF + wr * 64 + m * 16, g16 = ai * 8 + wr * 4 + m;
                const float sc = tab[u.par * BM + rtu + fr];
                const bool deferred = !smp && !seq0 && g16 == 0 && fr < 2;
                const f32x4 vg_raw = acc[ai][AH][m][0] * sc, vu_raw = acc[ai][AH][m][1] * sc;
                f32x4 f1g, f2g, f1u, f2u;
                if (m == 0) { f32x4 q14g, q15g, q14u, q15u;
                    if (smp || g16 == 0) {
                        if (smp) { const float* sp = st + ((size_t)(((u.pm - MPT) * 4 + (g16 >> 2)) * 2)) * NUPC; q14g = *at<const f32x4>(sp + cg, o_w); q15g = *at<const f32x4>(sp + NUPC + cg, o_w); q14u = *at<const f32x4>(sp + cu, o_w); q15u = *at<const f32x4>(sp + NUPC + cu, o_w); }
                        else { q14g = (f32x4){0.f, 0.f, 0.f, 0.f}; q15g = q14g; q14u = q14g; q15u = q14g; }
                    } else { typedef unsigned u32x4a __attribute__((ext_vector_type(4), may_alias));
                        const PG8_LAS bf16_t* bp = bnd + (((g16 - 1) * 2) * 2 + bj) * 128 + lcol8;
                        const u32x4a a14 = *(const PG8_LAS u32x4a*)(bp), a15 = *(const PG8_LAS u32x4a*)(bp + 256);
                        q14g = bf4(a14.x, a14.y); q14u = bf4(a14.z, a14.w); q15g = bf4(a15.x, a15.y); q15u = bf4(a15.z, a15.w); }
                    f1g = q15g; f1u = q15u;
#pragma unroll
                    for (int e = 0; e < 4; ++e) { f2g[e] = fr == 0 ? q14g[e] : q15g[e]; f2u[e] = fr == 0 ? q14u[e] : q15u[e]; }
                } else {
#pragma unroll
                    for (int e = 0; e < 4; ++e) { f1g[e] = dpp_ror1(pvg[e]); f2g[e] = dpp_ror2(pvg[e]); f1u[e] = dpp_ror1(pvu[e]); f2u[e] = dpp_ror2(pvu[e]); } }
                f32x4 p1, p2; taps(vg_raw, f1g, f2g, p1, p2);
                const f32x4 vg = wg0 * p2 + wg1 * p1 + wg2 * vg_raw + bg;
                taps(vu_raw, f1u, f2u, p1, p2);
                const f32x4 vu = wu0 * p2 + wu1 * p1 + wu2 * vu_raw + bu;
                if (!deferred) { f32x4 o;
#pragma unroll
                    for (int e = 0; e < 4; ++e) o[e] = vg[e] * __builtin_amdgcn_rcpf(1.0f + __expf(-vg[e])) * vu[e];
                    f32x2 w; w.x = __builtin_bit_cast(float, cvt_pk_bf16(o[0], o[1])); w.y = __builtin_bit_cast(float, cvt_pk_bf16(o[2], o[3]));
                    *at<f32x2>(act + ((size_t)(u.pm * BM + rtu)) * DFFC + cg, o_act) = w; }
                if (!smp) {
                    if ((g16 == 0 && fr < 2) || (g16 == 15 && fr >= 14)) { float* sp = side + ((size_t)(u.pm * 4)) * NUPC; *at<f32x4>(sp + cg, o_row) = vg_raw; *at<f32x4>(sp + cu, o_row) = vu_raw; }
                    if (g16 == 15 && fr >= 14 && (u.pm & 7) == 7) { float* op = out_p + ((size_t)((u.pm >> 3) * 2)) * NUPC; *at<f32x4>(op + cg, o_st) = vg_raw; *at<f32x4>(op + cu, o_st) = vu_raw; }
                } else if (m == 3 && fr >= 14) { float* op = out_s + ((size_t)(((u.pm - MPT) * 4 + (g16 >> 2)) * 2)) * NUPC; *at<f32x4>(op + cg, o_st) = vg_raw; *at<f32x4>(op + cu, o_st) = vu_raw; }
                pvg = vg_raw; pvu = vu_raw;
                asm volatile("" ::: "memory");
            }
        }
    }
    template <int AH> __device__ __forceinline__ void image(const f32x4 (&acc)[2][2][4][2], const Unit& u, int wr, int fr, int lcol8, int bj) const {
#pragma unroll
        for (int ai = 0; ai < 2; ++ai) { constexpr int m = 3; const float sc = tab[u.par * BM + ai * HALF + wr * 64 + m * 16 + fr]; const int g16 = ai * 8 + wr * 4 + m;
            if (fr >= 14) { const f32x4 v0 = acc[ai][AH][m][0] * sc, v1 = acc[ai][AH][m][1] * sc;
                u32x4 w; w.x = cvt_pk_bf16(v0[0], v0[1]); w.y = cvt_pk_bf16(v0[2], v0[3]); w.z = cvt_pk_bf16(v1[0], v1[1]); w.w = cvt_pk_bf16(v1[2], v1[3]);
                typedef unsigned u32x4a __attribute__((ext_vector_type(4), may_alias)); *(PG8_LAS u32x4a*)(bnd + ((g16 * 2 + (fr - 14)) * 2 + bj) * 128 + lcol8) = w; } }
    }
    template <int MASK = 3> __device__ __forceinline__ void run(const f32x4 (&acc)[2][2][4][2], const Unit& u, int wr, int wc, int fr_, int fq_) const {
        int fr = fr_, fq = fq_; asm volatile("" : "+v"(fr), "+v"(fq));
        const int lcol8 = wc * 32 + 8 * fq, lch = wc * 16 + 4 * fq;
        const bool smp = u.pm >= MPT, seq0 = !smp && (u.pm & 7) == 0;
        image<0>(acc, u, wr, fr, lcol8, 0); image<1>(acc, u, wr, fr, lcol8, 1);
        asm volatile("s_waitcnt lgkmcnt(0)" ::: "memory"); __builtin_amdgcn_s_barrier(); asm volatile("" ::: "memory");
        half_pass<0>(acc, u, wr, fr, lcol8, lch, smp, seq0, 0);
        half_pass<1>(acc, u, wr, fr, lcol8, lch, smp, seq0, 1);
    }
    __device__ __forceinline__ void run_half(const f32x4 (&acc)[2][2][4][2], const Unit& u, int wr, int wc, int fr_, int fq_, int bj) const {
        int fr = fr_, fq = fq_; asm volatile("" : "+v"(fr), "+v"(fq));
        const int lcol8 = wc * 32 + 8 * fq, lch = wc * 16 + 4 * fq;
        const bool smp = u.pm >= MPT, seq0 = !smp && (u.pm & 7) == 0;
        image<0>(acc, u, wr, fr, lcol8, bj);
        asm volatile("s_waitcnt lgkmcnt(0)" ::: "memory"); __builtin_amdgcn_s_barrier(); asm volatile("" ::: "memory");
        half_pass<0>(acc, u, wr, fr, lcol8, lch, smp, seq0, bj);
    }
};

template <int MY, class Epi>
__device__ __forceinline__ void sk_finish(f32x4 (&acc)[2][2][4][2], const Unit& cur, int me, int pc, const SkShare& sk, const Epi& E, int tid, int lane, int wr, int wc, int fr, int fq) {
    int tid2 = tid; asm volatile("" : "+v"(tid2));
    const __amdgpu_buffer_rsrc_t rs = __builtin_amdgcn_make_buffer_rsrc(sk.slab + (size_t)me * 65536, 0, 262144, 0x00020000);
#pragma unroll
    for (int a = 0; a < 2; ++a)
#pragma unroll
        for (int m = 0; m < 4; ++m)
#pragma unroll
            for (int n = 0; n < 2; ++n) __builtin_amdgcn_raw_buffer_store_b128(__builtin_bit_cast(u32x4, acc[a][1 - MY][m][n]), rs, (unsigned)(((a * 4 + m) * 2 + n) * 512 + tid2) * 16u, 0, 16);
    asm volatile("s_waitcnt vmcnt(0)" ::: "memory");
    if (lane == 0) __hip_atomic_fetch_add(sk.flags + 16 * me, 1u, __ATOMIC_RELAXED, __HIP_MEMORY_SCOPE_AGENT);
    unsigned spins = 0;
    while ((unsigned)__builtin_amdgcn_readfirstlane(__hip_atomic_load(sk.flags + 16 * pc, __ATOMIC_RELAXED, __HIP_MEMORY_SCOPE_AGENT)) < 8u) {
        __builtin_amdgcn_s_sleep(1);
        if ((++spins & 255u) == 0u) { if (__builtin_amdgcn_readfirstlane(__hip_atomic_load(sk.tmo, __ATOMIC_RELAXED, __HIP_MEMORY_SCOPE_AGENT)) != 0u) break;
            if (spins > (1u << 20)) { if (lane == 0) __hip_atomic_store(sk.tmo, 1u, __ATOMIC_RELAXED, __HIP_MEMORY_SCOPE_AGENT); break; } } }
    __builtin_amdgcn_fence(__ATOMIC_ACQUIRE, "agent");
    asm volatile("s_waitcnt vmcnt(0)" ::: "memory");
    const f32x4* sp = (const f32x4*)(sk.slab + (size_t)pc * 65536) + tid2;
#pragma unroll
    for (int a = 0; a < 2; ++a) {
        f32x4 p[8];
#pragma unroll
        for (int j = 0; j < 8; ++j) p[j] = sp[(a * 8 + j) * 512];
#pragma unroll
        for (int m = 0; m < 4; ++m) { acc[a][MY][m][0] += p[2 * m]; acc[a][MY][m][1] += p[2 * m + 1]; }
        asm volatile("" : "+v"(acc[a][MY][0][0]), "+v"(acc[a][MY][0][1]), "+v"(acc[a][MY][1][0]), "+v"(acc[a][MY][1][1]), "+v"(acc[a][MY][2][0]), "+v"(acc[a][MY][2][1]), "+v"(acc[a][MY][3][0]), "+v"(acc[a][MY][3][1]) :: "memory"); }
    E.template run<(1 << MY)>(acc, cur, wr, wc, fr, fq);
}
__device__ __forceinline__ void sk_exchange(f32x4 (&acc)[2][2][4][2], int me, int pc, const SkShare& sk, int tid, int lane) {
    int tid2 = tid; asm volatile("" : "+v"(tid2));
    const __amdgpu_buffer_rsrc_t rs = __builtin_amdgcn_make_buffer_rsrc(sk.slab + (size_t)me * 65536, 0, 262144, 0x00020000);
#pragma unroll
    for (int a = 0; a < 2; ++a)
#pragma unroll
        for (int m = 0; m < 4; ++m)
#pragma unroll
            for (int n = 0; n < 2; ++n) __builtin_amdgcn_raw_buffer_store_b128(__builtin_bit_cast(u32x4, acc[a][1][m][n]), rs, (unsigned)(((a * 4 + m) * 2 + n) * 512 + tid2) * 16u, 0, 16);
    asm volatile("s_waitcnt vmcnt(0)" ::: "memory");
    if (lane == 0) __hip_atomic_fetch_add(sk.flags + 16 * me, 1u, __ATOMIC_RELAXED, __HIP_MEMORY_SCOPE_AGENT);
    unsigned spins = 0;
    while ((unsigned)__builtin_amdgcn_readfirstlane(__hip_atomic_load(sk.flags + 16 * pc, __ATOMIC_RELAXED, __HIP_MEMORY_SCOPE_AGENT)) < 8u) {
        __builtin_amdgcn_s_sleep(1);
        if ((++spins & 255u) == 0u) { if (__builtin_amdgcn_readfirstlane(__hip_atomic_load(sk.tmo, __ATOMIC_RELAXED, __HIP_MEMORY_SCOPE_AGENT)) != 0u) break;
            if (spins > (1u << 20)) { if (lane == 0) __hip_atomic_store(sk.tmo, 1u, __ATOMIC_RELAXED, __HIP_MEMORY_SCOPE_AGENT); break; } } }
    __builtin_amdgcn_fence(__ATOMIC_ACQUIRE, "agent");
    asm volatile("s_waitcnt vmcnt(0)" ::: "memory");
    const f32x4* sp = (const f32x4*)(sk.slab + (size_t)pc * 65536) + tid2;
#pragma unroll
    for (int a = 0; a < 2; ++a)
#pragma unroll
        for (int mm = 0; mm < 4; mm += 2) {
            const f32x4 p0 = sp[(a * 8 + 2 * mm + 0) * 512], p1 = sp[(a * 8 + 2 * mm + 1) * 512], p2 = sp[(a * 8 + 2 * mm + 2) * 512], p3 = sp[(a * 8 + 2 * mm + 3) * 512];
            acc[a][0][mm][0] += p0; acc[a][0][mm][1] += p1; acc[a][0][mm + 1][0] += p2; acc[a][0][mm + 1][1] += p3;
            asm volatile("" : "+v"(acc[a][0][mm][0]), "+v"(acc[a][0][mm][1]), "+v"(acc[a][0][mm + 1][0]), "+v"(acc[a][0][mm + 1][1]) :: "memory"); }
}
template <class Epi, class Sched, bool ALIGN_EPI = false, bool SP2 = false>
__device__ __forceinline__ void gemm_phase(PG8_LAS unsigned char* lds, const Gemm g, Sched& S, const Epi& E, const SkShare sk) {
    const int tid = threadIdx.x, wid = __builtin_amdgcn_readfirstlane(tid >> 6), lane = tid & 63, wr = wid >> 2, wc = wid & 3, fr = lane & 15, fq = lane >> 4;
    const int K = g.K;
    unsigned voffA[2], voffB[2];
#pragma unroll
    for (int i = 0; i < 2; ++i) { int R, C; stage_rc(tid * 16 + i * 8192, R, C); const int Rb = Epi::PERM ? ((R & ~31) + perm32(R & 31)) : R;
        voffA[i] = (unsigned)(R * K + C) * 2u; voffB[i] = (unsigned)(Rb * K + C) * 2u; }
    const size_t kstep = (size_t)(BK * 2);
    const size_t hstep = (size_t)HALF * K * 2;
    const size_t tstep = 2 * hstep;
    const unsigned ldsw = (unsigned)wid * 1024u;
    const int aoff = lds_byte(wr * 64 + fr, fq * 8), boff = lds_byte(wc * 32 + fr, fq * 8);
#define PG8_SA(b, h) (((b) * 2 + (h)) * HTB)
#define PG8_SB(b, h) ((4 + (b) * 2 + (h)) * HTB)
#define PG8_STAGE(bufoff, gbase, voff) do { _Pragma("unroll") for (int _i = 0; _i < 2; ++_i) \
        __builtin_amdgcn_global_load_lds((const unsigned*)((const char*)(gbase) + (voff)[_i]), (PG8_LAS unsigned*)(lds + (bufoff) + ldsw + _i * 8192), 16, 0, 0); } while (0)
#define PG8_LDA(dst, b, h) do { _Pragma("unroll") for (int m = 0; m < 4; ++m) _Pragma("unroll") for (int k = 0; k < 2; ++k) dst[m][k] = *(const PG8_LAS bf16x8*)(lds + PG8_SA(b, h) + aoff + m * 2048 + k * 1024); } while (0)
#define PG8_LDB(dst, b, h) do { _Pragma("unroll") for (int n = 0; n < 2; ++n) _Pragma("unroll") for (int k = 0; k < 2; ++k) dst[n][k] = *(const PG8_LAS bf16x8*)(lds + PG8_SB(b, h) + boff + n * 2048 + k * 1024); } while (0)
#define PG8_MMA(ai, bj, At, Bt) do { __builtin_amdgcn_s_setprio(1); _Pragma("unroll") for (int m = 0; m < 4; ++m) _Pragma("unroll") for (int n = 0; n < 2; ++n) _Pragma("unroll") for (int k = 0; k < 2; ++k) \
        acc[ai][bj][m][n] = __builtin_amdgcn_mfma_f32_16x16x32_bf16(Bt[n][k], At[m][k], acc[ai][bj][m][n], 0, 0, 0); __builtin_amdgcn_s_setprio(0); } while (0)
#define PG8_WAIT_V(n) asm volatile("s_waitcnt vmcnt(" #n ")" ::: "memory")
#define PG8_WAIT_L(n) asm volatile("s_waitcnt lgkmcnt(" #n ")" ::: "memory")
#define PG8_BAR __builtin_amdgcn_s_barrier()
#define PG8_SCHED __builtin_amdgcn_sched_barrier(0)
    Unit cur, nxt; int ui = 0;
    if (!S.next(0, cur)) return;
    cur.par = 0; E.prep(cur, tid);
    f32x4 acc[2][2][4][2];
#pragma unroll
    for (int a = 0; a < 2; ++a)
#pragma unroll
        for (int b = 0; b < 2; ++b)
#pragma unroll
            for (int m = 0; m < 4; ++m)
#pragma unroll
                for (int n = 0; n < 2; ++n) acc[a][b][m][n] = (f32x4){0.f, 0.f, 0.f, 0.f};
    bf16x8 At[4][2], B0[2][2], B1[2][2];
    const char* cA = (const char*)g.A + (size_t)cur.pm * tstep + (size_t)cur.k0 * kstep; const char* cB = (const char*)g.Bt + (size_t)cur.pn * tstep + (size_t)cur.k0 * kstep;
    if constexpr (SP2) {
        PG8_STAGE(PG8_SB(0, 0), cB, voffB); PG8_STAGE(PG8_SB(0, 1), cB + hstep, voffB); PG8_STAGE(PG8_SA(0, 0), cA, voffA); PG8_STAGE(PG8_SA(0, 1), cA + hstep, voffA);
        if (wr == 1) PG8_BAR;
        PG8_WAIT_V(2); PG8_BAR;
        PG8_STAGE(PG8_SB(1, 0), cB + kstep, voffB); PG8_STAGE(PG8_SA(1, 0), cA + kstep, voffA); PG8_STAGE(PG8_SB(1, 1), cB + hstep + kstep, voffB);
        PG8_WAIT_V(6); PG8_BAR;
    } else {
        PG8_STAGE(PG8_SB(0, 0), cB, voffB); PG8_STAGE(PG8_SA(0, 0), cA, voffA); PG8_STAGE(PG8_SB(0, 1), cB + hstep, voffB); PG8_STAGE(PG8_SA(0, 1), cA + hstep, voffA);
        if (wr == 1) PG8_BAR;
        PG8_WAIT_V(4); PG8_BAR;
        PG8_STAGE(PG8_SB(1, 0), cB + kstep, voffB); PG8_STAGE(PG8_SA(1, 0), cA + kstep, voffA); PG8_STAGE(PG8_SB(1, 1), cB + hstep + kstep, voffB);
        PG8_WAIT_V(6); PG8_BAR;
    }
    for (;;) {
        const bool has_next = S.next(ui + 1, nxt); nxt.par = (has_next && nxt.pm != cur.pm) ? (cur.par ^ 1) : cur.par;
        const char* nA = has_next ? (const char*)g.A + (size_t)nxt.pm * tstep + (size_t)nxt.k0 * kstep : cA; const char* nB = has_next ? (const char*)g.Bt + (size_t)nxt.pn * tstep + (size_t)nxt.k0 * kstep : cB;
        const int nt = cur.nt;
        for (int t = 0; t < nt; t += 2) {
            const bool last = (t == nt - 2);
            const char* a1 = cA + (size_t)(t + 1) * kstep;
            const char* a2 = last ? nA : cA + (size_t)(t + 2) * kstep; const char* b2 = last ? nB : cB + (size_t)(t + 2) * kstep;
            const char* a3 = a2 + kstep; const char* b3 = b2 + kstep;
            if constexpr (SP2) {
            PG8_LDB(B0, 0, 0); PG8_LDB(B1, 0, 1); PG8_SCHED; PG8_LDA(At, 0, 0); PG8_STAGE(PG8_SA(1, 1), a1 + hstep, voffA);
            PG8_WAIT_V(8); PG8_WAIT_L(0); PG8_BAR; PG8_MMA(0, 0, At, B0); PG8_MMA(0, 1, At, B1); PG8_BAR; PG8_SCHED;
            PG8_LDA(At, 0, 1); PG8_STAGE(PG8_SB(0, 0), b2, voffB); PG8_STAGE(PG8_SB(0, 1), b2 + hstep, voffB); PG8_STAGE(PG8_SA(0, 0), a2, voffA);
            PG8_WAIT_V(8); PG8_WAIT_L(0); PG8_BAR; PG8_MMA(1, 0, At, B0); PG8_MMA(1, 1, At, B1); PG8_BAR; PG8_SCHED;
            PG8_LDB(B0, 1, 0); PG8_LDB(B1, 1, 1); PG8_SCHED; PG8_LDA(At, 1, 0); PG8_STAGE(PG8_SA(0, 1), a2 + hstep, voffA);
            PG8_WAIT_V(8); PG8_WAIT_L(0); PG8_BAR; PG8_MMA(0, 0, At, B0); PG8_MMA(0, 1, At, B1); PG8_BAR; PG8_SCHED;
            PG8_LDA(At, 1, 1); PG8_STAGE(PG8_SB(1, 0), b3, voffB); PG8_STAGE(PG8_SB(1, 1), b3 + hstep, voffB); PG8_STAGE(PG8_SA(1, 0), a3, voffA);
            PG8_WAIT_V(8); PG8_WAIT_L(0); PG8_BAR; PG8_MMA(1, 0, At, B0); PG8_MMA(1, 1, At, B1); PG8_BAR; PG8_SCHED;
            } else {
            PG8_LDB(B0, 0, 0); PG8_SCHED; PG8_LDA(At, 0, 0); PG8_STAGE(PG8_SA(1, 1), a1 + hstep, voffA);
            PG8_WAIT_L(8); PG8_BAR; PG8_WAIT_L(0); PG8_MMA(0, 0, At, B0); PG8_BAR; PG8_SCHED;
            PG8_LDB(B1, 0, 1); PG8_STAGE(PG8_SB(0, 0), b2, voffB);
            PG8_BAR; PG8_WAIT_L(0); PG8_MMA(0, 1, At, B1); PG8_BAR;
            PG8_LDA(At, 0, 1); PG8_STAGE(PG8_SA(0, 0), a2, voffA);
            PG8_BAR; PG8_WAIT_L(0); PG8_MMA(1, 0, At, B0); PG8_BAR; PG8_SCHED;
            PG8_STAGE(PG8_SB(0, 1), b2 + hstep, voffB);
            PG8_WAIT_V(6); PG8_BAR; PG8_MMA(1, 1, At, B1); PG8_BAR;
            PG8_LDB(B0, 1, 0); PG8_SCHED; PG8_LDA(At, 1, 0); PG8_STAGE(PG8_SA(0, 1), a2 + hstep, voffA);
            PG8_WAIT_L(8); PG8_BAR; PG8_WAIT_L(0); PG8_MMA(0, 0, At, B0); PG8_BAR; PG8_SCHED;
            PG8_LDB(B1, 1, 1); PG8_STAGE(PG8_SB(1, 0), b3, voffB);
            PG8_BAR; PG8_WAIT_L(0); PG8_MMA(0, 1, At, B1); PG8_BAR;
            PG8_LDA(At, 1, 1); PG8_STAGE(PG8_SA(1, 0), a3, voffA);
            PG8_BAR; PG8_WAIT_L(0); PG8_MMA(1, 0, At, B0); PG8_BAR; PG8_SCHED;
            PG8_STAGE(PG8_SB(1, 1), b3 + hstep, voffB);
            PG8_WAIT_V(6); PG8_BAR; PG8_MMA(1, 1, At, B1); PG8_BAR;
            }
        }
        if constexpr (ALIGN_EPI) { if (wr == 0) PG8_BAR; }
        if (cur.role != 0) break;
        E.template run<3>(acc, cur, wr, wc, fr, fq);
        if (!has_next) break;
        if (nxt.pm != cur.pm) E.prep(nxt, tid);
#pragma unroll
        for (int a = 0; a < 2; ++a)
#pragma unroll
            for (int b = 0; b < 2; ++b)
#pragma unroll
                for (int m = 0; m < 4; ++m)
#pragma unroll
                    for (int n = 0; n < 2; ++n) acc[a][b][m][n] = (f32x4){0.f, 0.f, 0.f, 0.f};
        cur = nxt; cA = nA; cB = nB; ++ui;
        if constexpr (ALIGN_EPI) { if (wr == 1) PG8_BAR; }
    }
    PG8_WAIT_V(0);
    if constexpr (!ALIGN_EPI) { if (wr == 0) PG8_BAR; }
    PG8_BAR;
    if constexpr (Epi::ONE_FINISH) {
        if (cur.role != 0) { const int my = cur.role == 2 ? 0 : 1;
            if (my == 1) {
#pragma unroll
                for (int a = 0; a < 2; ++a)
#pragma unroll
                    for (int m = 0; m < 4; ++m)
#pragma unroll
                        for (int n = 0; n < 2; ++n) { const f32x4 t = acc[a][0][m][n]; acc[a][0][m][n] = acc[a][1][m][n]; acc[a][1][m][n] = t; } }
            sk_exchange(acc, S.c, my == 0 ? S.c + NXCD : S.c - NXCD, sk, tid, lane);
            E.run_half(acc, cur, wr, wc, fr, fq, my); }
    } else {
        if (cur.role == 2) sk_finish<0>(acc, cur, S.c, S.c + NXCD, sk, E, tid, lane, wr, wc, fr, fq);
        else if (cur.role == 1) sk_finish<1>(acc, cur, S.c, S.c - NXCD, sk, E, tid, lane, wr, wc, fr, fq);
    }
#undef PG8_SA
#undef PG8_SB
#undef PG8_STAGE
#undef PG8_LDA
#undef PG8_LDB
#undef PG8_MMA
#undef PG8_WAIT_V
#undef PG8_WAIT_L
#undef PG8_BAR
#undef PG8_SCHED
}
}

#define GAS __attribute__((address_space(1)))
#define LAS __attribute__((address_space(3)))
typedef unsigned short bf16;
typedef unsigned v4u __attribute__((ext_vector_type(4)));
typedef float f32x4 __attribute__((ext_vector_type(4)));
typedef short bf16x8 __attribute__((ext_vector_type(8)));
typedef GAS unsigned gu32;
typedef GAS unsigned long long gu64;
#define RLX_AGENT __ATOMIC_RELAXED, __HIP_MEMORY_SCOPE_AGENT
#define LDS_WAIT() asm volatile("s_waitcnt lgkmcnt(0)" ::: "memory")
#define VM_WAIT() asm volatile("s_waitcnt vmcnt(0)" ::: "memory")
__device__ __forceinline__ unsigned long long rt() { return __builtin_amdgcn_s_memrealtime(); }

#define XB_TMO      128
#define XB_XCNT(j)  (256  + 64 * (j))
#define XB_XSUB(j)  (1280 + 64 * (j))
#define XB_XGEN(j)  (2304 + 64 * (j))
#define XB_TOP      3328
#define XB_TOPGEN   3392
#define XCD_BAR_WORDS 3456
#define XB_SPIN_CAP (1u << 18)

__device__ __forceinline__ unsigned xb_ld(unsigned* p)              { return __hip_atomic_load(p, __ATOMIC_RELAXED, __HIP_MEMORY_SCOPE_AGENT); }
__device__ __forceinline__ unsigned xb_add(unsigned* p, unsigned v) { return __hip_atomic_fetch_add(p, v, __ATOMIC_RELAXED, __HIP_MEMORY_SCOPE_AGENT); }
__device__ __forceinline__ unsigned xb_xcc_id() { return (unsigned)__builtin_amdgcn_s_getreg((3 << 11) | 20) & 0xFu; }
#define XB_SPIN(cond, bar) do { unsigned _sp = 0; while (cond) { __builtin_amdgcn_s_sleep(1); \
    if ((++_sp & 255u) == 0u) { if (xb_ld(&(bar)[XB_TMO])) break; if (_sp > XB_SPIN_CAP) { atomicAdd(&(bar)[XB_TMO], 1u); break; } } } } while (0)

struct XcdBarrier {
    unsigned* bar; unsigned x;
    volatile LAS unsigned* st;
};

__device__ __forceinline__ XcdBarrier xcd_barrier_post(unsigned* bar, volatile LAS unsigned* st) {
    XcdBarrier b; b.bar = bar; b.x = xb_xcc_id(); b.st = st;
    if (threadIdx.x == 0) (void)xb_add(&bar[XB_XCNT(b.x)], 1u);
    return b;
}
__device__ __forceinline__ void xcd_barrier_complete(unsigned* bar, unsigned x, unsigned& nloc, unsigned& nx) {
    const unsigned G = gridDim.x * gridDim.y * gridDim.z;
    unsigned sum, cnt, mine, sp = 0u;
    for (;;) {
        sum = 0u; cnt = 0u; mine = 0u;
#pragma unroll
        for (unsigned j = 0; j < 16; ++j) { const unsigned c = xb_ld(&bar[XB_XCNT(j)]); sum += c; cnt += (c > 0u) ? 1u : 0u; mine = (j == x) ? c : mine; }
        if (sum == G) break;
        __builtin_amdgcn_s_sleep(1);
        if ((++sp & 255u) == 0u) { if (xb_ld(&bar[XB_TMO])) break; if (sp > XB_SPIN_CAP) { atomicAdd(&bar[XB_TMO], 1u); break; } }
    }
    nloc = mine > 0u ? mine : 1u; nx = cnt > 0u ? cnt : 1u;
}

__device__ __forceinline__ void xcd_barrier(const XcdBarrier& b) {
    asm volatile("s_waitcnt vmcnt(0)" ::: "memory");
    __syncthreads();
    if (threadIdx.x == 0) {
        unsigned* bar = b.bar;
        __builtin_amdgcn_s_waitcnt(0);
        unsigned nloc = b.st[0], nx = b.st[1];
        if (nloc == 0u) { xcd_barrier_complete(bar, b.x, nloc, nx); b.st[0] = nloc; b.st[1] = nx; }
        const unsigned old = xb_add(&bar[XB_XSUB(b.x)], 1u);
        const unsigned gen = old / nloc;
        if (old + 1u == (gen + 1u) * nloc) {
            __builtin_amdgcn_fence(__ATOMIC_RELEASE, "agent");
            asm volatile("s_waitcnt vmcnt(0)" ::: "memory");
            const unsigned og = xb_add(&bar[XB_TOP], 1u);
            const unsigned tg = og / nx;
            if (og + 1u == (tg + 1u) * nx) xb_add(&bar[XB_TOPGEN], 1u);
            else XB_SPIN(xb_ld(&bar[XB_TOPGEN]) == tg, bar);
            __builtin_amdgcn_fence(__ATOMIC_ACQUIRE, "agent");
            xb_add(&bar[XB_XGEN(b.x)], 1u);
            asm volatile("s_waitcnt vmcnt(0)" ::: "memory");
        } else {
            XB_SPIN(xb_ld(&bar[XB_XGEN(b.x)]) == gen, bar);
            __builtin_amdgcn_fence(__ATOMIC_ACQUIRE, "agent");
            asm volatile("s_waitcnt vmcnt(0)" ::: "memory");
        }
    }
    __syncthreads();
}

constexpr int NWAVES = 8, NTHR = 512;
#ifndef MK_N_LAUNCHES
#define MK_N_LAUNCHES 1
#endif
constexpr int N_PHASES = 18;
constexpr int N_LAUNCHES = MK_N_LAUNCHES;
constexpr int D = 4096, MP = 8192, MS = 2048, M = MP + MS;
constexpr int CONVD = 2048, NPROJ = 9216, DFF = 11008, NUP = 22016, NGM = 8192;
constexpr int OFF_GB = 0, OFF_GC = 2048, OFF_HV = 4096, OFF_Q = 6144, OFF_K = 8192, OFF_V = 8704;
constexpr float RMS_EPS = 1e-6f, LN_EPS = 1e-5f;
constexpr size_t O_YP = 0, O_YS = O_YP + (size_t)MP * D, O_CP = O_YS + (size_t)MS * D, O_CS = O_CP + 4 * 2 * 2048, O_KP = O_CS + 32 * 2 * 2048, O_KS = O_KP + 4 * 128 * 512,
                 O_VP = O_KS + 32 * 128 * 512, O_VS = O_VP + 4 * 128 * 512, O_FP = O_VS + 32 * 128 * 512, O_FS = O_FP + (size_t)2 * 4 * 2 * NUP, O_GV = O_FS + (size_t)2 * 32 * 2 * NUP,
                 O_END = O_GV + (size_t)MS * D;
constexpr size_t MiB = 1u << 20;
constexpr size_t WS_CTL = 0, CTL_ZERO_BYTES = 1 * MiB;
constexpr size_t WS_WIN = 1 * MiB, WS_WOUT = WS_WIN + (size_t)NPROJ * D * 2, WS_WINC = WS_WOUT + (size_t)D * D * 2, WS_WOUTC = WS_WINC + (size_t)NGM * D * 2,
                 WS_WUP = WS_WOUTC + (size_t)D * D * 2, WS_WDN = WS_WUP + (size_t)2 * NUP * D * 2, WS_XN = WS_WDN + (size_t)2 * D * DFF * 2,
                 WS_PROJ = WS_XN + (size_t)M * D * 2, WS_MIX = WS_PROJ + (size_t)M * NPROJ * 2, WS_X = WS_MIX + (size_t)M * D * 2, WS_UP = WS_X + (size_t)M * D * 4,
                 WS_ACT = WS_UP + (size_t)M * NUP * 2, WS_Z = WS_ACT + (size_t)M * DFF * 2, WS_VLN = WS_Z + (size_t)M * NGM * 2, WS_RS = WS_VLN + (size_t)M * D * 2, WS_LS = WS_RS + (size_t)M * 128 * 4, WS_RSTD = WS_LS + (size_t)M * 128 * 8, WS_SLAB = WS_RSTD + (size_t)M * 4, WS_SIDE = WS_SLAB + (size_t)2 * 256 * 262144, WS_END = WS_SIDE + (size_t)32 * 4 * NUP * 4;
constexpr int CW_BAR = 4096, CW_SK = 16384;
constexpr int RING_OFF = 0, RING_BYTES = 131072, LDSCTL_OFF = RING_BYTES, MISC_OFF = LDSCTL_OFF + 320, TAB_OFF = LDSCTL_OFF + 1024  , BND_OFF = TAB_OFF + 2048  , LDS_BYTES = BND_OFF + 16384;

typedef unsigned short bf16;
typedef unsigned u32x4 __attribute__((ext_vector_type(4)));
typedef unsigned u32x2 __attribute__((ext_vector_type(2)));
typedef float f32x4 __attribute__((ext_vector_type(4)));
typedef float f32x16 __attribute__((ext_vector_type(16)));
typedef short bf16x8 __attribute__((ext_vector_type(8)));
typedef short s16x4 __attribute__((ext_vector_type(4)));
#define LDS_WAIT() asm volatile("s_waitcnt lgkmcnt(0)" ::: "memory")
#define MFMA32(a, b, c) __builtin_amdgcn_mfma_f32_32x32x16_bf16((a), (b), (c), 0, 0, 0)

struct Args {
    const float *x_p, *x_s, *st_conv, *cache_k, *cache_v, *st_ffn, *norm_mix, *norm_ffn, *norm_final, *w_in_ab, *conv_w_a, *sinks, *w_out_ab, *w_in_c, *ln_g, *ln_b, *w_s, *b_s, *w_out_c,
        *w_up, *conv_w_ffn, *conv_b_ffn, *w_down;
    float* out; unsigned char* ws; int ph_lo, ph_hi;
};

__device__ __forceinline__ float bflo(unsigned w) { return __uint_as_float(w << 16); }
__device__ __forceinline__ float bfhi(unsigned w) { return __uint_as_float(w & 0xffff0000u); }
__device__ __forceinline__ unsigned pk2(float lo, float hi) { return pg8::cvt_pk_bf16(lo, hi); }
__device__ __forceinline__ void unpack8(const u32x4 w, float (&f)[8]) { f[0] = bflo(w.x); f[1] = bfhi(w.x); f[2] = bflo(w.y); f[3] = bfhi(w.y); f[4] = bflo(w.z); f[5] = bfhi(w.z); f[6] = bflo(w.w); f[7] = bfhi(w.w); }
__device__ __forceinline__ u32x4 pack8(const float (&f)[8]) { u32x4 w; w.x = pk2(f[0], f[1]); w.y = pk2(f[2], f[3]); w.z = pk2(f[4], f[5]); w.w = pk2(f[6], f[7]); return w; }
__device__ __forceinline__ void load8f(const float* p, float (&f)[8]) { const f32x4 a = *(const f32x4*)p, b = *(const f32x4*)(p + 4); f[0] = a.x; f[1] = a.y; f[2] = a.z; f[3] = a.w; f[4] = b.x; f[5] = b.y; f[6] = b.z; f[7] = b.w; }
__device__ __forceinline__ void store8f(float* p, const float (&f)[8]) { *(f32x4*)p = (f32x4){f[0], f[1], f[2], f[3]}; *(f32x4*)(p + 4) = (f32x4){f[4], f[5], f[6], f[7]}; }
__device__ __forceinline__ float wave_sum(float v) {
#pragma unroll
    for (int o = 1; o < 64; o <<= 1) v += __shfl_xor(v, o);
    return v;
}
__device__ __forceinline__ int crow(int r, int hi) { return (r & 3) + 8 * (r >> 2) + 4 * hi; }

__device__ __forceinline__ void p0_load_item(const float* W, const float* gain, int N, int item, int lane, f32x4 (&v)[8]) {
    const int nblk = N / 32, kb = item / nblk, nb = item % nblk;
    const float* src = W + (size_t)(64 * kb + 8 * (lane >> 3)) * N + 32 * nb + 4 * (lane & 7);
#pragma unroll
    for (int i = 0; i < 8; ++i) v[i] = __builtin_nontemporal_load((const f32x4*)(src + (size_t)i * N));
    if (gain) { float gk[8]; load8f(gain + 64 * kb + 8 * (lane >> 3), gk);
#pragma unroll
        for (int i = 0; i < 8; ++i) v[i] = v[i] * gk[i]; }
}
template <bool PERMUP> __device__ __forceinline__ void p0_store_item(bf16* WT, int K, int N, int item, int lane, const f32x4 (&v)[8]) {
    const int nblk = N / 32, kb = item / nblk, nb = item % nblk;
    int rowb = 32 * nb + 4 * (lane & 7);
    if (PERMUP) { const int s0 = 32 * nb, hf = s0 >= DFF ? 1 : 0, ch = s0 - hf * DFF + 4 * (lane & 7), t = ch >> 7, ct = ch & 127;
        rowb = 256 * t + 128 * (ct >> 6) + 32 * ((ct >> 4) & 3) + 8 * ((ct >> 2) & 3) + 4 * hf; }
    bf16* dst = WT + (size_t)rowb * K + 64 * kb + 8 * (lane >> 3);
#pragma unroll
    for (int j = 0; j < 4; ++j) { u32x4 o; o.x = pk2(v[0][j], v[1][j]); o.y = pk2(v[2][j], v[3][j]); o.z = pk2(v[4][j], v[5][j]); o.w = pk2(v[6][j], v[7][j]);
        *(u32x4*)(dst + (size_t)j * K) = o; }
}
template <int NI, bool PERMUP = false> __device__ __forceinline__ void p0_transpose(const float* W, const float* gain, int K, int N, bf16* WT, int gw, int NGW, int lane) {
    const int nitems = (K / 64) * (N / 32);
    for (int it = gw; it < nitems; it += NI * NGW) {
        f32x4 v[NI][8];
#pragma unroll
        for (int j = 0; j < NI; ++j) { const int itj = it + j * NGW; if (itj < nitems) p0_load_item(W, gain, N, itj, lane, v[j]); }
#pragma unroll
        for (int j = 0; j < NI; ++j) { const int itj = it + j * NGW; if (itj < nitems) p0_store_item<PERMUP>(WT, K, N, itj, lane, v[j]); }
    }
}
__device__ __forceinline__ void final_row2(const float* x0, const float* x1, const float* rs0, const float* rs1, const float* g, float* o0, float* o1, bool two, int lane) {
    const float s = wave_sum(rs0[lane] + rs0[64 + lane]), t = wave_sum(rs1[lane] + rs1[64 + lane]);
    const float ra = 1.0f / sqrtf(s * (1.f / D) + RMS_EPS), rb = 1.0f / sqrtf(t * (1.f / D) + RMS_EPS);
    const f32x4* xr0 = (const f32x4*)x0 + lane; const f32x4* xr1 = (const f32x4*)x1 + lane; const f32x4* gr = (const f32x4*)g + lane;
#pragma unroll
    for (int j = 0; j < 16; ++j) { const f32x4 gg = gr[64 * j]; const f32x4 y = __builtin_nontemporal_load(xr0 + 64 * j) * ra * gg; __builtin_nontemporal_store(y, (f32x4*)o0 + lane + 64 * j);
        if (two) { const f32x4 z = __builtin_nontemporal_load(xr1 + 64 * j) * rb * gg; __builtin_nontemporal_store(z, (f32x4*)o1 + lane + 64 * j); } }
}
template <bool OUTF> __device__ __forceinline__ void rms_row2(const float* x0, const float* x1, const float* g, void* o0, void* o1, bool two, int lane) {
    const f32x4* xr0 = (const f32x4*)x0 + lane; const f32x4* xr1 = (const f32x4*)x1 + lane;
    f32x4 v[16], w[16]; float s = 0.f, t = 0.f;
#pragma unroll
    for (int j = 0; j < 16; ++j) v[j] = OUTF ? __builtin_nontemporal_load(xr0 + 64 * j) : xr0[64 * j];
    if (two) {
#pragma unroll
        for (int j = 0; j < 16; ++j) w[j] = OUTF ? __builtin_nontemporal_load(xr1 + 64 * j) : xr1[64 * j];
    } else {
#pragma unroll
        for (int j = 0; j < 16; ++j) w[j] = (f32x4){0.f, 0.f, 0.f, 0.f};
    }
#pragma unroll
    for (int j = 0; j < 16; ++j) { s += (v[j].x * v[j].x + v[j].y * v[j].y) + (v[j].z * v[j].z + v[j].w * v[j].w); t += (w[j].x * w[j].x + w[j].y * w[j].y) + (w[j].z * w[j].z + w[j].w * w[j].w); }
    const float rs = 1.0f / sqrtf(wave_sum(s) * (1.f / D) + RMS_EPS), rt = 1.0f / sqrtf(wave_sum(t) * (1.f / D) + RMS_EPS);
    const f32x4* gr = (const f32x4*)g + lane;
#pragma unroll
    for (int j = 0; j < 16; ++j) { const f32x4 gg = gr[64 * j]; const f32x4 y = v[j] * rs * gg, z = w[j] * rt * gg;
        if (OUTF) { __builtin_nontemporal_store(y, (f32x4*)o0 + lane + 64 * j); if (two) __builtin_nontemporal_store(z, (f32x4*)o1 + lane + 64 * j); }
        else { u32x2 a; a.x = pk2(y.x, y.y); a.y = pk2(y.z, y.w); ((u32x2*)o0 + lane)[64 * j] = a; if (two) { u32x2 b; b.x = pk2(z.x, z.y); b.y = pk2(z.z, z.w); ((u32x2*)o1 + lane)[64 * j] = b; } } }
}
struct Ctx { int tid, lane, wave, vcu, G; LAS unsigned char* lds; };

__device__ __forceinline__ void phase_rms(const Ctx& c, const float* xp, const float* xs, const float* g, bf16* XN) {
    const int gw = c.vcu * NWAVES + c.wave, NGW = c.G * NWAVES;
    for (int m = gw; m < M; m += 2 * NGW) { const int m2 = m + NGW; const bool two = m2 < M; const int mm = two ? m2 : m;
        const float* x0 = m < MP ? xp + (size_t)m * D : xs + (size_t)(m - MP) * D; const float* x1 = mm < MP ? xp + (size_t)mm * D : xs + (size_t)(mm - MP) * D;
        rms_row2<false>(x0, x1, g, XN + (size_t)m * D, XN + (size_t)mm * D, two, c.lane); }
}
__device__ __forceinline__ void phase_final(const Ctx& c, const bf16* X, const float* RS, const float* g, float* out) {
    const int rpbn = (M + c.G - 1) / c.G, r0 = c.vcu * rpbn, rpb = r0 >= M ? 0 : (M - r0 < rpbn ? M - r0 : rpbn);
    LAS float* tab = (LAS float*)(c.lds + TAB_OFF);
    for (int r = c.wave; r < rpb; r += NWAVES) { const float* rs = RS + (size_t)(r0 + r) * 128; const float s = wave_sum(rs[c.lane] + rs[64 + c.lane]); if (c.lane == 0) tab[r] = 1.0f / sqrtf(s * (1.f / D) + RMS_EPS); }
    __syncthreads();
    const u32x4* xp = (const u32x4*)(X + (size_t)r0 * D); float* op = out + O_YP + (size_t)r0 * D;
    const int n8 = rpb * (D / 8);
    for (int i0 = c.tid; i0 < n8; i0 += 16 * NTHR) {
        u32x4 v[16];
#pragma unroll
        for (int j = 0; j < 16; ++j) { const int i = i0 + j * NTHR; if (i < n8) v[j] = __builtin_nontemporal_load(xp + i); }
#pragma unroll
        for (int j = 0; j < 16; ++j) { const int i = i0 + j * NTHR; if (i < n8) { const float rs = tab[i >> 9]; float f[8], gg[8]; unpack8(v[j], f); load8f(g + (i & 511) * 8, gg);
#pragma unroll
                for (int e = 0; e < 8; ++e) f[e] = f[e] * rs * gg[e];
                __builtin_nontemporal_store((f32x4){f[0], f[1], f[2], f[3]}, (f32x4*)(op + (size_t)i * 8)); __builtin_nontemporal_store((f32x4){f[4], f[5], f[6], f[7]}, (f32x4*)(op + (size_t)i * 8 + 4)); } }
    }
    __syncthreads();
}
template <int NI> __device__ __forceinline__ void convert_weights(const Args& a, int which, int gw, int NGW, int lane) {
    unsigned char* ws = a.ws;
    if (which & 1) p0_transpose<NI>(a.w_in_ab, nullptr, D, NPROJ, (bf16*)(ws + WS_WIN), gw, NGW, lane);
    if (which & 2) p0_transpose<NI>(a.w_out_ab, nullptr, D, D, (bf16*)(ws + WS_WOUT), gw, NGW, lane);
    if (which & 4) p0_transpose<NI, true>(a.w_up, a.norm_ffn, D, NUP, (bf16*)(ws + WS_WUP), gw, NGW, lane);
    if (which & 8) p0_transpose<NI>(a.w_down, nullptr, DFF, D, (bf16*)(ws + WS_WDN), gw, NGW, lane);
    if (which & 16) p0_transpose<NI>(a.w_in_c, a.norm_mix + D, D, NGM, (bf16*)(ws + WS_WINC), gw, NGW, lane);
    if (which & 32) p0_transpose<NI>(a.w_out_c, nullptr, D, D, (bf16*)(ws + WS_WOUTC), gw, NGW, lane);
    if (which & 64) p0_transpose<NI, true>(a.w_up + (size_t)D * NUP, a.norm_ffn + D, D, NUP, (bf16*)(ws + WS_WUP) + (size_t)NUP * D, gw, NGW, lane);
    if (which & 128) p0_transpose<NI>(a.w_down + (size_t)DFF * D, nullptr, DFF, D, (bf16*)(ws + WS_WDN) + (size_t)D * DFF, gw, NGW, lane);
}
__device__ __forceinline__ void phase_prologue(const Ctx& c, const Args& a) {
#ifndef MK_QUAD
#define MK_QUAD true
#endif
#ifndef MK_P2_CONV
#define MK_P2_CONV 254
#endif
    convert_weights<2>(a, 255 & ~MK_P2_CONV, c.vcu * NWAVES + c.wave, c.G * NWAVES, c.lane);
    phase_rms(c, a.x_p, a.x_s, a.norm_mix, (bf16*)(a.ws + WS_XN));
}

__device__ __forceinline__ void mix0_conv(const Ctx& c, const Args& a) {
    const bf16* PROJ = (const bf16*)(a.ws + WS_PROJ); bf16* MIX = (bf16*)(a.ws + WS_MIX);
    const int gt = c.vcu * NTHR + c.tid, NT = c.G * NTHR;
    for (int it = gt; it < (M / 16) * 256; it += NT) {
        const int cc = it & 255, rb = it >> 8, r0 = rb * 16, ch = cc * 8;
        const bool smp = r0 >= MP; const int t0 = smp ? ((r0 - MP) & 63) : (r0 & 2047), T = smp ? 64 : 2048, b = smp ? ((r0 - MP) >> 6) : (r0 >> 11);
        float w0[8], w1[8], w2[8], p2[8], p1[8];
        load8f(a.conv_w_a + ch, w0); load8f(a.conv_w_a + CONVD + ch, w1); load8f(a.conv_w_a + 2 * CONVD + ch, w2);
        if (t0 == 0) {
            if (smp) { load8f(a.st_conv + (size_t)(b * 2 + 0) * CONVD + ch, p2); load8f(a.st_conv + (size_t)(b * 2 + 1) * CONVD + ch, p1); }
            else {
#pragma unroll
                for (int e = 0; e < 8; ++e) { p2[e] = 0.f; p1[e] = 0.f; } }
        } else {
            float gc[8], hv[8];
            const bf16* pr = PROJ + (size_t)(r0 - 2) * NPROJ + ch;
            unpack8(*(const u32x4*)(pr + OFF_GC), gc); unpack8(*(const u32x4*)(pr + OFF_HV), hv);
#pragma unroll
            for (int e = 0; e < 8; ++e) p2[e] = gc[e] * hv[e];
            pr += NPROJ;
            unpack8(*(const u32x4*)(pr + OFF_GC), gc); unpack8(*(const u32x4*)(pr + OFF_HV), hv);
#pragma unroll
            for (int e = 0; e < 8; ++e) p1[e] = gc[e] * hv[e];
        }
        float* so = a.out + (smp ? O_CS : O_CP) + (size_t)b * 2 * CONVD + ch;
#pragma unroll 1
        for (int i0 = 0; i0 < 16; i0 += 8) {
            u32x4 rb[8], rc[8], rh[8];
#pragma unroll
            for (int i = 0; i < 8; ++i) { const bf16* pr = PROJ + (size_t)(r0 + i0 + i) * NPROJ + ch; rb[i] = *(const u32x4*)(pr + OFF_GB); rc[i] = *(const u32x4*)(pr + OFF_GC); rh[i] = *(const u32x4*)(pr + OFF_HV); }
#pragma unroll
            for (int i = 0; i < 8; ++i) {
                float gb[8], gc[8], hv[8], cur[8], o[8];
                unpack8(rb[i], gb); unpack8(rc[i], gc); unpack8(rh[i], hv);
#pragma unroll
                for (int e = 0; e < 8; ++e) { cur[e] = gc[e] * hv[e]; o[e] = gb[e] * (w0[e] * p2[e] + w1[e] * p1[e] + w2[e] * cur[e]); }
                *(u32x4*)(MIX + (size_t)(r0 + i0 + i) * D + ch) = pack8(o);
                const int j = t0 + i0 + i - (T - 2);
                if (j >= 0) store8f(so + (size_t)j * CONVD, cur);
#pragma unroll
                for (int e = 0; e < 8; ++e) { p2[e] = p1[e]; p1[e] = cur[e]; }
            }
        }
    }
}
__device__ __forceinline__ void mix0_kvstate(const Ctx& c, const Args& a) {
    const bf16* PROJ = (const bf16*)(a.ws + WS_PROJ);
    const int gt = c.vcu * NTHR + c.tid, NT = c.G * NTHR;
    constexpr int NP = 4 * 128 * 64, NS = 32 * 128 * 64;
    for (int it = gt; it < 2 * (NP + NS); it += NT) {
        const int isv = it >= (NP + NS); int r = isv ? it - (NP + NS) : it;
        const int off = isv ? OFF_V : OFF_K; float f[8]; float* o;
        if (r < NP) { const int e8 = r & 63, j = (r >> 6) & 127, b = r >> 13;
            unpack8(*(const u32x4*)(PROJ + (size_t)(b * 2048 + 1920 + j) * NPROJ + off + e8 * 8), f);
            o = a.out + (isv ? O_VP : O_KP) + (size_t)r * 8;
        } else { r -= NP; const int e8 = r & 63, j = (r >> 6) & 127, b = r >> 13;
            if (j < 64) load8f((isv ? a.cache_v : a.cache_k) + ((size_t)(b * 128 + 64 + j) * 512 + e8 * 8), f);
            else unpack8(*(const u32x4*)(PROJ + (size_t)(MP + b * 64 + (j - 64)) * NPROJ + off + e8 * 8), f);
            o = a.out + (isv ? O_VS : O_KS) + (size_t)r * 8;
        }
        store8f(o, f);
    }
}
constexpr int KS_PITCH = 72, VT_PITCH = 200;
__device__ __forceinline__ void attn_unit(const Ctx& c, const Args& a, int unit) {
    const bf16* PROJ = (const bf16*)(a.ws + WS_PROJ); bf16* MIX = (bf16*)(a.ws + WS_MIX);
    const int tid = c.tid, wid = c.wave, lane = c.lane, l32 = lane & 31, hi = lane >> 5;
    const int ch = unit >> 3, kvh = unit & 7;
    LAS bf16* Ks = (LAS bf16*)(c.lds + RING_OFF); LAS bf16* Vt = (LAS bf16*)(c.lds + RING_OFF + 192 * KS_PITCH * 2);
    const bool smp = ch >= 128; int b, qrow0, jmin;
    if (!smp) { b = ch >> 5; const int cq = ch & 31; qrow0 = b * 2048 + cq * 64; jmin = cq >= 2 ? 0 : (2 - cq) * 64; } else { b = ch - 128; qrow0 = MP + b * 64; jmin = 0; }
    const int h = kvh * 4 + (wid >> 1), tq = 32 * (wid & 1) + l32;
    u32x4 qraw[4];
    { const bf16* qp = PROJ + (size_t)(qrow0 + tq) * NPROJ + OFF_Q + h * 64 + 8 * hi;
#pragma unroll
      for (int ks = 0; ks < 4; ++ks) qraw[ks] = *(const u32x4*)(qp + 16 * ks); }
#pragma unroll
    for (int i = 0; i < 3; ++i) {
        const int ci = tid + NTHR * i, j = ci >> 3, cc = ci & 7; u32x4 kv, vv;
        if (j < jmin) { kv = (u32x4){0u, 0u, 0u, 0u}; vv = kv; }
        else if (smp && j < 128) { float f[8]; const size_t o = ((size_t)(b * 128 + j) * 8 + kvh) * 64 + cc * 8; load8f(a.cache_k + o, f); kv = pack8(f); load8f(a.cache_v + o, f); vv = pack8(f); }
        else { const int row = smp ? (MP + b * 64 + (j - 128)) : (qrow0 - 128 + j); const bf16* p = PROJ + (size_t)row * NPROJ + kvh * 64 + cc * 8;
            kv = *(const u32x4*)(p + OFF_K); vv = *(const u32x4*)(p + OFF_V); }
        *(LAS u32x4*)(Ks + j * KS_PITCH + cc * 8) = kv;
        LAS bf16* vt = Vt + (cc * 8) * VT_PITCH + ((((j >> 2) ^ cc)) << 2) + (j & 3);
        vt[0 * VT_PITCH] = (bf16)(vv.x & 0xffffu); vt[1 * VT_PITCH] = (bf16)(vv.x >> 16); vt[2 * VT_PITCH] = (bf16)(vv.y & 0xffffu); vt[3 * VT_PITCH] = (bf16)(vv.y >> 16);
        vt[4 * VT_PITCH] = (bf16)(vv.z & 0xffffu); vt[5 * VT_PITCH] = (bf16)(vv.z >> 16); vt[6 * VT_PITCH] = (bf16)(vv.w & 0xffffu); vt[7 * VT_PITCH] = (bf16)(vv.w >> 16);
    }
    __syncthreads();
    bf16x8 qf[4];
#pragma unroll
    for (int ks = 0; ks < 4; ++ks) { float f[8]; unpack8(qraw[ks], f);
#pragma unroll
        for (int e = 0; e < 8; ++e) f[e] *= 0.125f;
        qf[ks] = __builtin_bit_cast(bf16x8, pack8(f)); }
    const float slope = exp2f(-0.25f * (float)(h + 1)), sink = a.sinks[h];
    const float t0 = (float)(tq + 128 - 4 * hi);
    const int kb0 = jmin >> 5;
    float mx = sink;
#pragma unroll
    for (int kb = 0; kb < 6; ++kb) {
        if (kb >= kb0) { f32x16 acc;
#pragma unroll
            for (int r = 0; r < 16; ++r) acc[r] = 0.f;
#pragma unroll
            for (int ks = 0; ks < 4; ++ks) { const bf16x8 kf = *(const LAS bf16x8*)(Ks + (32 * kb + l32) * KS_PITCH + 16 * ks + 8 * hi); acc = MFMA32(kf, qf[ks], acc); }
#pragma unroll
            for (int r = 0; r < 16; ++r) { const float dist = fabsf(t0 - (float)(32 * kb + (r & 3) + 8 * (r >> 2))); mx = fmaxf(mx, acc[r] - slope * dist); }
        }
        __builtin_amdgcn_sched_barrier(0);
    }
    mx = fmaxf(mx, __shfl_xor(mx, 32));
    f32x16 o0, o1; float sum = 0.f;
#pragma unroll
    for (int r = 0; r < 16; ++r) { o0[r] = 0.f; o1[r] = 0.f; }
#pragma unroll
    for (int kb = 0; kb < 6; ++kb) {
        if (kb >= kb0) { f32x16 acc;
#pragma unroll
            for (int r = 0; r < 16; ++r) acc[r] = 0.f;
#pragma unroll
            for (int ks = 0; ks < 4; ++ks) { const bf16x8 kf = *(const LAS bf16x8*)(Ks + (32 * kb + l32) * KS_PITCH + 16 * ks + 8 * hi); acc = MFMA32(kf, qf[ks], acc); }
            float p[16];
#pragma unroll
            for (int r = 0; r < 16; ++r) { const float dist = fabsf(t0 - (float)(32 * kb + (r & 3) + 8 * (r >> 2))); p[r] = __expf(acc[r] - slope * dist - mx); sum += p[r]; }
#pragma unroll
            for (int s = 0; s < 2; ++s) {
                u32x4 pw; pw.x = pk2(p[8 * s + 0], p[8 * s + 1]); pw.y = pk2(p[8 * s + 2], p[8 * s + 3]); pw.z = pk2(p[8 * s + 4], p[8 * s + 5]); pw.w = pk2(p[8 * s + 6], p[8 * s + 7]);
                const int k0 = l32 >> 3, x0 = 4 * s + hi, x1 = x0 + 2;
                const LAS bf16* vp = Vt + l32 * VT_PITCH + 32 * kb;
                const s16x4 a0 = *(const LAS s16x4*)(vp + ((x0 ^ k0) << 2)), a1 = *(const LAS s16x4*)(vp + ((x1 ^ k0) << 2)), b0 = *(const LAS s16x4*)(vp + 32 * VT_PITCH + ((x0 ^ k0 ^ 4) << 2)), b1 = *(const LAS s16x4*)(vp + 32 * VT_PITCH + ((x1 ^ k0 ^ 4) << 2));
                o0 = MFMA32(__builtin_shufflevector(a0, a1, 0, 1, 2, 3, 4, 5, 6, 7), __builtin_bit_cast(bf16x8, pw), o0);
                o1 = MFMA32(__builtin_shufflevector(b0, b1, 0, 1, 2, 3, 4, 5, 6, 7), __builtin_bit_cast(bf16x8, pw), o1); }
        }
        __builtin_amdgcn_sched_barrier(0);
    }
    sum += __shfl_xor(sum, 32);
    const float inv = 1.0f / (sum + __expf(sink - mx));
    bf16* op = MIX + (size_t)(qrow0 + tq) * D + CONVD + h * 64 + 4 * hi;
#pragma unroll
    for (int g = 0; g < 4; ++g) { u32x2 w; w.x = pk2(o0[4 * g] * inv, o0[4 * g + 1] * inv); w.y = pk2(o0[4 * g + 2] * inv, o0[4 * g + 3] * inv); *(u32x2*)(op + 8 * g) = w;
        w.x = pk2(o1[4 * g] * inv, o1[4 * g + 1] * inv); w.y = pk2(o1[4 * g + 2] * inv, o1[4 * g + 3] * inv); *(u32x2*)(op + 32 + 8 * g) = w; }
    __syncthreads();
}
__device__ __forceinline__ void phase_mix0(const Ctx& c, const Args& a) {
    if (c.vcu & 1) { convert_weights<2>(a, MK_P2_CONV, c.vcu * NWAVES + c.wave, c.G * NWAVES, c.lane); mix0_conv(c, a); mix0_kvstate(c, a); }
    for (int u = c.vcu; u < 160 * 8; u += c.G) attn_unit(c, a, u);
    if (!(c.vcu & 1)) { convert_weights<2>(a, MK_P2_CONV, c.vcu * NWAVES + c.wave, c.G * NWAVES, c.lane); mix0_conv(c, a); mix0_kvstate(c, a); }
}

__device__ __forceinline__ void phase_ffnfix(const Ctx& c, const Args& a, int layer) {
    const float* SIDE = (const float*)(a.ws + WS_SIDE); bf16* ACT = (bf16*)(a.ws + WS_ACT);
    const float* cw = a.conv_w_ffn + (size_t)layer * 3 * NUP; const float* cb = a.conv_b_ffn + (size_t)layer * NUP;
    const int gt = c.vcu * NTHR + c.tid, NT = c.G * NTHR; constexpr int NCH = DFF / 8;
    for (int it = gt; it < 32 * 2 * NCH; it += NT) {
        const int cc = it % NCH, tr = it / NCH, r = tr & 1, pm = tr >> 1, ch = cc * 8;
        if ((pm & 7) == 0) continue;
        const float* s2 = r == 0 ? SIDE + ((size_t)((pm - 1) * 4 + 2)) * NUP : SIDE + ((size_t)((pm - 1) * 4 + 3)) * NUP;
        const float* s1 = r == 0 ? SIDE + ((size_t)((pm - 1) * 4 + 3)) * NUP : SIDE + ((size_t)(pm * 4 + 0)) * NUP;
        const float* s0 = SIDE + ((size_t)(pm * 4 + r)) * NUP;
        float wg0[8], wg1[8], wg2[8], wu0[8], wu1[8], wu2[8], bg[8], bu[8], g2[8], g1[8], g0[8], u2[8], u1[8], u0[8], o[8];
        load8f(cw + ch, wg0); load8f(cw + NUP + ch, wg1); load8f(cw + 2 * NUP + ch, wg2); load8f(cw + DFF + ch, wu0); load8f(cw + NUP + DFF + ch, wu1); load8f(cw + 2 * NUP + DFF + ch, wu2);
        load8f(cb + ch, bg); load8f(cb + DFF + ch, bu);
        load8f(s2 + ch, g2); load8f(s2 + DFF + ch, u2); load8f(s1 + ch, g1); load8f(s1 + DFF + ch, u1); load8f(s0 + ch, g0); load8f(s0 + DFF + ch, u0);
#pragma unroll
        for (int e = 0; e < 8; ++e) { const float cg = wg0[e] * g2[e] + wg1[e] * g1[e] + wg2[e] * g0[e] + bg[e], cu = wu0[e] * u2[e] + wu1[e] * u1[e] + wu2[e] * u0[e] + bu[e];
            o[e] = cg / (1.0f + __expf(-cg)) * cu; }
        *(u32x4*)(ACT + (size_t)(pm * 256 + r) * DFF + ch) = pack8(o);
    }
}
constexpr int SG_PITCH = 136, SO_PITCH = 264;
constexpr int WL_OFF = 256 * SG_PITCH * 2, WL_PITCH = 136;
__device__ __forceinline__ void sgu_load_w(const Ctx& c, const Args& a, int g) {
    LAS bf16* WL = (LAS bf16*)(c.lds + RING_OFF + WL_OFF); const float* wsg = a.w_s + (size_t)g * 128 * 128;
#pragma unroll
    for (int i = 0; i < 8; ++i) { const int ci = c.tid + NTHR * i, t = ci >> 5, s0 = (ci & 31) * 4; const f32x4 w = *(const f32x4*)(wsg + (size_t)t * 128 + s0);
        u32x2 o; o.x = pk2(s0 + 0 <= t ? w.x : 0.f, s0 + 1 <= t ? w.y : 0.f); o.y = pk2(s0 + 2 <= t ? w.z : 0.f, s0 + 3 <= t ? w.w : 0.f);
        *(LAS u32x2*)(WL + t * WL_PITCH + s0) = o; }
}
__device__ __forceinline__ void sgu_unit(const Ctx& c, const Args& a, int unit, int& gcur) {
    const bf16* Z = (const bf16*)(a.ws + WS_Z); bf16* MIX = (bf16*)(a.ws + WS_MIX);
    const int tid = c.tid, wid = c.wave, lane = c.lane, l32 = lane & 31, hi = lane >> 5;
    int g, r0, nt;
    if (unit < 1024) { g = unit & 15; r0 = (unit >> 4) * 128; nt = 4; } else { const int u2 = unit - 1024; g = u2 & 15; r0 = MP + (u2 >> 4) * 64; nt = 2; }
    LAS bf16* VT = (LAS bf16*)(c.lds + RING_OFF); const LAS bf16* WL = (const LAS bf16*)(c.lds + RING_OFF + WL_OFF);
    LAS float* lnt = (LAS float*)(c.lds + TAB_OFF);
    const int cc = tid & 31, col = g * 256 + cc * 8;
    u32x4 zv[8], zu[8];
#pragma unroll
    for (int i = 0; i < 8; ++i) if (i < 2 * nt) { const bf16* zp = Z + (size_t)(r0 + (tid >> 5) + 16 * i) * NGM + col; zv[i] = *(const u32x4*)(zp + D); zu[i] = *(const u32x4*)zp; }
    float gg[8], bb[8]; load8f(a.ln_g + col, gg); load8f(a.ln_b + col, bb);
    if (g != gcur) { sgu_load_w(c, a, g); gcur = g; }
    { const int row = tid >> 2, qd = tid & 3;
      if (row < 32 * nt) { const f32x4* p = (const f32x4*)((const float*)(a.ws + WS_LS) + ((size_t)(r0 + row) * 128 + qd * 32) * 2);
          f32x4 s4 = p[0];
#pragma unroll
          for (int j = 1; j < 16; ++j) s4 += p[j];
          float s1 = s4.x + s4.z, s2 = s4.y + s4.w; s1 += __shfl_xor(s1, 1); s2 += __shfl_xor(s2, 1); s1 += __shfl_xor(s1, 2); s2 += __shfl_xor(s2, 2);
          const float mean = s1 * (1.f / D), var = fmaxf(s2 * (1.f / D) - mean * mean, 0.f);
          if (qd == 0) { lnt[2 * row] = mean; lnt[2 * row + 1] = 1.0f / sqrtf(var + LN_EPS); } } }
    __syncthreads();
#pragma unroll
    for (int i = 0; i < 8; ++i) if (i < 2 * nt) { const int s = (tid >> 5) + 16 * i;
        float f[8]; unpack8(zv[i], f);
        const float mean = lnt[2 * s], rstd = lnt[2 * s + 1];
#pragma unroll
        for (int e = 0; e < 8; ++e) f[e] = (f[e] - mean) * rstd * gg[e] + bb[e];
        if (r0 >= MP) store8f(a.out + O_GV + (size_t)(r0 - MP + s) * D + col, f);
        const u32x4 v = pack8(f);
        LAS bf16* vt = VT + (cc * 8) * SG_PITCH + ((((s >> 3) ^ cc) & 15) << 3) + (s & 7);
        vt[0 * SG_PITCH] = (bf16)(v.x & 0xffffu); vt[1 * SG_PITCH] = (bf16)(v.x >> 16); vt[2 * SG_PITCH] = (bf16)(v.y & 0xffffu); vt[3 * SG_PITCH] = (bf16)(v.y >> 16);
        vt[4 * SG_PITCH] = (bf16)(v.z & 0xffffu); vt[5 * SG_PITCH] = (bf16)(v.z >> 16); vt[6 * SG_PITCH] = (bf16)(v.w & 0xffffu); vt[7 * SG_PITCH] = (bf16)(v.w >> 16); }
    __syncthreads();
    f32x16 acc[4];
#pragma unroll
    for (int tb = 0; tb < 4; ++tb)
#pragma unroll
        for (int r = 0; r < 16; ++r) acc[tb][r] = 0.f;
#pragma unroll
    for (int ks = 0; ks < 8; ++ks) {
        if (ks < 2 * nt) {
            const bf16x8 bfr = *(const LAS bf16x8*)(VT + (32 * wid + l32) * SG_PITCH + ((((2 * ks + hi) ^ ((32 * wid + l32) >> 3)) & 15) << 3));
#pragma unroll
            for (int tb = 0; tb < 4; ++tb) {
                if (tb >= (ks >> 1) && tb < nt) { const bf16x8 afr = *(const LAS bf16x8*)(WL + (32 * tb + l32) * WL_PITCH + 16 * ks + 8 * hi); acc[tb] = MFMA32(afr, bfr, acc[tb]); }
            }
        }
    }
    __syncthreads();
    LAS bf16* SO = (LAS bf16*)(c.lds + RING_OFF);
#pragma unroll
    for (int tb = 0; tb < 4; ++tb) {
        if (tb < nt) {
#pragma unroll
            for (int r = 0; r < 16; ++r) { const int t = 32 * tb + crow(r, hi);
                SO[t * SO_PITCH + 32 * wid + l32] = (bf16)(pk2(acc[tb][r] + a.b_s[g * 128 + t], 0.f) & 0xffffu); }
        }
    }
    __syncthreads();
#pragma unroll
    for (int i = 0; i < 8; ++i) if (i < 2 * nt) { const int t = (tid >> 5) + 16 * i;
        float sv[8], uv[8], o[8]; unpack8(*(const LAS u32x4*)(SO + t * SO_PITCH + cc * 8), sv); unpack8(zu[i], uv);
#pragma unroll
        for (int e = 0; e < 8; ++e) o[e] = sv[e] * uv[e];
        *(u32x4*)(MIX + (size_t)(r0 + t) * D + col) = pack8(o); }
    __syncthreads();
}
__global__ void __launch_bounds__(NTHR, 2) mk_fwd(Args a) {
    extern __shared__ __attribute__((aligned(16))) unsigned char lds[];
    Ctx c; c.lds = (LAS unsigned char*)lds; c.tid = threadIdx.x; c.lane = c.tid & 63; c.wave = __builtin_amdgcn_readfirstlane(c.tid >> 6);
    c.G = gridDim.x; { const int bx = blockIdx.x; c.vcu = (c.G % 8 == 0) ? (bx % 8) * (c.G / 8) + bx / 8 : bx; }
    volatile LAS unsigned* MISC = (volatile LAS unsigned*)(c.lds + MISC_OFF);
    for (int u = c.tid; u < (LDS_BYTES - LDSCTL_OFF) / 4; u += NTHR) ((LAS unsigned*)(c.lds + LDSCTL_OFF))[u] = 0u;
    __syncthreads();
    unsigned char* ws = a.ws;
    unsigned* ctl = (unsigned*)(ws + WS_CTL);
    XcdBarrier bar; bar.bar = ctl + CW_BAR; bar.x = 0; bar.st = nullptr;
    if (N_LAUNCHES == 1) bar = xcd_barrier_post(ctl + CW_BAR, MISC + 8);
#define GRID_BAR() do { if (N_LAUNCHES == 1) xcd_barrier(bar); } while (0)
    const int lo = a.ph_lo, hi = a.ph_hi;
#define IN(k) (lo <= (k) && (k) < hi)
#define BOTH(k) (IN(k) && IN((k) + 1))
    bf16* XN = (bf16*)(ws + WS_XN); bf16* PROJ = (bf16*)(ws + WS_PROJ); bf16* MIX = (bf16*)(ws + WS_MIX);
    bf16* UP = (bf16*)(ws + WS_UP); bf16* ACT = (bf16*)(ws + WS_ACT); bf16* Z = (bf16*)(ws + WS_Z);
    LAS unsigned char* ring = c.lds + RING_OFF;
    float* RS = (float*)(ws + WS_RS); pg8::f32x2* LS = (pg8::f32x2*)(ws + WS_LS); LAS float* tab = (LAS float*)(c.lds + TAB_OFF);
#define SKS(gi) (pg8::SkShare{(float*)(ws + WS_SLAB) + (size_t)((gi) & 1) * 256 * 65536, ctl + CW_SK + (gi) * 256 * 16, ctl})
    const int bx = (int)blockIdx.x;

    if (IN(0)) { phase_prologue(c, a); if (BOTH(0)) GRID_BAR(); }
    if (IN(1)) {
        pg8::Gemm g{XN, (const bf16*)(ws + WS_WIN), M, NPROJ, D}; pg8::SkOrder S; S.init(M, NPROJ, D, c.G, bx, false); pg8::EpiBf16<0, false, false> E{PROJ, NPROJ, nullptr, nullptr, nullptr, 0};
        pg8::gemm_phase<pg8::EpiBf16<0, false, false>, pg8::SkOrder, true, true>(ring, g, S, E, SKS(0));
        if (BOTH(1)) GRID_BAR(); }
    if (IN(2)) { phase_mix0(c, a); if (BOTH(2)) GRID_BAR(); }
    if (IN(3)) {
        pg8::Gemm g{MIX, (const bf16*)(ws + WS_WOUT), M, D, D}; pg8::SkOrder S; S.init(M, D, D, c.G, bx, false); pg8::EpiRes<true, true> E{a.x_p, a.x_s, XN, RS, D, MP};
        pg8::gemm_phase<pg8::EpiRes<true, true>, pg8::SkOrder, true, true>(ring, g, S, E, SKS(1));
        if (BOTH(3)) GRID_BAR(); }
    if (IN(5)) {
        pg8::Gemm g{XN, (const bf16*)(ws + WS_WUP), M, NUP, D}; pg8::SkOrder S; S.init(M, NUP, D, c.G, bx, false); pg8::EpiConvGate E{ACT, RS, tab, (LAS bf16*)(c.lds + BND_OFF), a.conv_w_ffn + (size_t)0 * 3 * NUP, a.conv_b_ffn + (size_t)0 * NUP, a.st_ffn + (size_t)0 * 32 * 2 * NUP, (float*)(ws + WS_SIDE), a.out + O_FP + (size_t)0 * 4 * 2 * NUP, a.out + O_FS + (size_t)0 * 32 * 2 * NUP};
        pg8::gemm_phase<pg8::EpiConvGate, pg8::SkOrder, true, true>(ring, g, S, E, SKS(2));
        if (BOTH(5)) GRID_BAR(); }
    if (IN(6)) { phase_ffnfix(c, a, 0); if (BOTH(6)) GRID_BAR(); }
    if (IN(7)) {
        pg8::Gemm g{ACT, (const bf16*)(ws + WS_WDN), M, D, DFF}; pg8::SkOrder S; S.init(M, D, DFF, c.G, bx, true); S.quad = MK_QUAD; pg8::EpiRes<false, true> E{nullptr, nullptr, XN, RS, D, MP};
        pg8::gemm_phase<pg8::EpiRes<false, true>, pg8::SkOrder, true, true>(ring, g, S, E, SKS(3));
        if (BOTH(7)) GRID_BAR(); }
    if (IN(9)) {
        pg8::Gemm g{XN, (const bf16*)(ws + WS_WINC), M, NGM, D}; pg8::SkOrder S; S.init(M, NGM, D, c.G, bx, false); pg8::EpiBf16<1, true, true> E{Z, NGM, RS, tab, LS, 16};
        pg8::gemm_phase<pg8::EpiBf16<1, true, true>, pg8::SkOrder, true, true>(ring, g, S, E, SKS(4));
        if (BOTH(9)) GRID_BAR(); }
    if (IN(11)) { int gcur = -1; for (int u = c.vcu; u < 1024 + 512; u += c.G) sgu_unit(c, a, u, gcur); if (BOTH(11)) GRID_BAR(); }
    if (IN(12)) {
        pg8::Gemm g{MIX, (const bf16*)(ws + WS_WOUTC), M, D, D}; pg8::SkOrder S; S.init(M, D, D, c.G, bx, false); pg8::EpiRes<false, true> E{nullptr, nullptr, XN, RS, D, MP};
        pg8::gemm_phase<pg8::EpiRes<false, true>, pg8::SkOrder, true, true>(ring, g, S, E, SKS(5));
        if (BOTH(12)) GRID_BAR(); }
    if (IN(14)) {
        pg8::Gemm g{XN, (const bf16*)(ws + WS_WUP) + (size_t)NUP * D, M, NUP, D}; pg8::SkOrder S; S.init(M, NUP, D, c.G, bx, false); pg8::EpiConvGate E{ACT, RS, tab, (LAS bf16*)(c.lds + BND_OFF), a.conv_w_ffn + (size_t)1 * 3 * NUP, a.conv_b_ffn + (size_t)1 * NUP, a.st_ffn + (size_t)1 * 32 * 2 * NUP, (float*)(ws + WS_SIDE), a.out + O_FP + (size_t)1 * 4 * 2 * NUP, a.out + O_FS + (size_t)1 * 32 * 2 * NUP};
        pg8::gemm_phase<pg8::EpiConvGate, pg8::SkOrder, true, true>(ring, g, S, E, SKS(6));
        if (BOTH(14)) GRID_BAR(); }
    if (IN(15)) { phase_ffnfix(c, a, 1); if (BOTH(15)) GRID_BAR(); }
    if (IN(16)) {
        pg8::Gemm g{ACT, (const bf16*)(ws + WS_WDN) + (size_t)D * DFF, M, D, DFF}; pg8::SkOrder S; S.init(M, D, DFF, c.G, bx, true); S.quad = MK_QUAD; pg8::EpiRes<false, true> E{nullptr, nullptr, XN, RS, D, MP};
        pg8::gemm_phase<pg8::EpiRes<false, true>, pg8::SkOrder, true, true>(ring, g, S, E, SKS(7));
        if (BOTH(16)) GRID_BAR(); }
    if (IN(17)) { phase_final(c, XN, RS, a.norm_final, a.out); }
#undef IN
#undef BOTH
}

extern "C" void kernel_launch(void* const* d_in, const int* in_sizes, int n_in, void* d_out, int out_size, void* d_ws, size_t ws_size, hipStream_t stream) {
    static int grid = 0;
    if (grid == 0) {
        if (n_in != 23 || in_sizes[0] != MP * D || (size_t)out_size != O_END || ws_size < WS_END) {
            fprintf(stderr, "kernel_launch: shape mismatch: n_in %d in0 %d out %d (want %zu) ws %zu (want %zu); nothing launched\n", n_in, n_in > 0 ? in_sizes[0] : -1, out_size, (size_t)O_END, ws_size, (size_t)WS_END); grid = -1; return; }
        int dev = 0, cus = 0, per_cu = 0;
        if (hipGetDevice(&dev) != hipSuccess || hipDeviceGetAttribute(&cus, hipDeviceAttributeMultiprocessorCount, dev) != hipSuccess) { grid = -1; return; }
        if (hipFuncSetAttribute((const void*)mk_fwd, hipFuncAttributeMaxDynamicSharedMemorySize, LDS_BYTES) != hipSuccess) { fprintf(stderr, "kernel_launch: hipFuncSetAttribute failed\n"); grid = -1; return; }
        if (hipOccupancyMaxActiveBlocksPerMultiprocessor(&per_cu, (const void*)mk_fwd, NTHR, LDS_BYTES) != hipSuccess || per_cu < 1) fprintf(stderr, "kernel_launch: occupancy query reports %d blocks per CU\n", per_cu);
        (void)hipGetLastError();
        grid = cus;
    }
    if (grid < 0) return;
    if (hipMemsetAsync((char*)d_ws + WS_CTL, 0, CTL_ZERO_BYTES, stream) != hipSuccess) { fprintf(stderr, "kernel_launch: memset failed\n"); return; }
    Args a{};
    const float* const* in = (const float* const*)d_in;
    a.x_p = in[0]; a.x_s = in[1]; a.st_conv = in[2]; a.cache_k = in[3]; a.cache_v = in[4]; a.st_ffn = in[5]; a.norm_mix = in[6]; a.norm_ffn = in[7]; a.norm_final = in[8]; a.w_in_ab = in[9];
    a.conv_w_a = in[10]; a.sinks = in[11]; a.w_out_ab = in[12]; a.w_in_c = in[13]; a.ln_g = in[14]; a.ln_b = in[15]; a.w_s = in[16]; a.b_s = in[17]; a.w_out_c = in[18]; a.w_up = in[19];
    a.conv_w_ffn = in[20]; a.conv_b_ffn = in[21]; a.w_down = in[22];
    a.out = (float*)d_out; a.ws = (unsigned char*)d_ws;
    for (int li = 0; li < N_LAUNCHES; ++li) {
        a.ph_lo = (N_LAUNCHES == 1) ? 0 : li; a.ph_hi = (N_LAUNCHES == 1) ? N_PHASES : li + 1;
        hipLaunchKernelGGL(mk_fwd, dim3(grid), dim3(NTHR), LDS_BYTES, stream, a);
        const hipError_t le = hipPeekAtLastError();
        if (le != hipSuccess) { fprintf(stderr, "kernel_launch: launch %d failed: %s\n", li, hipGetErrorName(le)); break; }
    }
}
```

```cpp
#include <hip/hip_runtime.h>
#include <cstdio>
#include <cstdint>
namespace pg8 {
#define PG8_LAS __attribute__((address_space(3)))
typedef unsigned short bf16_t;
typedef short bf16x8 __attribute__((ext_vector_type(8)));
typedef float f32x4 __attribute__((ext_vector_type(4)));
typedef unsigned u32x4 __attribute__((ext_vector_type(4)));
typedef unsigned u32x2 __attribute__((ext_vector_type(2)));
constexpr int BM = 256, BK = 64, HALF = 128, HTB = HALF * BK * 2  , STAGE_BYTES = 8 * HTB, NXCD = 8, WGM = 8;

__host__ __device__ __forceinline__ int lds_byte(int r, int c) { const int st = (r >> 4) * 2 + (c >> 5), rr = r & 15, cc = c & 31, ob = rr * 64 + cc * 2; return st * 1024 + (ob ^ (((ob >> 9) & 1) << 5)); }
__host__ __device__ __forceinline__ void stage_rc(int b, int& R, int& C) { const int st = b / 1024, sb = b % 1024, swz = sb ^ (((sb >> 9) & 1) << 5); R = (st >> 1) * 16 + swz / 64; C = (st & 1) * 32 + (swz % 64) / 2; }
__host__ __device__ __forceinline__ int perm32(int rho) { const int n = rho >> 4, i = rho & 15; return 8 * (i >> 2) + 4 * n + (i & 3); }

struct Unit { int pm, pn, k0, nt, role, par; };
struct Gemm { const bf16_t* A; const bf16_t* Bt; int M, N, K; };

struct SkOrder {
    int nM, nN, T, q, R, nDP, rem, xcd, rank, c; bool sk;
    __device__ __forceinline__ void init(int M, int N, int K, int G, int c_, bool gs = false, int Ra = 0) { gsync = gs; nM = M / BM; nN = N / BM; T = K / BK; q = (nM * nN) / NXCD; R = Ra > 0 ? Ra : G / NXCD; c = c_; xcd = c_ % NXCD; rank = c_ / NXCD;
        nDP = q / R; rem = q - nDP * R; sk = rem > 0 && 2 * rem <= R && (T % 4) == 0; }
    bool quad = false;
    bool gsync;
    __device__ __forceinline__ void unit_of(int id, Unit& u) const {
        if (quad) {
            const int x = id / q, j = id - x * q, b = x & 3, h = x >> 2, hr = nM / 2, r = j >> 5, jj = j & 31, full = hr >> 3;
            if (r < full) { u.pm = hr * h + 8 * r + (jj & 7); u.pn = 4 * b + (jj >> 3); } else { const int rest = hr - 8 * full; u.pm = hr * h + 8 * full + (jj % rest); u.pn = 4 * b + (jj / rest); } }
        else if (gsync) { const int x = id / q, j = id - x * q, gi = j / nN, ig = x * nN + (j - gi * nN); u.pm = gi * WGM + (ig & (WGM - 1)); u.pn = ig / WGM; }
        else { const int nig = WGM * nN, gid = id / nig, fm = gid * WGM, gsz = (nM - fm) < WGM ? (nM - fm) : WGM; u.pm = fm + ((id % nig) % gsz); u.pn = (id % nig) / gsz; } }
    __device__ __forceinline__ bool next(int i, Unit& u) const {
        if (rank >= R) return false;
        if (i < nDP) { unit_of(xcd * q + i * R + rank, u); u.k0 = 0; u.nt = T; u.role = 0; return true; }
        if (i > nDP) return false;
        if (sk) { if (rank >= 2 * rem) return false; unit_of(xcd * q + nDP * R + (rank >> 1), u); u.nt = T / 2; u.k0 = (rank & 1) * (T / 2); u.role = (rank & 1) ? 1 : 2; return true; }
        if (rank >= rem) return false;
        unit_of(xcd * q + nDP * R + rank, u); u.k0 = 0; u.nt = T; u.role = 0; return true;
    }
};
struct SkShare { float* slab; unsigned* flags; unsigned* tmo; };

__device__ __forceinline__ unsigned cvt_pk_bf16(float lo, float hi) { unsigned r; asm volatile("v_cvt_pk_bf16_f32 %0, %1, %2" : "=v"(r) : "v"(lo), "v"(hi)); return r; }
typedef float f32x2 __attribute__((ext_vector_type(2)));
__device__ __forceinline__ f32x2 gelu_pk(f32x2 v) {
    const f32x2 av = __builtin_elementwise_abs(v), d = av * 0.2316418882f + 1.0f;
    f32x2 t; t.x = __builtin_amdgcn_rcpf(d.x); t.y = __builtin_amdgcn_rcpf(d.y);
    f32x2 q = t * 0.5307027145f + (-0.7265760135f); q = q * t + 0.7107068705f; q = q * t + (-0.142248368f); q = q * t + 0.127414796f; q = q * t;
    const f32x2 s = (v * v) * (-0.72134752044f);
    f32x2 e; e.x = __builtin_amdgcn_exp2f(s.x); e.y = __builtin_amdgcn_exp2f(s.y);
    const f32x2 m = v * (q * e), r = v - m;
    f32x2 o; o.x = v.x < 0.f ? m.x : r.x; o.y = v.y < 0.f ? m.y : r.y; return o;
}

template <int ACT, bool RSTD, bool LNS> struct EpiBf16 {
    static constexpr bool PERM = true, AFTER_DRAIN = false, ONE_FINISH = false;
    bf16_t* O; int ldc; const float* rs; PG8_LAS float* tab; f32x2* ls; int lns_pn0;
    __device__ __forceinline__ void prep(const Unit& u, int tid) const {
        if constexpr (RSTD) {
            const int t_ = (int)threadIdx.x, row = t_ >> 1, h = t_ & 1; const f32x4* p = (const f32x4*)(rs + ((size_t)(u.pm * BM + row)) * 128 + h * 64);
            f32x4 s4 = p[0];
#pragma unroll
            for (int j = 1; j < 16; ++j) s4 += p[j];
            float s = (s4.x + s4.y) + (s4.z + s4.w); s += __shfl_xor(s, 1);
            if (h == 0) tab[u.par * BM + row] = 1.0f / sqrtf(s * (1.0f / 4096.0f) + 1e-6f);
        }
    }
    template <int MASK = 3> __device__ __forceinline__ void run(const f32x4 (&acc)[2][2][4][2], const Unit& u, int wr, int wc, int fr, int fq) const {
        const int row0 = u.pm * BM + wr * 64 + fr; const int col0 = u.pn * BM + wc * 32 + 8 * fq;
#pragma unroll
        for (int ai = 0; ai < 2; ++ai)
#pragma unroll
            for (int m = 0; m < 4; ++m) { const int row = row0 + ai * HALF + m * 16; bf16_t* rowp = O + (size_t)row * ldc + col0;
                float sc = 1.0f; if constexpr (RSTD) sc = tab[u.par * BM + wr * 64 + fr + ai * HALF + m * 16];
#pragma unroll
                for (int bj = 0; bj < 2; ++bj) { if (!((MASK >> bj) & 1)) continue; f32x4 v0 = acc[ai][bj][m][0] * sc, v1 = acc[ai][bj][m][1] * sc;
                    if (ACT == 1) { f32x2 a = gelu_pk((f32x2){v0[0], v0[1]}), b = gelu_pk((f32x2){v0[2], v0[3]}), c = gelu_pk((f32x2){v1[0], v1[1]}), d = gelu_pk((f32x2){v1[2], v1[3]});
                        v0 = (f32x4){a.x, a.y, b.x, b.y}; v1 = (f32x4){c.x, c.y, d.x, d.y}; }
                    u32x4 w; w.x = cvt_pk_bf16(v0[0], v0[1]); w.y = cvt_pk_bf16(v0[2], v0[3]); w.z = cvt_pk_bf16(v1[0], v1[1]); w.w = cvt_pk_bf16(v1[2], v1[3]);
                    *(u32x4*)(rowp + bj * HALF) = w;
                    if constexpr (LNS) { if (u.pn >= lns_pn0) {
                        float s1 = ((v0[0] + v0[1]) + (v0[2] + v0[3])) + ((v1[0] + v1[1]) + (v1[2] + v1[3]));
                        float s2 = ((v0[0] * v0[0] + v0[1] * v0[1]) + (v0[2] * v0[2] + v0[3] * v0[3])) + ((v1[0] * v1[0] + v1[1] * v1[1]) + (v1[2] * v1[2] + v1[3] * v1[3]));
                        s1 += __shfl_xor(s1, 16); s2 += __shfl_xor(s2, 16); s1 += __shfl_xor(s1, 32); s2 += __shfl_xor(s2, 32);
                        if (fq == 0) ls[(size_t)row * 128 + (u.pn - lns_pn0) * 8 + wc * 2 + bj] = (f32x2){s1, s2}; } }
                } }
    }
};
template <bool BASEF32, bool STATS> struct EpiRes {
    static constexpr bool PERM = true, AFTER_DRAIN = false, ONE_FINISH = false;
    const float* bp; const float* bs; bf16_t* xn; float* rs; int ld; int split;
    __device__ __forceinline__ void prep(const Unit&, int) const {}
    template <int MASK = 3> __device__ __forceinline__ void run(const f32x4 (&acc)[2][2][4][2], const Unit& u, int wr, int wc, int fr, int fq) const {
        const int row0 = u.pm * BM + wr * 64 + fr, col0 = u.pn * BM + wc * 32 + 8 * fq;
#pragma unroll
        for (int ai = 0; ai < 2; ++ai) {
            f32x4 b[4][2][2];
#pragma unroll
            for (int m = 0; m < 4; ++m) { const int row = row0 + ai * HALF + m * 16;
#pragma unroll
                for (int bj = 0; bj < 2; ++bj) { if (!((MASK >> bj) & 1)) continue;
                    if constexpr (BASEF32) { const float* br = (row < split ? bp + (size_t)row * ld : bs + (size_t)(row - split) * ld) + col0 + bj * HALF; b[m][bj][0] = *(const f32x4*)br; b[m][bj][1] = *(const f32x4*)(br + 4); }
                    else { const u32x4 w = *(const u32x4*)(xn + (size_t)row * ld + col0 + bj * HALF);
                        b[m][bj][0] = (f32x4){__uint_as_float(w.x << 16), __uint_as_float(w.x & 0xffff0000u), __uint_as_float(w.y << 16), __uint_as_float(w.y & 0xffff0000u)};
                        b[m][bj][1] = (f32x4){__uint_as_float(w.z << 16), __uint_as_float(w.z & 0xffff0000u), __uint_as_float(w.w << 16), __uint_as_float(w.w & 0xffff0000u)}; } } }
            asm volatile("" ::: "memory");
#pragma unroll
            for (int m = 0; m < 4; ++m) { const int row = row0 + ai * HALF + m * 16;
#pragma unroll
                for (int bj = 0; bj < 2; ++bj) { if (!((MASK >> bj) & 1)) continue;
                    const f32x4 o0 = b[m][bj][0] + acc[ai][bj][m][0], o1 = b[m][bj][1] + acc[ai][bj][m][1];
                    u32x4 w; w.x = cvt_pk_bf16(o0[0], o0[1]); w.y = cvt_pk_bf16(o0[2], o0[3]); w.z = cvt_pk_bf16(o1[0], o1[1]); w.w = cvt_pk_bf16(o1[2], o1[3]);
                    *(u32x4*)(xn + (size_t)row * ld + col0 + bj * HALF) = w;
                    if constexpr (STATS) {
                        float ss = ((o0[0] * o0[0] + o0[1] * o0[1]) + (o0[2] * o0[2] + o0[3] * o0[3])) + ((o1[0] * o1[0] + o1[1] * o1[1]) + (o1[2] * o1[2] + o1[3] * o1[3]));
                        ss += __shfl_xor(ss, 16); ss += __shfl_xor(ss, 32);
                        if (fq == 0) rs[(size_t)row * 128 + u.pn * 8 + wc * 2 + bj] = ss; }
                } }
            asm volatile("" ::: "memory");
        }
    }
};

struct EpiConvGate {
    static constexpr bool PERM = true, AFTER_DRAIN = false, ONE_FINISH = true;
    bf16_t* act; const float* rs; PG8_LAS float* tab; PG8_LAS bf16_t* bnd; const float* cw; const float* cb; const float* st; float* side; float* out_p; float* out_s;
    static constexpr int NUPC = 22016, DFFC = 11008, MPT = 32;
    __device__ __forceinline__ void prep(const Unit& u, int tid) const {
        const int t_ = (int)threadIdx.x, row = t_ >> 1, h = t_ & 1; const f32x4* p = (const f32x4*)(rs + ((size_t)(u.pm * BM + row)) * 128 + h * 64);
        f32x4 s4 = p[0];
#pragma unroll
        for (int j = 1; j < 16; ++j) s4 += p[j];
        float s = (s4.x + s4.y) + (s4.z + s4.w); s += __shfl_xor(s, 1);
        if (h == 0) tab[u.par * BM + row] = 1.0f / sqrtf(s * (1.0f / 4096.0f) + 1e-6f);
    }
    static __device__ __forceinline__ float dpp_shr1(float old, float v) { return __builtin_bit_cast(float, __builtin_amdgcn_update_dpp(__builtin_bit_cast(int, old), __builtin_bit_cast(int, v), 0x111, 0xf, 0xf, false)); }
    static __device__ __forceinline__ float dpp_shr2(float old, float v) { return __builtin_bit_cast(float, __builtin_amdgcn_update_dpp(__builtin_bit_cast(int, old), __builtin_bit_cast(int, v), 0x112, 0xf, 0xf, false)); }
    static __device__ __forceinline__ float dpp_ror1(float v) { return __builtin_bit_cast(float, __builtin_amdgcn_update_dpp(0, __builtin_bit_cast(int, v), 0x121, 0xf, 0xf, false)); }
    static __device__ __forceinline__ float dpp_ror2(float v) { return __builtin_bit_cast(float, __builtin_amdgcn_update_dpp(0, __builtin_bit_cast(int, v), 0x122, 0xf, 0xf, false)); }
    static __device__ __forceinline__ f32x4 bf4(unsigned lo, unsigned hi) { return (f32x4){__uint_as_float(lo << 16), __uint_as_float(lo & 0xffff0000u), __uint_as_float(hi << 16), __uint_as_float(hi & 0xffff0000u)}; }
    template <class T> static __device__ __forceinline__ T* at(const void* base, unsigned off) { return (T*)((const char*)base + off); }
    static __device__ __forceinline__ void taps(const f32x4& cv, const f32x4& f1, const f32x4& f2, f32x4& p1, f32x4& p2) {
#pragma unroll
        for (int e = 0; e < 4; ++e) { p1[e] = dpp_shr1(f1[e], cv[e]); p2[e] = dpp_shr2(f2[e], cv[e]); } }
    template <int AH> __device__ __forceinline__ void half_pass(const f32x4 (&acc)[2][2][4][2], const Unit& u, int wr, int fr, int lcol8, int lch, bool smp, bool seq0, int bj) const {
        const unsigned o_act = (unsigned)(fr * DFFC + lch) * 2u, o_w = (unsigned)lch * 4u;
        const unsigned o_row = (unsigned)((fr < 2 ? fr : fr - 12) * NUPC + lch) * 4u;
        const unsigned o_st = (unsigned)((fr - 14) * NUPC + lch) * 4u;
        const int cg = u.pn * 128 + 64 * bj, cu = cg + DFFC;
        const f32x4 wg0 = *at<const f32x4>(cw + cg, o_w), wg1 = *at<const f32x4>(cw + NUPC + cg, o_w), wg2 = *at<const f32x4>(cw + 2 * NUPC + cg, o_w), bg = *at<const f32x4>(cb + cg, o_w);
        const f32x4 wu0 = *at<const f32x4>(cw + cu, o_w), wu1 = *at<const f32x4>(cw + NUPC + cu, o_w), wu2 = *at<const f32x4>(cw + 2 * NUPC + cu, o_w), bu = *at<const f32x4>(cb + cu, o_w);
#pragma unroll
        for (int ai = 0; ai < 2; ++ai) { f32x4 pvg = (f32x4){0.f, 0.f, 0.f, 0.f}, pvu = pvg;
#pragma unroll
            for (int m = 0; m < 4; ++m) { const int rtu = ai * HALF + wr * 64 + m * 16, g16 = ai * 8 + wr * 4 + m;
                const float sc = tab[u.par * BM + rtu + fr];
                const bool deferred = !smp && !seq0 && g16 == 0 && fr < 2;
                const f32x4 vg_raw = acc[ai][AH][m][0] * sc, vu_raw = acc[ai][AH][m][1] * sc;
                f32x4 f1g, f2g, f1u, f2u;
                if (m == 0) { f32x4 q14g, q15g, q14u, q15u;
                    if (smp || g16 == 0) {
                        if (smp) { const float* sp = st + ((size_t)(((u.pm - MPT) * 4 + (g16 >> 2)) * 2)) * NUPC; q14g = *at<const f32x4>(sp + cg, o_w); q15g = *at<const f32x4>(sp + NUPC + cg, o_w); q14u = *at<const f32x4>(sp + cu, o_w); q15u = *at<const f32x4>(sp + NUPC + cu, o_w); }
                        else { q14g = (f32x4){0.f, 0.f, 0.f, 0.f}; q15g = q14g; q14u = q14g; q15u = q14g; }
                    } else { typedef unsigned u32x4a __attribute__((ext_vector_type(4), may_alias));
                        const PG8_LAS bf16_t* bp = bnd + (((g16 - 1) * 2) * 2 + bj) * 128 + lcol8;
                        const u32x4a a14 = *(const PG8_LAS u32x4a*)(bp), a15 = *(const PG8_LAS u32x4a*)(bp + 256);
                        q14g = bf4(a14.x, a14.y); q14u = bf4(a14.z, a14.w); q15g = bf4(a15.x, a15.y); q15u = bf4(a15.z, a15.w); }
                    f1g = q15g; f1u = q15u;
#pragma unroll
                    for (int e = 0; e < 4; ++e) { f2g[e] = fr == 0 ? q14g[e] : q15g[e]; f2u[e] = fr == 0 ? q14u[e] : q15u[e]; }
                } else {
#pragma unroll
                    for (int e = 0; e < 4; ++e) { f1g[e] = dpp_ror1(pvg[e]); f2g[e] = dpp_ror2(pvg[e]); f1u[e] = dpp_ror1(pvu[e]); f2u[e] = dpp_ror2(pvu[e]); } }
                f32x4 p1, p2; taps(vg_raw, f1g, f2g, p1, p2);
                const f32x4 vg = wg0 * p2 + wg1 * p1 + wg2 * vg_raw + bg;
                taps(vu_raw, f1u, f2u, p1, p2);
                const f32x4 vu = wu0 * p2 + wu1 * p1 + wu2 * vu_raw + bu;
                if (!deferred) { f32x4 o;
#pragma unroll
                    for (int e = 0; e < 4; ++e) o[e] = vg[e] * __builtin_amdgcn_rcpf(1.0f + __expf(-vg[e])) * vu[e];
                    f32x2 w; w.x = __builtin_bit_cast(float, cvt_pk_bf16(o[0], o[1])); w.y = __builtin_bit_cast(float, cvt_pk_bf16(o[2], o[3]));
                    *at<f32x2>(act + ((size_t)(u.pm * BM + rtu)) * DFFC + cg, o_act) = w; }
                if (!smp) {
                    if ((g16 == 0 && fr < 2) || (g16 == 15 && fr >= 14)) { float* sp = side + ((size_t)(u.pm * 4)) * NUPC; *at<f32x4>(sp + cg, o_row) = vg_raw; *at<f32x4>(sp + cu, o_row) = vu_raw; }
                    if (g16 == 15 && fr >= 14 && (u.pm & 7) == 7) { float* op = out_p + ((size_t)((u.pm >> 3) * 2)) * NUPC; *at<f32x4>(op + cg, o_st) = vg_raw; *at<f32x4>(op + cu, o_st) = vu_raw; }
                } else if (m == 3 && fr >= 14) { float* op = out_s + ((size_t)(((u.pm - MPT) * 4 + (g16 >> 2)) * 2)) * NUPC; *at<f32x4>(op + cg, o_st) = vg_raw; *at<f32x4>(op + cu, o_st) = vu_raw; }
                pvg = vg_raw; pvu = vu_raw;
                asm volatile("" ::: "memory");
            }
        }
    }
    template <int AH> __device__ __forceinline__ void image(const f32x4 (&acc)[2][2][4][2], const Unit& u, int wr, int fr, int lcol8, int bj) const {
#pragma unroll
        for (int ai = 0; ai < 2; ++ai) { constexpr int m = 3; const float sc = tab[u.par * BM + ai * HALF + wr * 64 + m * 16 + fr]; const int g16 = ai * 8 + wr * 4 + m;
            if (fr >= 14) { const f32x4 v0 = acc[ai][AH][m][0] * sc, v1 = acc[ai][AH][m][1] * sc;
                u32x4 w; w.x = cvt_pk_bf16(v0[0], v0[1]); w.y = cvt_pk_bf16(v0[2], v0[3]); w.z = cvt_pk_bf16(v1[0], v1[1]); w.w = cvt_pk_bf16(v1[2], v1[3]);
                typedef unsigned u32x4a __attribute__((ext_vector_type(4), may_alias)); *(PG8_LAS u32x4a*)(bnd + ((g16 * 2 + (fr - 14)) * 2 + bj) * 128 + lcol8) = w; } }
    }
    template <int MASK = 3> __device__ __forceinline__ void run(const f32x4 (&acc)[2][2][4][2], const Unit& u, int wr, int wc, int fr_, int fq_) const {
        int fr = fr_, fq = fq_; asm volatile("" : "+v"(fr), "+v"(fq));
        const int lcol8 = wc * 32 + 8 * fq, lch = wc * 16 + 4 * fq;
        const bool smp = u.pm >= MPT, seq0 = !smp && (u.pm & 7) == 0;
        image<0>(acc, u, wr, fr, lcol8, 0); image<1>(acc, u, wr, fr, lcol8, 1);
        asm volatile("s_waitcnt lgkmcnt(0)" ::: "memory"); __builtin_amdgcn_s_barrier(); asm volatile("" ::: "memory");
        half_pass<0>(acc, u, wr, fr, lcol8, lch, smp, seq0, 0);
        half_pass<1>(acc, u, wr, fr, lcol8, lch, smp, seq0, 1);
    }
    __device__ __forceinline__ void run_half(const f32x4 (&acc)[2][2][4][2], const Unit& u, int wr, int wc, int fr_, int fq_, int bj) const {
        int fr = fr_, fq = fq_; asm volatile("" : "+v"(fr), "+v"(fq));
        const int lcol8 = wc * 32 + 8 * fq, lch = wc * 16 + 4 * fq;
        const bool smp = u.pm >= MPT, seq0 = !smp && (u.pm & 7) == 0;
        image<0>(acc, u, wr, fr, lcol8, bj);
        asm volatile("s_waitcnt lgkmcnt(0)" ::: "memory"); __builtin_amdgcn_s_barrier(); asm volatile("" ::: "memory");
        half_pass<0>(acc, u, wr, fr, lcol8, lch, smp, seq0, bj);
    }
};

template <int MY, class Epi>
__device__ __forceinline__ void sk_finish(f32x4 (&acc)[2][2][4][2], const Unit& cur, int me, int pc, const SkShare& sk, const Epi& E, int tid, int lane, int wr, int wc, int fr, int fq) {
    int tid2 = tid; asm volatile("" : "+v"(tid2));
    const __amdgpu_buffer_rsrc_t rs = __builtin_amdgcn_make_buffer_rsrc(sk.slab + (size_t)me * 65536, 0, 262144, 0x00020000);
#pragma unroll
    for (int a = 0; a < 2; ++a)
#pragma unroll
        for (int m = 0; m < 4; ++m)
#pragma unroll
            for (int n = 0; n < 2; ++n) __builtin_amdgcn_raw_buffer_store_b128(__builtin_bit_cast(u32x4, acc[a][1 - MY][m][n]), rs, (unsigned)(((a * 4 + m) * 2 + n) * 512 + tid2) * 16u, 0, 16);
    asm volatile("s_waitcnt vmcnt(0)" ::: "memory");
    if (lane == 0) __hip_atomic_fetch_add(sk.flags + 16 * me, 1u, __ATOMIC_RELAXED, __HIP_MEMORY_SCOPE_AGENT);
    unsigned spins = 0;
    while ((unsigned)__builtin_amdgcn_readfirstlane(__hip_atomic_load(sk.flags + 16 * pc, __ATOMIC_RELAXED, __HIP_MEMORY_SCOPE_AGENT)) < 8u) {
        __builtin_amdgcn_s_sleep(1);
        if ((++spins & 255u) == 0u) { if (__builtin_amdgcn_readfirstlane(__hip_atomic_load(sk.tmo, __ATOMIC_RELAXED, __HIP_MEMORY_SCOPE_AGENT)) != 0u) break;
            if (spins > (1u << 20)) { if (lane == 0) __hip_atomic_store(sk.tmo, 1u, __ATOMIC_RELAXED, __HIP_MEMORY_SCOPE_AGENT); break; } } }
    __builtin_amdgcn_fence(__ATOMIC_ACQUIRE, "agent");
    asm volatile("s_waitcnt vmcnt(0)" ::: "memory");
    const f32x4* sp = (const f32x4*)(sk.slab + (size_t)pc * 65536) + tid2;
#pragma unroll
    for (int a = 0; a < 2; ++a) {
        f32x4 p[8];
#pragma unroll
        for (int j = 0; j < 8; ++j) p[j] = sp[(a * 8 + j) * 512];
#pragma unroll
        for (int m = 0; m < 4; ++m) { acc[a][MY][m][0] += p[2 * m]; acc[a][MY][m][1] += p[2 * m + 1]; }
        asm volatile("" : "+v"(acc[a][MY][0][0]), "+v"(acc[a][MY][0][1]), "+v"(acc[a][MY][1][0]), "+v"(acc[a][MY][1][1]), "+v"(acc[a][MY][2][0]), "+v"(acc[a][MY][2][1]), "+v"(acc[a][MY][3][0]), "+v"(acc[a][MY][3][1]) :: "memory"); }
    E.template run<(1 << MY)>(acc, cur, wr, wc, fr, fq);
}
__device__ __forceinline__ void sk_exchange(f32x4 (&acc)[2][2][4][2], int me, int pc, const SkShare& sk, int tid, int lane) {
    int tid2 = tid; asm volatile("" : "+v"(tid2));
    const __amdgpu_buffer_rsrc_t rs = __builtin_amdgcn_make_buffer_rsrc(sk.slab + (size_t)me * 65536, 0, 262144, 0x00020000);
#pragma unroll
    for (int a = 0; a < 2; ++a)
#pragma unroll
        for (int m = 0; m < 4; ++m)
#pragma unroll
            for (int n = 0; n < 2; ++n) __builtin_amdgcn_raw_buffer_store_b128(__builtin_bit_cast(u32x4, acc[a][1][m][n]), rs, (unsigned)(((a * 4 + m) * 2 + n) * 512 + tid2) * 16u, 0, 16);
    asm volatile("s_waitcnt vmcnt(0)" ::: "memory");
    if (lane == 0) __hip_atomic_fetch_add(sk.flags + 16 * me, 1u, __ATOMIC_RELAXED, __HIP_MEMORY_SCOPE_AGENT);
    unsigned spins = 0;
    while ((unsigned)__builtin_amdgcn_readfirstlane(__hip_atomic_load(sk.flags + 16 * pc, __ATOMIC_RELAXED, __HIP_MEMORY_SCOPE_AGENT)) < 8u) {
        __builtin_amdgcn_s_sleep(1);
        if ((++spins & 255u) == 0u) { if (__builtin_amdgcn_readfirstlane(__hip_atomic_load(sk.tmo, __ATOMIC_RELAXED, __HIP_MEMORY_SCOPE_AGENT)) != 0u) break;
            if (spins > (1u << 20)) { if (lane == 0) __hip_atomic_store(sk.tmo, 1u, __ATOMIC_RELAXED, __HIP_MEMORY_SCOPE_AGENT); break; } } }
    __builtin_amdgcn_fence(__ATOMIC_ACQUIRE, "agent");
    asm volatile("s_waitcnt vmcnt(0)" ::: "memory");
    const f32x4* sp = (const f32x4*)(sk.slab + (size_t)pc * 65536) + tid2;
#pragma unroll
    for (int a = 0; a < 2; ++a)
#pragma unroll
        for (int mm = 0; mm < 4; mm += 2) {
            const f32x4 p0 = sp[(a * 8 + 2 * mm + 0) * 512], p1 = sp[(a * 8 + 2 * mm + 1) * 512], p2 = sp[(a * 8 + 2 * mm + 2) * 512], p3 = sp[(a * 8 + 2 * mm + 3) * 512];
            acc[a][0][mm][0] += p0; acc[a][0][mm][1] += p1; acc[a][0][mm + 1][0] += p2; acc[a][0][mm + 1][1] += p3;
            asm volatile("" : "+v"(acc[a][0][mm][0]), "+v"(acc[a][0][mm][1]), "+v"(acc[a][0][mm + 1][0]), "+v"(acc[a][0][mm + 1][1]) :: "memory"); }
}
template <class Epi, class Sched, bool ALIGN_EPI = false, bool SP2 = false>
__device__ __forceinline__ void gemm_phase(PG8_LAS unsigned char* lds, const Gemm g, Sched& S, const Epi& E, const SkShare sk) {
    const int tid = threadIdx.x, wid = __builtin_amdgcn_readfirstlane(tid >> 6), lane = tid & 63, wr = wid >> 2, wc = wid & 3, fr = lane & 15, fq = lane >> 4;
    const int K = g.K;
    unsigned voffA[2], voffB[2];
#pragma unroll
    for (int i = 0; i < 2; ++i) { int R, C; stage_rc(tid * 16 + i * 8192, R, C); const int Rb = Epi::PERM ? ((R & ~31) + perm32(R & 31)) : R;
        voffA[i] = (unsigned)(R * K + C) * 2u; voffB[i] = (unsigned)(Rb * K + C) * 2u; }
    const size_t kstep = (size_t)(BK * 2);
    const size_t hstep = (size_t)HALF * K * 2;
    const size_t tstep = 2 * hstep;
    const unsigned ldsw = (unsigned)wid * 1024u;
    const int aoff = lds_byte(wr * 64 + fr, fq * 8), boff = lds_byte(wc * 32 + fr, fq * 8);
#define PG8_SA(b, h) (((b) * 2 + (h)) * HTB)
#define PG8_SB(b, h) ((4 + (b) * 2 + (h)) * HTB)
#define PG8_STAGE(bufoff, gbase, voff) do { _Pragma("unroll") for (int _i = 0; _i < 2; ++_i) \
        __builtin_amdgcn_global_load_lds((const unsigned*)((const char*)(gbase) + (voff)[_i]), (PG8_LAS unsigned*)(lds + (bufoff) + ldsw + _i * 8192), 16, 0, 0); } while (0)
#define PG8_LDA(dst, b, h) do { _Pragma("unroll") for (int m = 0; m < 4; ++m) _Pragma("unroll") for (int k = 0; k < 2; ++k) dst[m][k] = *(const PG8_LAS bf16x8*)(lds + PG8_SA(b, h) + aoff + m * 2048 + k * 1024); } while (0)
#define PG8_LDB(dst, b, h) do { _Pragma("unroll") for (int n = 0; n < 2; ++n) _Pragma("unroll") for (int k = 0; k < 2; ++k) dst[n][k] = *(const PG8_LAS bf16x8*)(lds + PG8_SB(b, h) + boff + n * 2048 + k * 1024); } while (0)
#define PG8_MMA(ai, bj, At, Bt) do { __builtin_amdgcn_s_setprio(1); _Pragma("unroll") for (int m = 0; m < 4; ++m) _Pragma("unroll") for (int n = 0; n < 2; ++n) _Pragma("unroll") for (int k = 0; k < 2; ++k) \
        acc[ai][bj][m][n] = __builtin_amdgcn_mfma_f32_16x16x32_bf16(Bt[n][k], At[m][k], acc[ai][bj][m][n], 0, 0, 0); __builtin_amdgcn_s_setprio(0); } while (0)
#define PG8_WAIT_V(n) asm volatile("s_waitcnt vmcnt(" #n ")" ::: "memory")
#define PG8_WAIT_L(n) asm volatile("s_waitcnt lgkmcnt(" #n ")" ::: "memory")
#define PG8_BAR __builtin_amdgcn_s_barrier()
#define PG8_SCHED __builtin_amdgcn_sched_barrier(0)
    Unit cur, nxt; int ui = 0;
    if (!S.next(0, cur)) return;
    cur.par = 0; E.prep(cur, tid);
    f32x4 acc[2][2][4][2];
#pragma unroll
    for (int a = 0; a < 2; ++a)
#pragma unroll
        for (int b = 0; b < 2; ++b)
#pragma unroll
            for (int m = 0; m < 4; ++m)
#pragma unroll
                for (int n = 0; n < 2; ++n) acc[a][b][m][n] = (f32x4){0.f, 0.f, 0.f, 0.f};
    bf16x8 At[4][2], B0[2][2], B1[2][2];
    const char* cA = (const char*)g.A + (size_t)cur.pm * tstep + (size_t)cur.k0 * kstep; const char* cB = (const char*)g.Bt + (size_t)cur.pn * tstep + (size_t)cur.k0 * kstep;
    if constexpr (SP2) {
        PG8_STAGE(PG8_SB(0, 0), cB, voffB); PG8_STAGE(PG8_SB(0, 1), cB + hstep, voffB); PG8_STAGE(PG8_SA(0, 0), cA, voffA); PG8_STAGE(PG8_SA(0, 1), cA + hstep, voffA);
        if (wr == 1) PG8_BAR;
        PG8_WAIT_V(2); PG8_BAR;
        PG8_STAGE(PG8_SB(1, 0), cB + kstep, voffB); PG8_STAGE(PG8_SA(1, 0), cA + kstep, voffA); PG8_STAGE(PG8_SB(1, 1), cB + hstep + kstep, voffB);
        PG8_WAIT_V(6); PG8_BAR;
    } else {
        PG8_STAGE(PG8_SB(0, 0), cB, voffB); PG8_STAGE(PG8_SA(0, 0), cA, voffA); PG8_STAGE(PG8_SB(0, 1), cB + hstep, voffB); PG8_STAGE(PG8_SA(0, 1), cA + hstep, voffA);
        if (wr == 1) PG8_BAR;
        PG8_WAIT_V(4); PG8_BAR;
        PG8_STAGE(PG8_SB(1, 0), cB + kstep, voffB); PG8_STAGE(PG8_SA(1, 0), cA + kstep, voffA); PG8_STAGE(PG8_SB(1, 1), cB + hstep + kstep, voffB);
        PG8_WAIT_V(6); PG8_BAR;
    }
    for (;;) {
        const bool has_next = S.next(ui + 1, nxt); nxt.par = (has_next && nxt.pm != cur.pm) ? (cur.par ^ 1) : cur.par;
        const char* nA = has_next ? (const char*)g.A + (size_t)nxt.pm * tstep + (size_t)nxt.k0 * kstep : cA; const char* nB = has_next ? (const char*)g.Bt + (size_t)nxt.pn * tstep + (size_t)nxt.k0 * kstep : cB;
        const int nt = cur.nt;
        for (int t = 0; t < nt; t += 2) {
            const bool last = (t == nt - 2);
            const char* a1 = cA + (size_t)(t + 1) * kstep;
            const char* a2 = last ? nA : cA + (size_t)(t + 2) * kstep; const char* b2 = last ? nB : cB + (size_t)(t + 2) * kstep;
            const char* a3 = a2 + kstep; const char* b3 = b2 + kstep;
            if constexpr (SP2) {
            PG8_LDB(B0, 0, 0); PG8_LDB(B1, 0, 1); PG8_SCHED; PG8_LDA(At, 0, 0); PG8_STAGE(PG8_SA(1, 1), a1 + hstep, voffA);
            PG8_WAIT_V(8); PG8_WAIT_L(0); PG8_BAR; PG8_MMA(0, 0, At, B0); PG8_MMA(0, 1, At, B1); PG8_BAR; PG8_SCHED;
            PG8_LDA(At, 0, 1); PG8_STAGE(PG8_SB(0, 0), b2, voffB); PG8_STAGE(PG8_SB(0, 1), b2 + hstep, voffB); PG8_STAGE(PG8_SA(0, 0), a2, voffA);
            PG8_WAIT_V(8); PG8_WAIT_L(0); PG8_BAR; PG8_MMA(1, 0, At, B0); PG8_MMA(1, 1, At, B1); PG8_BAR; PG8_SCHED;
            PG8_LDB(B0, 1, 0); PG8_LDB(B1, 1, 1); PG8_SCHED; PG8_LDA(At, 1, 0); PG8_STAGE(PG8_SA(0, 1), a2 + hstep, voffA);
            PG8_WAIT_V(8); PG8_WAIT_L(0); PG8_BAR; PG8_MMA(0, 0, At, B0); PG8_MMA(0, 1, At, B1); PG8_BAR; PG8_SCHED;
            PG8_LDA(At, 1, 1); PG8_STAGE(PG8_SB(1, 0), b3, voffB); PG8_STAGE(PG8_SB(1, 1), b3 + hstep, voffB); PG8_STAGE(PG8_SA(1, 0), a3, voffA);
            PG8_WAIT_V(8); PG8_WAIT_L(0); PG8_BAR; PG8_MMA(1, 0, At, B0); PG8_MMA(1, 1, At, B1); PG8_BAR; PG8_SCHED;
            } else {
            PG8_LDB(B0, 0, 0); PG8_SCHED; PG8_LDA(At, 0, 0); PG8_STAGE(PG8_SA(1, 1), a1 + hstep, voffA);
            PG8_WAIT_L(8); PG8_BAR; PG8_WAIT_L(0); PG8_MMA(0, 0, At, B0); PG8_BAR; PG8_SCHED;
            PG8_LDB(B1, 0, 1); PG8_STAGE(PG8_SB(0, 0), b2, voffB);
            PG8_BAR; PG8_WAIT_L(0); PG8_MMA(0, 1, At, B1); PG8_BAR;
            PG8_LDA(At, 0, 1); PG8_STAGE(PG8_SA(0, 0), a2, voffA);
            PG8_BAR; PG8_WAIT_L(0); PG8_MMA(1, 0, At, B0); PG8_BAR; PG8_SCHED;
            PG8_STAGE(PG8_SB(0, 1), b2 + hstep, voffB);
            PG8_WAIT_V(6); PG8_BAR; PG8_MMA(1, 1, At, B1); PG8_BAR;
            PG8_LDB(B0, 1, 0); PG8_SCHED; PG8_LDA(At, 1, 0); PG8_STAGE(PG8_SA(0, 1), a2 + hstep, voffA);
            PG8_WAIT_L(8); PG8_BAR; PG8_WAIT_L(0); PG8_MMA(0, 0, At, B0); PG8_BAR; PG8_SCHED;
            PG8_LDB(B1, 1, 1); PG8_STAGE(PG8_SB(1, 0), b3, voffB);
            PG8_BAR; PG8_WAIT_L(0); PG8_MMA(0, 1, At, B1); PG8_BAR;
            PG8_LDA(At, 1, 1); PG8_STAGE(PG8_SA(1, 0), a3, voffA);
            PG8_BAR; PG8_WAIT_L(0); PG8_MMA(1, 0, At, B0); PG8_BAR; PG8_SCHED;
            PG8_STAGE(PG8_SB(1, 1), b3 + hstep, voffB);
            PG8_WAIT_V(6); PG8_BAR; PG8_MMA(1, 1, At, B1); PG8_BAR;
            }
        }
        if constexpr (ALIGN_EPI) { if (wr == 0) PG8_BAR; }
        if (cur.role != 0) break;
        E.template run<3>(acc, cur, wr, wc, fr, fq);
        if (!has_next) break;
        if (nxt.pm != cur.pm) E.prep(nxt, tid);
#pragma unroll
        for (int a = 0; a < 2; ++a)
#pragma unroll
            for (int b = 0; b < 2; ++b)
#pragma unroll
                for (int m = 0; m < 4; ++m)
#pragma unroll
                    for (int n = 0; n < 2; ++n) acc[a][b][m][n] = (f32x4){0.f, 0.f, 0.f, 0.f};
        cur = nxt; cA = nA; cB = nB; ++ui;
        if constexpr (ALIGN_EPI) { if (wr == 1) PG8_BAR; }
    }
    PG8_WAIT_V(0);
    if constexpr (!ALIGN_EPI) { if (wr == 0) PG8_BAR; }
    PG8_BAR;
    if constexpr (Epi::ONE_FINISH) {
        if (cur.role != 0) { const int my = cur.role == 2 ? 0 : 1;
            if (my == 1) {
#pragma unroll
                for (int a = 0; a < 2; ++a)
#pragma unroll
                    for (int m = 0; m < 4; ++m)
#pragma unroll
                        for (int n = 0; n < 2; ++n) { const f32x4 t = acc[a][0][m][n]; acc[a][0][m][n] = acc[a][1][m][n]; acc[a][1][m][n] = t; } }
            sk_exchange(acc, S.c, my == 0 ? S.c + NXCD : S.c - NXCD, sk, tid, lane);
            E.run_half(acc, cur, wr, wc, fr, fq, my); }
    } else {
        if (cur.role == 2) sk_finish<0>(acc, cur, S.c, S.c + NXCD, sk, E, tid, lane, wr, wc, fr, fq);
        else if (cur.role == 1) sk_finish<1>(acc, cur, S.c, S.c - NXCD, sk, E, tid, lane, wr, wc, fr, fq);
    }
#undef PG8_SA
#undef PG8_SB
#undef PG8_STAGE
#undef PG8_LDA
#undef PG8_LDB
#undef PG8_MMA
#undef PG8_WAIT_V
#undef PG8_WAIT_L
#undef PG8_BAR
#undef PG8_SCHED
}
}

#define GAS __attribute__((address_space(1)))
#define LAS __attribute__((address_space(3)))
typedef unsigned short bf16;
typedef unsigned v4u __attribute__((ext_vector_type(4)));
typedef float f32x4 __attribute__((ext_vector_type(4)));
typedef short bf16x8 __attribute__((ext_vector_type(8)));
typedef GAS unsigned gu32;
typedef GAS unsigned long long gu64;
#define RLX_AGENT __ATOMIC_RELAXED, __HIP_MEMORY_SCOPE_AGENT
#define LDS_WAIT() asm volatile("s_waitcnt lgkmcnt(0)" ::: "memory")
#define VM_WAIT() asm volatile("s_waitcnt vmcnt(0)" ::: "memory")
__device__ __forceinline__ unsigned long long rt() { return __builtin_amdgcn_s_memrealtime(); }

#define XB_TMO      128
#define XB_XCNT(j)  (256  + 64 * (j))
#define XB_XSUB(j)  (1280 + 64 * (j))
#define XB_XGEN(j)  (2304 + 64 * (j))
#define XB_TOP      3328
#define XB_TOPGEN   3392
#define XCD_BAR_WORDS 3456
#define XB_SPIN_CAP (1u << 18)

__device__ __forceinline__ unsigned xb_ld(unsigned* p)              { return __hip_atomic_load(p, __ATOMIC_RELAXED, __HIP_MEMORY_SCOPE_AGENT); }
__device__ __forceinline__ unsigned xb_add(unsigned* p, unsigned v) { return __hip_atomic_fetch_add(p, v, __ATOMIC_RELAXED, __HIP_MEMORY_SCOPE_AGENT); }
__device__ __forceinline__ unsigned xb_xcc_id() { return (unsigned)__builtin_amdgcn_s_getreg((3 << 11) | 20) & 0xFu; }
#define XB_SPIN(cond, bar) do { unsigned _sp = 0; while (cond) { __builtin_amdgcn_s_sleep(1); \
    if ((++_sp & 255u) == 0u) { if (xb_ld(&(bar)[XB_TMO])) break; if (_sp > XB_SPIN_CAP) { atomicAdd(&(bar)[XB_TMO], 1u); break; } } } } while (0)

struct XcdBarrier {
    unsigned* bar; unsigned x;
    volatile LAS unsigned* st;
};

__device__ __forceinline__ XcdBarrier xcd_barrier_post(unsigned* bar, volatile LAS unsigned* st) {
    XcdBarrier b; b.bar = bar; b.x = xb_xcc_id(); b.st = st;
    if (threadIdx.x == 0) (void)xb_add(&bar[XB_XCNT(b.x)], 1u);
    return b;
}
__device__ __forceinline__ void xcd_barrier_complete(unsigned* bar, unsigned x, unsigned& nloc, unsigned& nx) {
    const unsigned G = gridDim.x * gridDim.y * gridDim.z;
    unsigned sum, cnt, mine, sp = 0u;
    for (;;) {
        sum = 0u; cnt = 0u; mine = 0u;
#pragma unroll
        for (unsigned j = 0; j < 16; ++j) { const unsigned c = xb_ld(&bar[XB_XCNT(j)]); sum += c; cnt += (c > 0u) ? 1u : 0u; mine = (j == x) ? c : mine; }
        if (sum == G) break;
        __builtin_amdgcn_s_sleep(1);
        if ((++sp & 255u) == 0u) { if (xb_ld(&bar[XB_TMO])) break; if (sp > XB_SPIN_CAP) { atomicAdd(&bar[XB_TMO], 1u); break; } }
    }
    nloc = mine > 0u ? mine : 1u; nx = cnt > 0u ? cnt : 1u;
}

__device__ __forceinline__ void xcd_barrier(const XcdBarrier& b) {
    asm volatile("s_waitcnt vmcnt(0)" ::: "memory");
    __syncthreads();
    if (threadIdx.x == 0) {
        unsigned* bar = b.bar;
        __builtin_amdgcn_s_waitcnt(0);
        unsigned nloc = b.st[0], nx = b.st[1];
        if (nloc == 0u) { xcd_barrier_complete(bar, b.x, nloc, nx); b.st[0] = nloc; b.st[1] = nx; }
        const unsigned old = xb_add(&bar[XB_XSUB(b.x)], 1u);
        const unsigned gen = old / nloc;
        if (old + 1u == (gen + 1u) * nloc) {
            __builtin_amdgcn_fence(__ATOMIC_RELEASE, "agent");
            asm volatile("s_waitcnt vmcnt(0)" ::: "memory");
            const unsigned og = xb_add(&bar[XB_TOP], 1u);
            const unsigned tg = og / nx;
            if (og + 1u == (tg + 1u) * nx) xb_add(&bar[XB_TOPGEN], 1u);
            else XB_SPIN(xb_ld(&bar[XB_TOPGEN]) == tg, bar);
            __builtin_amdgcn_fence(__ATOMIC_ACQUIRE, "agent");
            xb_add(&bar[XB_XGEN(b.x)], 1u);
            asm volatile("s_waitcnt vmcnt(0)" ::: "memory");
        } else {
            XB_SPIN(xb_ld(&bar[XB_XGEN(b.x)]) == gen, bar);
            __builtin_amdgcn_fence(__ATOMIC_ACQUIRE, "agent");
            asm volatile("s_waitcnt vmcnt(0)" ::: "memory");
        }
    }
    __syncthreads();
}

constexpr int NWAVES = 8, NTHR = 512;
#ifndef MK_N_LAUNCHES
#define MK_N_LAUNCHES 1
#endif
constexpr int N_PHASES = 18;
constexpr int N_LAUNCHES = MK_N_LAUNCHES;
constexpr int D = 4096, MP = 8192, MS = 2048, M = MP + MS;
constexpr int CONVD = 2048, NPROJ = 9216, DFF = 11008, NUP = 22016, NGM = 8192;
constexpr int OFF_GB = 0, OFF_GC = 2048, OFF_HV = 4096, OFF_Q = 6144, OFF_K = 8192, OFF_V = 8704;
constexpr float RMS_EPS = 1e-6f, LN_EPS = 1e-5f;
constexpr size_t O_YP = 0, O_YS = O_YP + (size_t)MP * D, O_CP = O_YS + (size_t)MS * D, O_CS = O_CP + 4 * 2 * 2048, O_KP = O_CS + 32 * 2 * 2048, O_KS = O_KP + 4 * 128 * 512,
                 O_VP = O_KS + 32 * 128 * 512, O_VS = O_VP + 4 * 128 * 512, O_FP = O_VS + 32 * 128 * 512, O_FS = O_FP + (size_t)2 * 4 * 2 * NUP, O_GV = O_FS + (size_t)2 * 32 * 2 * NUP,
                 O_END = O_GV + (size_t)MS * D;
constexpr size_t MiB = 1u << 20;
constexpr size_t WS_CTL = 0, CTL_ZERO_BYTES = 1 * MiB;
constexpr size_t WS_WIN = 1 * MiB, WS_WOUT = WS_WIN + (size_t)NPROJ * D * 2, WS_WINC = WS_WOUT + (size_t)D * D * 2, WS_WOUTC = WS_WINC + (size_t)NGM * D * 2,
                 WS_WUP = WS_WOUTC + (size_t)D * D * 2, WS_WDN = WS_WUP + (size_t)2 * NUP * D * 2, WS_XN = WS_WDN + (size_t)2 * D * DFF * 2,
                 WS_PROJ = WS_XN + (size_t)M * D * 2, WS_MIX = WS_PROJ + (size_t)M * NPROJ * 2, WS_X = WS_MIX + (size_t)M * D * 2, WS_UP = WS_X + (size_t)M * D * 4,
                 WS_ACT = WS_UP + (size_t)M * NUP * 2, WS_Z = WS_ACT + (size_t)M * DFF * 2, WS_VLN = WS_Z + (size_t)M * NGM * 2, WS_RS = WS_VLN + (size_t)M * D * 2, WS_LS = WS_RS + (size_t)M * 128 * 4, WS_RSTD = WS_LS + (size_t)M * 128 * 8, WS_SLAB = WS_RSTD + (size_t)M * 4, WS_SIDE = WS_SLAB + (size_t)2 * 256 * 262144, WS_END = WS_SIDE + (size_t)32 * 4 * NUP * 4;
constexpr int CW_BAR = 4096, CW_SK = 16384;
constexpr int RING_OFF = 0, RING_BYTES = 131072, LDSCTL_OFF = RING_BYTES, MISC_OFF = LDSCTL_OFF + 320, TAB_OFF = LDSCTL_OFF + 1024  , BND_OFF = TAB_OFF + 2048  , LDS_BYTES = BND_OFF + 16384;

typedef unsigned short bf16;
typedef unsigned u32x4 __attribute__((ext_vector_type(4)));
typedef unsigned u32x2 __attribute__((ext_vector_type(2)));
typedef float f32x4 __attribute__((ext_vector_type(4)));
typedef float f32x16 __attribute__((ext_vector_type(16)));
typedef short bf16x8 __attribute__((ext_vector_type(8)));
typedef short s16x4 __attribute__((ext_vector_type(4)));
#define LDS_WAIT() asm volatile("s_waitcnt lgkmcnt(0)" ::: "memory")
#define MFMA32(a, b, c) __builtin_amdgcn_mfma_f32_32x32x16_bf16((a), (b), (c), 0, 0, 0)

struct Args {
    const float *x_p, *x_s, *st_conv, *cache_k, *cache_v, *st_ffn, *norm_mix, *norm_ffn, *norm_final, *w_in_ab, *conv_w_a, *sinks, *w_out_ab, *w_in_c, *ln_g, *ln_b, *w_s, *b_s, *w_out_c,
        *w_up, *conv_w_ffn, *conv_b_ffn, *w_down;
    float* out; unsigned char* ws; int ph_lo, ph_hi;
};

__device__ __forceinline__ float bflo(unsigned w) { return __uint_as_float(w << 16); }
__device__ __forceinline__ float bfhi(unsigned w) { return __uint_as_float(w & 0xffff0000u); }
__device__ __forceinline__ unsigned pk2(float lo, float hi) { return pg8::cvt_pk_bf16(lo, hi); }
__device__ __forceinline__ void unpack8(const u32x4 w, float (&f)[8]) { f[0] = bflo(w.x); f[1] = bfhi(w.x); f[2] = bflo(w.y); f[3] = bfhi(w.y); f[4] = bflo(w.z); f[5] = bfhi(w.z); f[6] = bflo(w.w); f[7] = bfhi(w.w); }
__device__ __forceinline__ u32x4 pack8(const float (&f)[8]) { u32x4 w; w.x = pk2(f[0], f[1]); w.y = pk2(f[2], f[3]); w.z = pk2(f[4], f[5]); w.w = pk2(f[6], f[7]); return w; }
__device__ __forceinline__ void load8f(const float* p, float (&f)[8]) { const f32x4 a = *(const f32x4*)p, b = *(const f32x4*)(p + 4); f[0] = a.x; f[1] = a.y; f[2] = a.z; f[3] = a.w; f[4] = b.x; f[5] = b.y; f[6] = b.z; f[7] = b.w; }
__device__ __forceinline__ void store8f(float* p, const float (&f)[8]) { *(f32x4*)p = (f32x4){f[0], f[1], f[2], f[3]}; *(f32x4*)(p + 4) = (f32x4){f[4], f[5], f[6], f[7]}; }
__device__ __forceinline__ float wave_sum(float v) {
#pragma unroll
    for (int o = 1; o < 64; o <<= 1) v += __shfl_xor(v, o);
    return v;
}
__device__ __forceinline__ int crow(int r, int hi) { return (r & 3) + 8 * (r >> 2) + 4 * hi; }

__device__ __forceinline__ void p0_load_item(const float* W, const float* gain, int N, int item, int lane, f32x4 (&v)[8]) {
    const int nblk = N / 32, kb = item / nblk, nb = item % nblk;
    const float* src = W + (size_t)(64 * kb + 8 * (lane >> 3)) * N + 32 * nb + 4 * (lane & 7);
#pragma unroll
    for (int i = 0; i < 8; ++i) v[i] = __builtin_nontemporal_load((const f32x4*)(src + (size_t)i * N));
    if (gain) { float gk[8]; load8f(gain + 64 * kb + 8 * (lane >> 3), gk);
#pragma unroll
        for (int i = 0; i < 8; ++i) v[i] = v[i] * gk[i]; }
}
template <bool PERMUP> __device__ __forceinline__ void p0_store_item(bf16* WT, int K, int N, int item, int lane, const f32x4 (&v)[8]) {
    const int nblk = N / 32, kb = item / nblk, nb = item % nblk;
    int rowb = 32 * nb + 4 * (lane & 7);
    if (PERMUP) { const int s0 = 32 * nb, hf = s0 >= DFF ? 1 : 0, ch = s0 - hf * DFF + 4 * (lane & 7), t = ch >> 7, ct = ch & 127;
        rowb = 256 * t + 128 * (ct >> 6) + 32 * ((ct >> 4) & 3) + 8 * ((ct >> 2) & 3) + 4 * hf; }
    bf16* dst = WT + (size_t)rowb * K + 64 * kb + 8 * (lane >> 3);
#pragma unroll
    for (int j = 0; j < 4; ++j) { u32x4 o; o.x = pk2(v[0][j], v[1][j]); o.y = pk2(v[2][j], v[3][j]); o.z = pk2(v[4][j], v[5][j]); o.w = pk2(v[6][j], v[7][j]);
        *(u32x4*)(dst + (size_t)j * K) = o; }
}
template <int NI, bool PERMUP = false> __device__ __forceinline__ void p0_transpose(const float* W, const float* gain, int K, int N, bf16* WT, int gw, int NGW, int lane) {
    const int nitems = (K / 64) * (N / 32);
    for (int it = gw; it < nitems; it += NI * NGW) {
        f32x4 v[NI][8];
#pragma unroll
        for (int j = 0; j < NI; ++j) { const int itj = it + j * NGW; if (itj < nitems) p0_load_item(W, gain, N, itj, lane, v[j]); }
#pragma unroll
        for (int j = 0; j < NI; ++j) { const int itj = it + j * NGW; if (itj < nitems) p0_store_item<PERMUP>(WT, K, N, itj, lane, v[j]); }
    }
}
__device__ __forceinline__ void final_row2(const float* x0, const float* x1, const float* rs0, const float* rs1, const float* g, float* o0, float* o1, bool two, int lane) {
    const float s = wave_sum(rs0[lane] + rs0[64 + lane]), t = wave_sum(rs1[lane] + rs1[64 + lane]);
    const float ra = 1.0f / sqrtf(s * (1.f / D) + RMS_EPS), rb = 1.0f / sqrtf(t * (1.f / D) + RMS_EPS);
    const f32x4* xr0 = (const f32x4*)x0 + lane; const f32x4* xr1 = (const f32x4*)x1 + lane; const f32x4* gr = (const f32x4*)g + lane;
#pragma unroll
    for (int j = 0; j < 16; ++j) { const f32x4 gg = gr[64 * j]; const f32x4 y = __builtin_nontemporal_load(xr0 + 64 * j) * ra * gg; __builtin_nontemporal_store(y, (f32x4*)o0 + lane + 64 * j);
        if (two) { const f32x4 z = __builtin_nontemporal_load(xr1 + 64 * j) * rb * gg; __builtin_nontemporal_store(z, (f32x4*)o1 + lane + 64 * j); } }
}
template <bool OUTF> __device__ __forceinline__ void rms_row2(const float* x0, const float* x1, const float* g, void* o0, void* o1, bool two, int lane) {
    const f32x4* xr0 = (const f32x4*)x0 + lane; const f32x4* xr1 = (const f32x4*)x1 + lane;
    f32x4 v[16], w[16]; float s = 0.f, t = 0.f;
#pragma unroll
    for (int j = 0; j < 16; ++j) v[j] = OUTF ? __builtin_nontemporal_load(xr0 + 64 * j) : xr0[64 * j];
    if (two) {
#pragma unroll
        for (int j = 0; j < 16; ++j) w[j] = OUTF ? __builtin_nontemporal_load(xr1 + 64 * j) : xr1[64 * j];
    } else {
#pragma unroll
        for (int j = 0; j < 16; ++j) w[j] = (f32x4){0.f, 0.f, 0.f, 0.f};
    }
#pragma unroll
    for (int j = 0; j < 16; ++j) { s += (v[j].x * v[j].x + v[j].y * v[j].y) + (v[j].z * v[j].z + v[j].w * v[j].w); t += (w[j].x * w[j].x + w[j].y * w[j].y) + (w[j].z * w[j].z + w[j].w * w[j].w); }
    const float rs = 1.0f / sqrtf(wave_sum(s) * (1.f / D) + RMS_EPS), rt = 1.0f / sqrtf(wave_sum(t) * (1.f / D) + RMS_EPS);
    const f32x4* gr = (const f32x4*)g + lane;
#pragma unroll
    for (int j = 0; j < 16; ++j) { const f32x4 gg = gr[64 * j]; const f32x4 y = v[j] * rs * gg, z = w[j] * rt * gg;
        if (OUTF) { __builtin_nontemporal_store(y, (f32x4*)o0 + lane + 64 * j); if (two) __builtin_nontemporal_store(z, (f32x4*)o1 + lane + 64 * j); }
        else { u32x2 a; a.x = pk2(y.x, y.y); a.y = pk2(y.z, y.w); ((u32x2*)o0 + lane)[64 * j] = a; if (two) { u32x2 b; b.x = pk2(z.x, z.y); b.y = pk2(z.z, z.w); ((u32x2*)o1 + lane)[64 * j] = b; } } }
}
struct Ctx { int tid, lane, wave, vcu, G; LAS unsigned char* lds; };

__device__ __forceinline__ void phase_rms(const Ctx& c, const float* xp, const float* xs, const float* g, bf16* XN) {
    const int gw = c.vcu * NWAVES + c.wave, NGW = c.G * NWAVES;
    for (int m = gw; m < M; m += 2 * NGW) { const int m2 = m + NGW; const bool two = m2 < M; const int mm = two ? m2 : m;
        const float* x0 = m < MP ? xp + (size_t)m * D : xs + (size_t)(m - MP) * D; const float* x1 = mm < MP ? xp + (size_t)mm * D : xs + (size_t)(mm - MP) * D;
        rms_row2<false>(x0, x1, g, XN + (size_t)m * D, XN + (size_t)mm * D, two, c.lane); }
}
__device__ __forceinline__ void phase_final(const Ctx& c, const bf16* X, const float* RS, const float* g, float* out) {
    const int rpbn = (M + c.G - 1) / c.G, r0 = c.vcu * rpbn, rpb = r0 >= M ? 0 : (M - r0 < rpbn ? M - r0 : rpbn);
    LAS float* tab = (LAS float*)(c.lds + TAB_OFF);
    for (int r = c.wave; r < rpb; r += NWAVES) { const float* rs = RS + (size_t)(r0 + r) * 128; const float s = wave_sum(rs[c.lane] + rs[64 + c.lane]); if (c.lane == 0) tab[r] = 1.0f / sqrtf(s * (1.f / D) + RMS_EPS); }
    __syncthreads();
    const u32x4* xp = (const u32x4*)(X + (size_t)r0 * D); float* op = out + O_YP + (size_t)r0 * D;
    const int n8 = rpb * (D / 8);
    for (int i0 = c.tid; i0 < n8; i0 += 16 * NTHR) {
        u32x4 v[16];
#pragma unroll
        for (int j = 0; j < 16; ++j) { const int i = i0 + j * NTHR; if (i < n8) v[j] = __builtin_nontemporal_load(xp + i); }
#pragma unroll
        for (int j = 0; j < 16; ++j) { const int i = i0 + j * NTHR; if (i < n8) { const float rs = tab[i >> 9]; float f[8], gg[8]; unpack8(v[j], f); load8f(g + (i & 511) * 8, gg);
#pragma unroll
                for (int e = 0; e < 8; ++e) f[e] = f[e] * rs * gg[e];
                __builtin_nontemporal_store((f32x4){f[0], f[1], f[2], f[3]}, (f32x4*)(op + (size_t)i * 8)); __builtin_nontemporal_store((f32x4){f[4], f[5], f[6], f[7]}, (f32x4*)(op + (size_t)i * 8 + 4)); } }
    }
    __syncthreads();
}
template <int NI> __device__ __forceinline__ void convert_weights(const Args& a, int which, int gw, int NGW, int lane) {
    unsigned char* ws = a.ws;
    if (which & 1) p0_transpose<NI>(a.w_in_ab, nullptr, D, NPROJ, (bf16*)(ws + WS_WIN), gw, NGW, lane);
    if (which & 2) p0_transpose<NI>(a.w_out_ab, nullptr, D, D, (bf16*)(ws + WS_WOUT), gw, NGW, lane);
    if (which & 4) p0_transpose<NI, true>(a.w_up, a.norm_ffn, D, NUP, (bf16*)(ws + WS_WUP), gw, NGW, lane);
    if (which & 8) p0_transpose<NI>(a.w_down, nullptr, DFF, D, (bf16*)(ws + WS_WDN), gw, NGW, lane);
    if (which & 16) p0_transpose<NI>(a.w_in_c, a.norm_mix + D, D, NGM, (bf16*)(ws + WS_WINC), gw, NGW, lane);
    if (which & 32) p0_transpose<NI>(a.w_out_c, nullptr, D, D, (bf16*)(ws + WS_WOUTC), gw, NGW, lane);
    if (which & 64) p0_transpose<NI, true>(a.w_up + (size_t)D * NUP, a.norm_ffn + D, D, NUP, (bf16*)(ws + WS_WUP) + (size_t)NUP * D, gw, NGW, lane);
    if (which & 128) p0_transpose<NI>(a.w_down + (size_t)DFF * D, nullptr, DFF, D, (bf16*)(ws + WS_WDN) + (size_t)D * DFF, gw, NGW, lane);
}
__device__ __forceinline__ void phase_prologue(const Ctx& c, const Args& a) {
#ifndef MK_QUAD
#define MK_QUAD true
#endif
#ifndef MK_P2_CONV
#define MK_P2_CONV 254
#endif
    convert_weights<2>(a, 255 & ~MK_P2_CONV, c.vcu * NWAVES + c.wave, c.G * NWAVES, c.lane);
    phase_rms(c, a.x_p, a.x_s, a.norm_mix, (bf16*)(a.ws + WS_XN));
}

__device__ __forceinline__ void mix0_conv(const Ctx& c, const Args& a) {
    const bf16* PROJ = (const bf16*)(a.ws + WS_PROJ); bf16* MIX = (bf16*)(a.ws + WS_MIX);
    const int gt = c.vcu * NTHR + c.tid, NT = c.G * NTHR;
    for (int it = gt; it < (M / 16) * 256; it += NT) {
        const int cc = it & 255, rb = it >> 8, r0 = rb * 16, ch = cc * 8;
        const bool smp = r0 >= MP; const int t0 = smp ? ((r0 - MP) & 63) : (r0 & 2047), T = smp ? 64 : 2048, b = smp ? ((r0 - MP) >> 6) : (r0 >> 11);
        float w0[8], w1[8], w2[8], p2[8], p1[8];
        load8f(a.conv_w_a + ch, w0); load8f(a.conv_w_a + CONVD + ch, w1); load8f(a.conv_w_a + 2 * CONVD + ch, w2);
        if (t0 == 0) {
            if (smp) { load8f(a.st_conv + (size_t)(b * 2 + 0) * CONVD + ch, p2); load8f(a.st_conv + (size_t)(b * 2 + 1) * CONVD + ch, p1); }
            else {
#pragma unroll
                for (int e = 0; e < 8; ++e) { p2[e] = 0.f; p1[e] = 0.f; } }
        } else {
            float gc[8], hv[8];
            const bf16* pr = PROJ + (size_t)(r0 - 2) * NPROJ + ch;
            unpack8(*(const u32x4*)(pr + OFF_GC), gc); unpack8(*(const u32x4*)(pr + OFF_HV), hv);
#pragma unroll
            for (int e = 0; e < 8; ++e) p2[e] = gc[e] * hv[e];
            pr += NPROJ;
            unpack8(*(const u32x4*)(pr + OFF_GC), gc); unpack8(*(const u32x4*)(pr + OFF_HV), hv);
#pragma unroll
            for (int e = 0; e < 8; ++e) p1[e] = gc[e] * hv[e];
        }
        float* so = a.out + (smp ? O_CS : O_CP) + (size_t)b * 2 * CONVD + ch;
#pragma unroll 1
        for (int i0 = 0; i0 < 16; i0 += 8) {
            u32x4 rb[8], rc[8], rh[8];
#pragma unroll
            for (int i = 0; i < 8; ++i) { const bf16* pr = PROJ + (size_t)(r0 + i0 + i) * NPROJ + ch; rb[i] = *(const u32x4*)(pr + OFF_GB); rc[i] = *(const u32x4*)(pr + OFF_GC); rh[i] = *(const u32x4*)(pr + OFF_HV); }
#pragma unroll
            for (int i = 0; i < 8; ++i) {
                float gb[8], gc[8], hv[8], cur[8], o[8];
                unpack8(rb[i], gb); unpack8(rc[i], gc); unpack8(rh[i], hv);
#pragma unroll
                for (int e = 0; e < 8; ++e) { cur[e] = gc[e] * hv[e]; o[e] = gb[e] * (w0[e] * p2[e] + w1[e] * p1[e] + w2[e] * cur[e]); }
                *(u32x4*)(MIX + (size_t)(r0 + i0 + i) * D + ch) = pack8(o);
                const int j = t0 + i0 + i - (T - 2);
                if (j >= 0) store8f(so + (size_t)j * CONVD, cur);
#pragma unroll
                for (int e = 0; e < 8; ++e) { p2[e] = p1[e]; p1[e] = cur[e]; }
            }
        }
    }
}
__device__ __forceinline__ void mix0_kvstate(const Ctx& c, const Args& a) {
    const bf16* PROJ = (const bf16*)(a.ws + WS_PROJ);
    const int gt = c.vcu * NTHR + c.tid, NT = c.G * NTHR;
    constexpr int NP = 4 * 128 * 64, NS = 32 * 128 * 64;
    for (int it = gt; it < 2 * (NP + NS); it += NT) {
        const int isv = it >= (NP + NS); int r = isv ? it - (NP + NS) : it;
        const int off = isv ? OFF_V : OFF_K; float f[8]; float* o;
        if (r < NP) { const int e8 = r & 63, j = (r >> 6) & 127, b = r >> 13;
            unpack8(*(const u32x4*)(PROJ + (size_t)(b * 2048 + 1920 + j) * NPROJ + off + e8 * 8), f);
            o = a.out + (isv ? O_VP : O_KP) + (size_t)r * 8;
        } else { r -= NP; const int e8 = r & 63, j = (r >> 6) & 127, b = r >> 13;
            if (j < 64) load8f((isv ? a.cache_v : a.cache_k) + ((size_t)(b * 128 + 64 + j) * 512 + e8 * 8), f);
            else unpack8(*(const u32x4*)(PROJ + (size_t)(MP + b * 64 + (j - 64)) * NPROJ + off + e8 * 8), f);
            o = a.out + (isv ? O_VS : O_KS) + (size_t)r * 8;
        }
        store8f(o, f);
    }
}
constexpr int KS_PITCH = 72, VT_PITCH = 200;
__device__ __forceinline__ void attn_unit(const Ctx& c, const Args& a, int unit) {
    const bf16* PROJ = (const bf16*)(a.ws + WS_PROJ); bf16* MIX = (bf16*)(a.ws + WS_MIX);
    const int tid = c.tid, wid = c.wave, lane = c.lane, l32 = lane & 31, hi = lane >> 5;
    const int ch = unit >> 3, kvh = unit & 7;
    LAS bf16* Ks = (LAS bf16*)(c.lds + RING_OFF); LAS bf16* Vt = (LAS bf16*)(c.lds + RING_OFF + 192 * KS_PITCH * 2);
    const bool smp = ch >= 128; int b, qrow0, jmin;
    if (!smp) { b = ch >> 5; const int cq = ch & 31; qrow0 = b * 2048 + cq * 64; jmin = cq >= 2 ? 0 : (2 - cq) * 64; } else { b = ch - 128; qrow0 = MP + b * 64; jmin = 0; }
    const int h = kvh * 4 + (wid >> 1), tq = 32 * (wid & 1) + l32;
    u32x4 qraw[4];
    { const bf16* qp = PROJ + (size_t)(qrow0 + tq) * NPROJ + OFF_Q + h * 64 + 8 * hi;
#pragma unroll
      for (int ks = 0; ks < 4; ++ks) qraw[ks] = *(const u32x4*)(qp + 16 * ks); }
#pragma unroll
    for (int i = 0; i < 3; ++i) {
        const int ci = tid + NTHR * i, j = ci >> 3, cc = ci & 7; u32x4 kv, vv;
        if (j < jmin) { kv = (u32x4){0u, 0u, 0u, 0u}; vv = kv; }
        else if (smp && j < 128) { float f[8]; const size_t o = ((size_t)(b * 128 + j) * 8 + kvh) * 64 + cc * 8; load8f(a.cache_k + o, f); kv = pack8(f); load8f(a.cache_v + o, f); vv = pack8(f); }
        else { const int row = smp ? (MP + b * 64 + (j - 128)) : (qrow0 - 128 + j); const bf16* p = PROJ + (size_t)row * NPROJ + kvh * 64 + cc * 8;
            kv = *(const u32x4*)(p + OFF_K); vv = *(const u32x4*)(p + OFF_V); }
        *(LAS u32x4*)(Ks + j * KS_PITCH + cc * 8) = kv;
        LAS bf16* vt = Vt + (cc * 8) * VT_PITCH + ((((j >> 2) ^ cc)) << 2) + (j & 3);
        vt[0 * VT_PITCH] = (bf16)(vv.x & 0xffffu); vt[1 * VT_PITCH] = (bf16)(vv.x >> 16); vt[2 * VT_PITCH] = (bf16)(vv.y & 0xffffu); vt[3 * VT_PITCH] = (bf16)(vv.y >> 16);
        vt[4 * VT_PITCH] = (bf16)(vv.z & 0xffffu); vt[5 * VT_PITCH] = (bf16)(vv.z >> 16); vt[6 * VT_PITCH] = (bf16)(vv.w & 0xffffu); vt[7 * VT_PITCH] = (bf16)(vv.w >> 16);
    }
    __syncthreads();
    bf16x8 qf[4];
#pragma unroll
    for (int ks = 0; ks < 4; ++ks) { float f[8]; unpack8(qraw[ks], f);
#pragma unroll
        for (int e = 0; e < 8; ++e) f[e] *= 0.125f;
        qf[ks] = __builtin_bit_cast(bf16x8, pack8(f)); }
    const float slope = exp2f(-0.25f * (float)(h + 1)), sink = a.sinks[h];
    const float t0 = (float)(tq + 128 - 4 * hi);
    const int kb0 = jmin >> 5;
    float mx = sink;
#pragma unroll
    for (int kb = 0; kb < 6; ++kb) {
        if (kb >= kb0) { f32x16 acc;
#pragma unroll
            for (int r = 0; r < 16; ++r) acc[r] = 0.f;
#pragma unroll
            for (int ks = 0; ks < 4; ++ks) { const bf16x8 kf = *(const LAS bf16x8*)(Ks + (32 * kb + l32) * KS_PITCH + 16 * ks + 8 * hi); acc = MFMA32(kf, qf[ks], acc); }
#pragma unroll
            for (int r = 0; r < 16; ++r) { const float dist = fabsf(t0 - (float)(32 * kb + (r & 3) + 8 * (r >> 2))); mx = fmaxf(mx, acc[r] - slope * dist); }
        }
        __builtin_amdgcn_sched_barrier(0);
    }
    mx = fmaxf(mx, __shfl_xor(mx, 32));
    f32x16 o0, o1; float sum = 0.f;
#pragma unroll
    for (int r = 0; r < 16; ++r) { o0[r] = 0.f; o1[r] = 0.f; }
#pragma unroll
    for (int kb = 0; kb < 6; ++kb) {
        if (kb >= kb0) { f32x16 acc;
#pragma unroll
            for (int r = 0; r < 16; ++r) acc[r] = 0.f;
#pragma unroll
            for (int ks = 0; ks < 4; ++ks) { const bf16x8 kf = *(const LAS bf16x8*)(Ks + (32 * kb + l32) * KS_PITCH + 16 * ks + 8 * hi); acc = MFMA32(kf, qf[ks], acc); }
            float p[16];
#pragma unroll
            for (int r = 0; r < 16; ++r) { const float dist = fabsf(t0 - (float)(32 * kb + (r & 3) + 8 * (r >> 2))); p[r] = __expf(acc[r] - slope * dist - mx); sum += p[r]; }
#pragma unroll
            for (int s = 0; s < 2; ++s) {
                u32x4 pw; pw.x = pk2(p[8 * s + 0], p[8 * s + 1]); pw.y = pk2(p[8 * s + 2], p[8 * s + 3]); pw.z = pk2(p[8 * s + 4], p[8 * s + 5]); pw.w = pk2(p[8 * s + 6], p[8 * s + 7]);
                const int k0 = l32 >> 3, x0 = 4 * s + hi, x1 = x0 + 2;
                const LAS bf16* vp = Vt + l32 * VT_PITCH + 32 * kb;
                const s16x4 a0 = *(const LAS s16x4*)(vp + ((x0 ^ k0) << 2)), a1 = *(const LAS s16x4*)(vp + ((x1 ^ k0) << 2)), b0 = *(const LAS s16x4*)(vp + 32 * VT_PITCH + ((x0 ^ k0 ^ 4) << 2)), b1 = *(const LAS s16x4*)(vp + 32 * VT_PITCH + ((x1 ^ k0 ^ 4) << 2));
                o0 = MFMA32(__builtin_shufflevector(a0, a1, 0, 1, 2, 3, 4, 5, 6, 7), __builtin_bit_cast(bf16x8, pw), o0);
                o1 = MFMA32(__builtin_shufflevector(b0, b1, 0, 1, 2, 3, 4, 5, 6, 7), __builtin_bit_cast(bf16x8, pw), o1); }
        }
        __builtin_amdgcn_sched_barrier(0);
    }
    sum += __shfl_xor(sum, 32);
    const float inv = 1.0f / (sum + __expf(sink - mx));
    bf16* op = MIX + (size_t)(qrow0 + tq) * D + CONVD + h * 64 + 4 * hi;
#pragma unroll
    for (int g = 0; g < 4; ++g) { u32x2 w; w.x = pk2(o0[4 * g] * inv, o0[4 * g + 1] * inv); w.y = pk2(o0[4 * g + 2] * inv, o0[4 * g + 3] * inv); *(u32x2*)(op + 8 * g) = w;
        w.x = pk2(o1[4 * g] * inv, o1[4 * g + 1] * inv); w.y = pk2(o1[4 * g + 2] * inv, o1[4 * g + 3] * inv); *(u32x2*)(op + 32 + 8 * g) = w; }
    __syncthreads();
}
__device__ __forceinline__ void phase_mix0(const Ctx& c, const Args& a) {
    if (c.vcu & 1) { convert_weights<2>(a, MK_P2_CONV, c.vcu * NWAVES + c.wave, c.G * NWAVES, c.lane); mix0_conv(c, a); mix0_kvstate(c, a); }
    for (int u = c.vcu; u < 160 * 8; u += c.G) attn_unit(c, a, u);
    if (!(c.vcu & 1)) { convert_weights<2>(a, MK_P2_CONV, c.vcu * NWAVES + c.wave, c.G * NWAVES, c.lane); mix0_conv(c, a); mix0_kvstate(c, a); }
}

__device__ __forceinline__ void phase_ffnfix(const Ctx& c, const Args& a, int layer) {
    const float* SIDE = (const float*)(a.ws + WS_SIDE); bf16* ACT = (bf16*)(a.ws + WS_ACT);
    const float* cw = a.conv_w_ffn + (size_t)layer * 3 * NUP; const float* cb = a.conv_b_ffn + (size_t)layer * NUP;
    const int gt = c.vcu * NTHR + c.tid, NT = c.G * NTHR; constexpr int NCH = DFF / 8;
    for (int it = gt; it < 32 * 2 * NCH; it += NT) {
        const int cc = it % NCH, tr = it / NCH, r = tr & 1, pm = tr >> 1, ch = cc * 8;
        if ((pm & 7) == 0) continue;
        const float* s2 = r == 0 ? SIDE + ((size_t)((pm - 1) * 4 + 2)) * NUP : SIDE + ((size_t)((pm - 1) * 4 + 3)) * NUP;
        const float* s1 = r == 0 ? SIDE + ((size_t)((pm - 1) * 4 + 3)) * NUP : SIDE + ((size_t)(pm * 4 + 0)) * NUP;
        const float* s0 = SIDE + ((size_t)(pm * 4 + r)) * NUP;
        float wg0[8], wg1[8], wg2[8], wu0[8], wu1[8], wu2[8], bg[8], bu[8], g2[8], g1[8], g0[8], u2[8], u1[8], u0[8], o[8];
        load8f(cw + ch, wg0); load8f(cw + NUP + ch, wg1); load8f(cw + 2 * NUP + ch, wg2); load8f(cw + DFF + ch, wu0); load8f(cw + NUP + DFF + ch, wu1); load8f(cw + 2 * NUP + DFF + ch, wu2);
        load8f(cb + ch, bg); load8f(cb + DFF + ch, bu);
        load8f(s2 + ch, g2); load8f(s2 + DFF + ch, u2); load8f(s1 + ch, g1); load8f(s1 + DFF + ch, u1); load8f(s0 + ch, g0); load8f(s0 + DFF + ch, u0);
#pragma unroll
        for (int e = 0; e < 8; ++e) { const float cg = wg0[e] * g2[e] + wg1[e] * g1[e] + wg2[e] * g0[e] + bg[e], cu = wu0[e] * u2[e] + wu1[e] * u1[e] + wu2[e] * u0[e] + bu[e];
            o[e] = cg / (1.0f + __expf(-cg)) * cu; }
        *(u32x4*)(ACT + (size_t)(pm * 256 + r) * DFF + ch) = pack8(o);
    }
}
constexpr int SG_PITCH = 136, SO_PITCH = 264;
constexpr int WL_OFF = 256 * SG_PITCH * 2, WL_PITCH = 136;
__device__ __forceinline__ void sgu_load_w(const Ctx& c, const Args& a, int g) {
    LAS bf16* WL = (LAS bf16*)(c.lds + RING_OFF + WL_OFF); const float* wsg = a.w_s + (size_t)g * 128 * 128;
#pragma unroll
    for (int i = 0; i < 8; ++i) { const int ci = c.tid + NTHR * i, t = ci >> 5, s0 = (ci & 31) * 4; const f32x4 w = *(const f32x4*)(wsg + (size_t)t * 128 + s0);
        u32x2 o; o.x = pk2(s0 + 0 <= t ? w.x : 0.f, s0 + 1 <= t ? w.y : 0.f); o.y = pk2(s0 + 2 <= t ? w.z : 0.f, s0 + 3 <= t ? w.w : 0.f);
        *(LAS u32x2*)(WL + t * WL_PITCH + s0) = o; }
}
__device__ __forceinline__ void sgu_unit(const Ctx& c, const Args& a, int unit, int& gcur) {
    const bf16* Z = (const bf16*)(a.ws + WS_Z); bf16* MIX = (bf16*)(a.ws + WS_MIX);
    const int tid = c.tid, wid = c.wave, lane = c.lane, l32 = lane & 31, hi = lane >> 5;
    int g, r0, nt;
    if (unit < 1024) { g = unit & 15; r0 = (unit >> 4) * 128; nt = 4; } else { const int u2 = unit - 1024; g = u2 & 15; r0 = MP + (u2 >> 4) * 64; nt = 2; }
    LAS bf16* VT = (LAS bf16*)(c.lds + RING_OFF); const LAS bf16* WL = (const LAS bf16*)(c.lds + RING_OFF + WL_OFF);
    LAS float* lnt = (LAS float*)(c.lds + TAB_OFF);
    const int cc = tid & 31, col = g * 256 + cc * 8;
    u32x4 zv[8], zu[8];
#pragma unroll
    for (int i = 0; i < 8; ++i) if (i < 2 * nt) { const bf16* zp = Z + (size_t)(r0 + (tid >> 5) + 16 * i) * NGM + col; zv[i] = *(const u32x4*)(zp + D); zu[i] = *(const u32x4*)zp; }
    float gg[8], bb[8]; load8f(a.ln_g + col, gg); load8f(a.ln_b + col, bb);
    if (g != gcur) { sgu_load_w(c, a, g); gcur = g; }
    { const int row = tid >> 2, qd = tid & 3;
      if (row < 32 * nt) { const f32x4* p = (const f32x4*)((const float*)(a.ws + WS_LS) + ((size_t)(r0 + row) * 128 + qd * 32) * 2);
          f32x4 s4 = p[0];
#pragma unroll
          for (int j = 1; j < 16; ++j) s4 += p[j];
          float s1 = s4.x + s4.z, s2 = s4.y + s4.w; s1 += __shfl_xor(s1, 1); s2 += __shfl_xor(s2, 1); s1 += __shfl_xor(s1, 2); s2 += __shfl_xor(s2, 2);
          const float mean = s1 * (1.f / D), var = fmaxf(s2 * (1.f / D) - mean * mean, 0.f);
          if (qd == 0) { lnt[2 * row] = mean; lnt[2 * row + 1] = 1.0f / sqrtf(var + LN_EPS); } } }
    __syncthreads();
#pragma unroll
    for (int i = 0; i < 8; ++i) if (i < 2 * nt) { const int s = (tid >> 5) + 16 * i;
        float f[8]; unpack8(zv[i], f);
        const float mean = lnt[2 * s], rstd = lnt[2 * s + 1];
#pragma unroll
        for (int e = 0; e < 8; ++e) f[e] = (f[e] - mean) * rstd * gg[e] + bb[e];
        if (r0 >= MP) store8f(a.out + O_GV + (size_t)(r0 - MP + s) * D + col, f);
        const u32x4 v = pack8(f);
        LAS bf16* vt = VT + (cc * 8) * SG_PITCH + ((((s >> 3) ^ cc) & 15) << 3) + (s & 7);
        vt[0 * SG_PITCH] = (bf16)(v.x & 0xffffu); vt[1 * SG_PITCH] = (bf16)(v.x >> 16); vt[2 * SG_PITCH] = (bf16)(v.y & 0xffffu); vt[3 * SG_PITCH] = (bf16)(v.y >> 16);
        vt[4 * SG_PITCH] = (bf16)(v.z & 0xffffu); vt[5 * SG_PITCH] = (bf16)(v.z >> 16); vt[6 * SG_PITCH] = (bf16)(v.w & 0xffffu); vt[7 * SG_PITCH] = (bf16)(v.w >> 16); }
    __syncthreads();
    f32x16 acc[4];
#pragma unroll
    for (int tb = 0; tb < 4; ++tb)
#pragma unroll
        for (int r = 0; r < 16; ++r) acc[tb][r] = 0.f;
#pragma unroll
    for (int ks = 0; ks < 8; ++ks) {
        if (ks < 2 * nt) {
            const bf16x8 bfr = *(const LAS bf16x8*)(VT + (32 * wid + l32) * SG_PITCH + ((((2 * ks + hi) ^ ((32 * wid + l32) >> 3)) & 15) << 3));
#pragma unroll
            for (int tb = 0; tb < 4; ++tb) {
                if (tb >= (ks >> 1) && tb < nt) { const bf16x8 afr = *(const LAS bf16x8*)(WL + (32 * tb + l32) * WL_PITCH + 16 * ks + 8 * hi); acc[tb] = MFMA32(afr, bfr, acc[tb]); }
            }
        }
    }
    __syncthreads();
    LAS bf16* SO = (LAS bf16*)(c.lds + RING_OFF);
#pragma unroll
    for (int tb = 0; tb < 4; ++tb) {
        if (tb < nt) {
#pragma unroll
            for (int r = 0; r < 16; ++r) { const int t = 32 * tb + crow(r, hi);
                SO[t * SO_PITCH + 32 * wid + l32] = (bf16)(pk2(acc[tb][r] + a.b_s[g * 128 + t], 0.f) & 0xffffu); }
        }
    }
    __syncthreads();
#pragma unroll
    for (int i = 0; i < 8; ++i) if (i < 2 * nt) { const int t = (tid >> 5) + 16 * i;
        float sv[8], uv[8], o[8]; unpack8(*(const LAS u32x4*)(SO + t * SO_PITCH + cc * 8), sv); unpack8(zu[i], uv);
#pragma unroll
        for (int e = 0; e < 8; ++e) o[e] = sv[e] * uv[e];
        *(u32x4*)(MIX + (size_t)(r0 + t) * D + col) = pack8(o); }
    __syncthreads();
}
__global__ void __launch_bounds__(NTHR, 2) mk_fwd(Args a) {
    extern __shared__ __attribute__((aligned(16))) unsigned char lds[];
    Ctx c; c.lds = (LAS unsigned char*)lds; c.tid = threadIdx.x; c.lane = c.tid & 63; c.wave = __builtin_amdgcn_readfirstlane(c.tid >> 6);
    c.G = gridDim.x; { const int bx = blockIdx.x; c.vcu = (c.G % 8 == 0) ? (bx % 8) * (c.G / 8) + bx / 8 : bx; }
    volatile LAS unsigned* MISC = (volatile LAS unsigned*)(c.lds + MISC_OFF);
    for (int u = c.tid; u < (LDS_BYTES - LDSCTL_OFF) / 4; u += NTHR) ((LAS unsigned*)(c.lds + LDSCTL_OFF))[u] = 0u;
    __syncthreads();
    unsigned char* ws = a.ws;
    unsigned* ctl = (unsigned*)(ws + WS_CTL);
    XcdBarrier bar; bar.bar = ctl + CW_BAR; bar.x = 0; bar.st = nullptr;
    if (N_LAUNCHES == 1) bar = xcd_barrier_post(ctl + CW_BAR, MISC + 8);
#define GRID_BAR() do { if (N_LAUNCHES == 1) xcd_barrier(bar); } while (0)
    const int lo = a.ph_lo, hi = a.ph_hi;
#define IN(k) (lo <= (k) && (k) < hi)
#define BOTH(k) (IN(k) && IN((k) + 1))
    bf16* XN = (bf16*)(ws + WS_XN); bf16* PROJ = (bf16*)(ws + WS_PROJ); bf16* MIX = (bf16*)(ws + WS_MIX);
    bf16* UP = (bf16*)(ws + WS_UP); bf16* ACT = (bf16*)(ws + WS_ACT); bf16* Z = (bf16*)(ws + WS_Z);
    LAS unsigned char* ring = c.lds + RING_OFF;
    float* RS = (float*)(ws + WS_RS); pg8::f32x2* LS = (pg8::f32x2*)(ws + WS_LS); LAS float* tab = (LAS float*)(c.lds + TAB_OFF);
#define SKS(gi) (pg8::SkShare{(float*)(ws + WS_SLAB) + (size_t)((gi) & 1) * 256 * 65536, ctl + CW_SK + (gi) * 256 * 16, ctl})
    const int bx = (int)blockIdx.x;

    if (IN(0)) { phase_prologue(c, a); if (BOTH(0)) GRID_BAR(); }
    if (IN(1)) {
        pg8::Gemm g{XN, (const bf16*)(ws + WS_WIN), M, NPROJ, D}; pg8::SkOrder S; S.init(M, NPROJ, D, c.G, bx, false); pg8::EpiBf16<0, false, false> E{PROJ, NPROJ, nullptr, nullptr, nullptr, 0};
        pg8::gemm_phase<pg8::EpiBf16<0, false, false>, pg8::SkOrder, true, true>(ring, g, S, E, SKS(0));
        if (BOTH(1)) GRID_BAR(); }
    if (IN(2)) { phase_mix0(c, a); if (BOTH(2)) GRID_BAR(); }
    if (IN(3)) {
        pg8::Gemm g{MIX, (const bf16*)(ws + WS_WOUT), M, D, D}; pg8::SkOrder S; S.init(M, D, D, c.G, bx, false); S.quad = MK_QUAD; pg8::EpiRes<true, true> E{a.x_p, a.x_s, XN, RS, D, MP};
        pg8::gemm_phase<pg8::EpiRes<true, true>, pg8::SkOrder, true, true>(ring, g, S, E, SKS(1));
        if (BOTH(3)) GRID_BAR(); }
    if (IN(5)) {
        pg8::Gemm g{XN, (const bf16*)(ws + WS_WUP), M, NUP, D}; pg8::SkOrder S; S.init(M, NUP, D, c.G, bx, false); pg8::EpiConvGate E{ACT, RS, tab, (LAS bf16*)(c.lds + BND_OFF), a.conv_w_ffn + (size_t)0 * 3 * NUP, a.conv_b_ffn + (size_t)0 * NUP, a.st_ffn + (size_t)0 * 32 * 2 * NUP, (float*)(ws + WS_SIDE), a.out + O_FP + (size_t)0 * 4 * 2 * NUP, a.out + O_FS + (size_t)0 * 32 * 2 * NUP};
        pg8::gemm_phase<pg8::EpiConvGate, pg8::SkOrder, true, true>(ring, g, S, E, SKS(2));
        if (BOTH(5)) GRID_BAR(); }
    if (IN(6)) { phase_ffnfix(c, a, 0); if (BOTH(6)) GRID_BAR(); }
    if (IN(7)) {
        pg8::Gemm g{ACT, (const bf16*)(ws + WS_WDN), M, D, DFF}; pg8::SkOrder S; S.init(M, D, DFF, c.G, bx, true); S.quad = MK_QUAD; pg8::EpiRes<false, true> E{nullptr, nullptr, XN, RS, D, MP};
        pg8::gemm_phase<pg8::EpiRes<false, true>, pg8::SkOrder, true, true>(ring, g, S, E, SKS(3));
        if (BOTH(7)) GRID_BAR(); }
    if (IN(9)) {
        pg8::Gemm g{XN, (const bf16*)(ws + WS_WINC), M, NGM, D}; pg8::SkOrder S; S.init(M, NGM, D, c.G, bx, false); pg8::EpiBf16<1, true, true> E{Z, NGM, RS, tab, LS, 16};
        pg8::gemm_phase<pg8::EpiBf16<1, true, true>, pg8::SkOrder, true, true>(ring, g, S, E, SKS(4));
        if (BOTH(9)) GRID_BAR(); }
    if (IN(11)) { int gcur = -1; for (int u = c.vcu; u < 1024 + 512; u += c.G) sgu_unit(c, a, u, gcur); if (BOTH(11)) GRID_BAR(); }
    if (IN(12)) {
        pg8::Gemm g{MIX, (const bf16*)(ws + WS_WOUTC), M, D, D}; pg8::SkOrder S; S.init(M, D, D, c.G, bx, false); S.quad = MK_QUAD; pg8::EpiRes<false, true> E{nullptr, nullptr, XN, RS, D, MP};
        pg8::gemm_phase<pg8::EpiRes<false, true>, pg8::SkOrder, true, true>(ring, g, S, E, SKS(5));
        if (BOTH(12)) GRID_BAR(); }
    if (IN(14)) {
        pg8::Gemm g{XN, (const bf16*)(ws + WS_WUP) + (size_t)NUP * D, M, NUP, D}; pg8::SkOrder S; S.init(M, NUP, D, c.G, bx, false); pg8::EpiConvGate E{ACT, RS, tab, (LAS bf16*)(c.lds + BND_OFF), a.conv_w_ffn + (size_t)1 * 3 * NUP, a.conv_b_ffn + (size_t)1 * NUP, a.st_ffn + (size_t)1 * 32 * 2 * NUP, (float*)(ws + WS_SIDE), a.out + O_FP + (size_t)1 * 4 * 2 * NUP, a.out + O_FS + (size_t)1 * 32 * 2 * NUP};
        pg8::gemm_phase<pg8::EpiConvGate, pg8::SkOrder, true, true>(ring, g, S, E, SKS(6));
        if (BOTH(14)) GRID_BAR(); }
    if (IN(15)) { phase_ffnfix(c, a, 1); if (BOTH(15)) GRID_BAR(); }
    if (IN(16)) {
        pg8::Gemm g{ACT, (const bf16*)(ws + WS_WDN) + (size_t)D * DFF, M, D, DFF}; pg8::SkOrder S; S.init(M, D, DFF, c.G, bx, true); S.quad = MK_QUAD; pg8::EpiRes<false, true> E{nullptr, nullptr, XN, RS, D, MP};
        pg8::gemm_phase<pg8::EpiRes<false, true>, pg8::SkOrder, true, true>(ring, g, S, E, SKS(7));
        if (BOTH(16)) GRID_BAR(); }
    if (IN(17)) { phase_final(c, XN, RS, a.norm_final, a.out); }
#undef IN
#undef BOTH
}

extern "C" void kernel_launch(void* const* d_in, const int* in_sizes, int n_in, void* d_out, int out_size, void* d_ws, size_t ws_size, hipStream_t stream) {
    static int grid = 0;
    if (grid == 0) {
        if (n_in != 23 || in_sizes[0] != MP * D || (size_t)out_size != O_END || ws_size < WS_END) {
            fprintf(stderr, "kernel_launch: shape mismatch: n_in %d in0 %d out %d (want %zu) ws %zu (want %zu); nothing launched\n", n_in, n_in > 0 ? in_sizes[0] : -1, out_size, (size_t)O_END, ws_size, (size_t)WS_END); grid = -1; return; }
        int dev = 0, cus = 0, per_cu = 0;
        if (hipGetDevice(&dev) != hipSuccess || hipDeviceGetAttribute(&cus, hipDeviceAttributeMultiprocessorCount, dev) != hipSuccess) { grid = -1; return; }
        if (hipFuncSetAttribute((const void*)mk_fwd, hipFuncAttributeMaxDynamicSharedMemorySize, LDS_BYTES) != hipSuccess) { fprintf(stderr, "kernel_launch: hipFuncSetAttribute failed\n"); grid = -1; return; }
        if (hipOccupancyMaxActiveBlocksPerMultiprocessor(&per_cu, (const void*)mk_fwd, NTHR, LDS_BYTES) != hipSuccess || per_cu < 1) fprintf(stderr, "kernel_launch: occupancy query reports %d blocks per CU\n", per_cu);
        (void)hipGetLastError();
        grid = cus;
    }
    if (grid < 0) return;
    if (hipMemsetAsync((char*)d_ws + WS_CTL, 0, CTL_ZERO_BYTES, stream) != hipSuccess) { fprintf(stderr, "kernel_launch: memset failed\n"); return; }
    Args a{};
    const float* const* in = (const float* const*)d_in;
    a.x_p = in[0]; a.x_s = in[1]; a.st_conv = in[2]; a.cache_k = in[3]; a.cache_v = in[4]; a.st_ffn = in[5]; a.norm_mix = in[6]; a.norm_ffn = in[7]; a.norm_final = in[8]; a.w_in_ab = in[9];
    a.conv_w_a = in[10]; a.sinks = in[11]; a.w_out_ab = in[12]; a.w_in_c = in[13]; a.ln_g = in[14]; a.ln_b = in[15]; a.w_s = in[16]; a.b_s = in[17]; a.w_out_c = in[18]; a.w_up = in[19];
    a.conv_w_ffn = in[20]; a.conv_b_ffn = in[21]; a.w_down = in[22];
    a.out = (float*)d_out; a.ws = (unsigned char*)d_ws;
    for (int li = 0; li < N_LAUNCHES; ++li) {
        a.ph_lo = (N_LAUNCHES == 1) ? 0 : li; a.ph_hi = (N_LAUNCHES == 1) ? N_PHASES : li + 1;
        hipLaunchKernelGGL(mk_fwd, dim3(grid), dim3(NTHR), LDS_BYTES, stream, a);
        const hipError_t le = hipPeekAtLastError();
        if (le != hipSuccess) { fprintf(stderr, "kernel_launch: launch %d failed: %s\n", li, hipGetErrorName(le)); break; }
    }
}
```

```cpp
#include <hip/hip_runtime.h>
#include <cstdio>
#include <cstdint>
namespace pg8 {
#define PG8_LAS __attribute__((address_space(3)))
typedef unsigned short bf16_t;
typedef short bf16x8 __attribute__((ext_vector_type(8)));
typedef float f32x4 __attribute__((ext_vector_type(4)));
typedef unsigned u32x4 __attribute__((ext_vector_type(4)));
typedef unsigned u32x2 __attribute__((ext_vector_type(2)));
constexpr int BM = 256, BK = 64, HALF = 128, HTB = HALF * BK * 2  , STAGE_BYTES = 8 * HTB, NXCD = 8, WGM = 8;

__host__ __device__ __forceinline__ int lds_byte(int r, int c) { const int st = (r >> 4) * 2 + (c >> 5), rr = r & 15, cc = c & 31, ob = rr * 64 + cc * 2; return st * 1024 + (ob ^ (((ob >> 9) & 1) << 5)); }
__host__ __device__ __forceinline__ void stage_rc(int b, int& R, int& C) { const int st = b / 1024, sb = b % 1024, swz = sb ^ (((sb >> 9) & 1) << 5); R = (st >> 1) * 16 + swz / 64; C = (st & 1) * 32 + (swz % 64) / 2; }
__host__ __device__ __forceinline__ int perm32(int rho) { const int n = rho >> 4, i = rho & 15; return 8 * (i >> 2) + 4 * n + (i & 3); }

struct Unit { int pm, pn, k0, nt, role, par; };
struct Gemm { const bf16_t* A; const bf16_t* Bt; int M, N, K; };

struct SkOrder {
    int nM, nN, T, q, R, nDP, rem, xcd, rank, c; bool sk;
    __device__ __forceinline__ void init(int M, int N, int K, int G, int c_, bool gs = false, int Ra = 0) { gsync = gs; nM = M / BM; nN = N / BM; T = K / BK; q = (nM * nN) / NXCD; R = Ra > 0 ? Ra : G / NXCD; c = c_; xcd = c_ % NXCD; rank = c_ / NXCD;
        nDP = q / R; rem = q - nDP * R; sk = rem > 0 && 2 * rem <= R && (T % 4) == 0; }
    bool quad = false, bst = false;
    bool gsync;
    __device__ __forceinline__ void unit_of(int id, Unit& u) const {
        if (quad) {
            const int x = id / q, j = id - x * q, b = x & 3, h = x >> 2, hr = nM / 2, r = j >> 5, jj = j & 31, full = hr >> 3;
            if (r < full) { u.pm = hr * h + 8 * r + (jj & 7); u.pn = 4 * b + (jj >> 3); } else { const int rest = hr - 8 * full; u.pm = hr * h + 8 * full + (jj % rest); u.pn = 4 * b + (jj / rest); } }
        else if (gsync) { const int x = id / q, j = id - x * q, gi = j / nN, ig = x * nN + (j - gi * nN); u.pm = gi * WGM + (ig & (WGM - 1)); u.pn = ig / WGM; }
        else if (bst) {
            const int bs = 4 * nM, blk = id / bs, r = id - blk * bs, nb = (nN - 4 * blk) < 4 ? (nN - 4 * blk) : 4, gsz8 = 8 * nb, g = r / gsz8, rr = r - g * gsz8; u.pm = 8 * g + (rr & 7); u.pn = 4 * blk + (rr >> 3); }
        else { const int nig = WGM * nN, gid = id / nig, fm = gid * WGM, gsz = (nM - fm) < WGM ? (nM - fm) : WGM; u.pm = fm + ((id % nig) % gsz); u.pn = (id % nig) / gsz; } }
    __device__ __forceinline__ bool next(int i, Unit& u) const {
        if (rank >= R) return false;
        if (i < nDP) { unit_of(xcd * q + i * R + rank, u); u.k0 = 0; u.nt = T; u.role = 0; return true; }
        if (i > nDP) return false;
        if (sk) { if (rank >= 2 * rem) return false; unit_of(xcd * q + nDP * R + (rank >> 1), u); u.nt = T / 2; u.k0 = (rank & 1) * (T / 2); u.role = (rank & 1) ? 1 : 2; return true; }
        if (rank >= rem) return false;
        unit_of(xcd * q + nDP * R + rank, u); u.k0 = 0; u.nt = T; u.role = 0; return true;
    }
};
struct SkShare { float* slab; unsigned* flags; unsigned* tmo; };

__device__ __forceinline__ unsigned cvt_pk_bf16(float lo, float hi) { unsigned r; asm volatile("v_cvt_pk_bf16_f32 %0, %1, %2" : "=v"(r) : "v"(lo), "v"(hi)); return r; }
typedef float f32x2 __attribute__((ext_vector_type(2)));
__device__ __forceinline__ f32x2 gelu_pk(f32x2 v) {
    const f32x2 av = __builtin_elementwise_abs(v), d = av * 0.2316418882f + 1.0f;
    f32x2 t; t.x = __builtin_amdgcn_rcpf(d.x); t.y = __builtin_amdgcn_rcpf(d.y);
    f32x2 q = t * 0.5307027145f + (-0.7265760135f); q = q * t + 0.7107068705f; q = q * t + (-0.142248368f); q = q * t + 0.127414796f; q = q * t;
    const f32x2 s = (v * v) * (-0.72134752044f);
    f32x2 e; e.x = __builtin_amdgcn_exp2f(s.x); e.y = __builtin_amdgcn_exp2f(s.y);
    const f32x2 m = v * (q * e), r = v - m;
    f32x2 o; o.x = v.x < 0.f ? m.x : r.x; o.y = v.y < 0.f ? m.y : r.y; return o;
}

template <int ACT, bool RSTD, bool LNS> struct EpiBf16 {
    static constexpr bool PERM = true, AFTER_DRAIN = false, ONE_FINISH = false, CACHED_TAB = false;
    bf16_t* O; int ldc; const float* rs; PG8_LAS float* tab; f32x2* ls; int lns_pn0;
    __device__ __forceinline__ void prep(const Unit& u, int tid) const {
        if constexpr (RSTD) {
            const int t_ = (int)threadIdx.x, row = t_ >> 1, h = t_ & 1; const f32x4* p = (const f32x4*)(rs + ((size_t)(u.pm * BM + row)) * 128 + h * 64);
            f32x4 s4 = p[0];
#pragma unroll
            for (int j = 1; j < 16; ++j) s4 += p[j];
            float s = (s4.x + s4.y) + (s4.z + s4.w); s += __shfl_xor(s, 1);
            if (h == 0) tab[u.par * BM + row] = 1.0f / sqrtf(s * (1.0f / 4096.0f) + 1e-6f);
        }
    }
    template <int MASK = 3> __device__ __forceinline__ void run(const f32x4 (&acc)[2][2][4][2], const Unit& u, int wr, int wc, int fr, int fq) const {
        const int row0 = u.pm * BM + wr * 64 + fr; const int col0 = u.pn * BM + wc * 32 + 8 * fq;
#pragma unroll
        for (int ai = 0; ai < 2; ++ai)
#pragma unroll
            for (int m = 0; m < 4; ++m) { const int row = row0 + ai * HALF + m * 16; bf16_t* rowp = O + (size_t)row * ldc + col0;
                float sc = 1.0f; if constexpr (RSTD) sc = tab[u.par * BM + wr * 64 + fr + ai * HALF + m * 16];
#pragma unroll
                for (int bj = 0; bj < 2; ++bj) { if (!((MASK >> bj) & 1)) continue; f32x4 v0 = acc[ai][bj][m][0] * sc, v1 = acc[ai][bj][m][1] * sc;
                    if (ACT == 1) { f32x2 a = gelu_pk((f32x2){v0[0], v0[1]}), b = gelu_pk((f32x2){v0[2], v0[3]}), c = gelu_pk((f32x2){v1[0], v1[1]}), d = gelu_pk((f32x2){v1[2], v1[3]});
                        v0 = (f32x4){a.x, a.y, b.x, b.y}; v1 = (f32x4){c.x, c.y, d.x, d.y}; }
                    u32x4 w; w.x = cvt_pk_bf16(v0[0], v0[1]); w.y = cvt_pk_bf16(v0[2], v0[3]); w.z = cvt_pk_bf16(v1[0], v1[1]); w.w = cvt_pk_bf16(v1[2], v1[3]);
                    *(u32x4*)(rowp + bj * HALF) = w;
                    if constexpr (LNS) { if (u.pn >= lns_pn0) {
                        float s1 = ((v0[0] + v0[1]) + (v0[2] + v0[3])) + ((v1[0] + v1[1]) + (v1[2] + v1[3]));
                        float s2 = ((v0[0] * v0[0] + v0[1] * v0[1]) + (v0[2] * v0[2] + v0[3] * v0[3])) + ((v1[0] * v1[0] + v1[1] * v1[1]) + (v1[2] * v1[2] + v1[3] * v1[3]));
                        s1 += __shfl_xor(s1, 16); s2 += __shfl_xor(s2, 16); s1 += __shfl_xor(s1, 32); s2 += __shfl_xor(s2, 32);
                        if (fq == 0) ls[(size_t)row * 128 + (u.pn - lns_pn0) * 8 + wc * 2 + bj] = (f32x2){s1, s2}; } }
                } }
    }
};
template <bool BASEF32, bool STATS> struct EpiRes {
    static constexpr bool PERM = true, AFTER_DRAIN = false, ONE_FINISH = false, CACHED_TAB = false;
    const float* bp; const float* bs; bf16_t* xn; float* rs; int ld; int split;
    __device__ __forceinline__ void prep(const Unit&, int) const {}
    template <int MASK = 3> __device__ __forceinline__ void run(const f32x4 (&acc)[2][2][4][2], const Unit& u, int wr, int wc, int fr, int fq) const {
        const int row0 = u.pm * BM + wr * 64 + fr, col0 = u.pn * BM + wc * 32 + 8 * fq;
#pragma unroll
        for (int ai = 0; ai < 2; ++ai) {
            f32x4 b[4][2][2];
#pragma unroll
            for (int m = 0; m < 4; ++m) { const int row = row0 + ai * HALF + m * 16;
#pragma unroll
                for (int bj = 0; bj < 2; ++bj) { if (!((MASK >> bj) & 1)) continue;
                    if constexpr (BASEF32) { const float* br = (row < split ? bp + (size_t)row * ld : bs + (size_t)(row - split) * ld) + col0 + bj * HALF; b[m][bj][0] = *(const f32x4*)br; b[m][bj][1] = *(const f32x4*)(br + 4); }
                    else { const u32x4 w = *(const u32x4*)(xn + (size_t)row * ld + col0 + bj * HALF);
                        b[m][bj][0] = (f32x4){__uint_as_float(w.x << 16), __uint_as_float(w.x & 0xffff0000u), __uint_as_float(w.y << 16), __uint_as_float(w.y & 0xffff0000u)};
                        b[m][bj][1] = (f32x4){__uint_as_float(w.z << 16), __uint_as_float(w.z & 0xffff0000u), __uint_as_float(w.w << 16), __uint_as_float(w.w & 0xffff0000u)}; } } }
            asm volatile("" ::: "memory");
#pragma unroll
            for (int m = 0; m < 4; ++m) { const int row = row0 + ai * HALF + m * 16;
#pragma unroll
                for (int bj = 0; bj < 2; ++bj) { if (!((MASK >> bj) & 1)) continue;
                    const f32x4 o0 = b[m][bj][0] + acc[ai][bj][m][0], o1 = b[m][bj][1] + acc[ai][bj][m][1];
                    u32x4 w; w.x = cvt_pk_bf16(o0[0], o0[1]); w.y = cvt_pk_bf16(o0[2], o0[3]); w.z = cvt_pk_bf16(o1[0], o1[1]); w.w = cvt_pk_bf16(o1[2], o1[3]);
                    *(u32x4*)(xn + (size_t)row * ld + col0 + bj * HALF) = w;
                    if constexpr (STATS) {
                        float ss = ((o0[0] * o0[0] + o0[1] * o0[1]) + (o0[2] * o0[2] + o0[3] * o0[3])) + ((o1[0] * o1[0] + o1[1] * o1[1]) + (o1[2] * o1[2] + o1[3] * o1[3]));
                        ss += __shfl_xor(ss, 16); ss += __shfl_xor(ss, 32);
                        if (fq == 0) rs[(size_t)row * 128 + u.pn * 8 + wc * 2 + bj] = ss; }
                } }
            asm volatile("" ::: "memory");
        }
    }
};

struct EpiConvGate {
    static constexpr bool PERM = true, AFTER_DRAIN = false, ONE_FINISH = true, CACHED_TAB = true;
    bf16_t* act; const float* rs; PG8_LAS float* tab; PG8_LAS bf16_t* bnd; const float* cw; const float* cb; const float* st; float* side; float* out_p; float* out_s;
    static constexpr int NUPC = 22016, DFFC = 11008, MPT = 32;
    __device__ __forceinline__ void prep(const Unit& u, int tid) const {
        const int t_ = (int)threadIdx.x, row = t_ >> 1, h = t_ & 1; const f32x4* p = (const f32x4*)(rs + ((size_t)(u.pm * BM + row)) * 128 + h * 64);
        f32x4 s4 = p[0];
#pragma unroll
        for (int j = 1; j < 16; ++j) s4 += p[j];
        float s = (s4.x + s4.y) + (s4.z + s4.w); s += __shfl_xor(s, 1);
        if (h == 0) tab[u.par * BM + row] = 1.0f / sqrtf(s * (1.0f / 4096.0f) + 1e-6f);
    }
    static __device__ __forceinline__ float dpp_shr1(float old, float v) { return __builtin_bit_cast(float, __builtin_amdgcn_update_dpp(__builtin_bit_cast(int, old), __builtin_bit_cast(int, v), 0x111, 0xf, 0xf, false)); }
    static __device__ __forceinline__ float dpp_shr2(float old, float v) { return __builtin_bit_cast(float, __builtin_amdgcn_update_dpp(__builtin_bit_cast(int, old), __builtin_bit_cast(int, v), 0x112, 0xf, 0xf, false)); }
    static __device__ __forceinline__ float dpp_ror1(float v) { return __builtin_bit_cast(float, __builtin_amdgcn_update_dpp(0, __builtin_bit_cast(int, v), 0x121, 0xf, 0xf, false)); }
    static __device__ __forceinline__ float dpp_ror2(float v) { return __builtin_bit_cast(float, __builtin_amdgcn_update_dpp(0, __builtin_bit_cast(int, v), 0x122, 0xf, 0xf, false)); }
    static __device__ __forceinline__ f32x4 bf4(unsigned lo, unsigned hi) { return (f32x4){__uint_as_float(lo << 16), __uint_as_float(lo & 0xffff0000u), __uint_as_float(hi << 16), __uint_as_float(hi & 0xffff0000u)}; }
    template <class T> static __device__ __forceinline__ T* at(const void* base, unsigned off) { return (T*)((const char*)base + off); }
    static __device__ __forceinline__ void taps(const f32x4& cv, const f32x4& f1, const f32x4& f2, f32x4& p1, f32x4& p2) {
#pragma unroll
        for (int e = 0; e < 4; ++e) { p1[e] = dpp_shr1(f1[e], cv[e]); p2[e] = dpp_shr2(f2[e], cv[e]); } }
    template <int AH> __device__ __forceinline__ void half_pass(const f32x4 (&acc)[2][2][4][2], const Unit& u, int wr, int fr, int lcol8, int lch, bool smp, bool seq0, int bj) const {
        const unsigned o_act = (unsigned)(fr * DFFC + lch) * 2u, o_w = (unsigned)lch * 4u;
        const unsigned o_row = (unsigned)((fr < 2 ? fr : fr - 12) * NUPC + lch) * 4u;
        const unsigned o_st = (unsigned)((fr - 14) * NUPC + lch) * 4u;
        const int cg = u.pn * 128 + 64 * bj, cu = cg + DFFC;
        const f32x4 wg0 = *at<const f32x4>(cw + cg, o_w), wg1 = *at<const f32x4>(cw + NUPC + cg, o_w), wg2 = *at<const f32x4>(cw + 2 * NUPC + cg, o_w), bg = *at<const f32x4>(cb + cg, o_w);
        const f32x4 wu0 = *at<const f32x4>(cw + cu, o_w), wu1 = *at<const f32x4>(cw + NUPC + cu, o_w), wu2 = *at<const f32x4>(cw + 2 * NUPC + cu, o_w), bu = *at<const f32x4>(cb + cu, o_w);
#pragma unroll
        for (int ai = 0; ai < 2; ++ai) { f32x4 pvg = (f32x4){0.f, 0.f, 0.f, 0.f}, pvu = pvg;
#pragma unroll
            for (int m = 0; m < 4; ++m) { const int rtu = ai * HALF + wr * 64 + m * 16, g16 = ai * 8 + wr * 4 + m;
                const float sc = tab[u.par * BM + rtu + fr];
                const bool deferred = !smp && !seq0 && g16 == 0 && fr < 2;
                const f32x4 vg_raw = acc[ai][AH][m][0] * sc, vu_raw = acc[ai][AH][m][1] * sc;
                f32x4 f1g, f2g, f1u, f2u;
                if (m == 0) { f32x4 q14g, q15g, q14u, q15u;
                    if (smp || g16 == 0) {
                        if (smp) { const float* sp = st + ((size_t)(((u.pm - MPT) * 4 + (g16 >> 2)) * 2)) * NUPC; q14g = *at<const f32x4>(sp + cg, o_w); q15g = *at<const f32x4>(sp + NUPC + cg, o_w); q14u = *at<const f32x4>(sp + cu, o_w); q15u = *at<const f32x4>(sp + NUPC + cu, o_w); }
                        else { q14g = (f32x4){0.f, 0.f, 0.f, 0.f}; q15g = q14g; q14u = q14g; q15u = q14g; }
                    } else { typedef unsigned u32x4a __attribute__((ext_vector_type(4), may_alias));
                        const PG8_LAS bf16_t* bp = bnd + (((g16 - 1) * 2) * 2 + bj) * 128 + lcol8;
                        const u32x4a a14 = *(const PG8_LAS u32x4a*)(bp), a15 = *(const PG8_LAS u32x4a*)(bp + 256);
                        q14g = bf4(a14.x, a14.y); q14u = bf4(a14.z, a14.w); q15g = bf4(a15.x, a15.y); q15u = bf4(a15.z, a15.w); }
                    f1g = q15g; f1u = q15u;
#pragma unroll
                    for (int e = 0; e < 4; ++e) { f2g[e] = fr == 0 ? q14g[e] : q15g[e]; f2u[e] = fr == 0 ? q14u[e] : q15u[e]; }
                } else {
#pragma unroll
                    for (int e = 0; e < 4; ++e) { f1g[e] = dpp_ror1(pvg[e]); f2g[e] = dpp_ror2(pvg[e]); f1u[e] = dpp_ror1(pvu[e]); f2u[e] = dpp_ror2(pvu[e]); } }
                f32x4 p1, p2; taps(vg_raw, f1g, f2g, p1, p2);
                const f32x4 vg = wg0 * p2 + wg1 * p1 + wg2 * vg_raw + bg;
                taps(vu_raw, f1u, f2u, p1, p2);
                const f32x4 vu = wu0 * p2 + wu1 * p1 + wu2 * vu_raw + bu;
                if (!deferred) { f32x4 o;
#pragma unroll
                    for (int e = 0; e < 4; ++e) o[e] = vg[e] * __builtin_amdgcn_rcpf(1.0f + __expf(-vg[e])) * vu[e];
                    f32x2 w; w.x = __builtin_bit_cast(float, cvt_pk_bf16(o[0], o[1])); w.y = __builtin_bit_cast(float, cvt_pk_bf16(o[2], o[3]));
                    *at<f32x2>(act + ((size_t)(u.pm * BM + rtu)) * DFFC + cg, o_act) = w; }
                if (!smp) {
                    if ((g16 == 0 && fr < 2) || (g16 == 15 && fr >= 14)) { float* sp = side + ((size_t)(u.pm * 4)) * NUPC; *at<f32x4>(sp + cg, o_row) = vg_raw; *at<f32x4>(sp + cu, o_row) = vu_raw; }
                    if (g16 == 15 && fr >= 14 && (u.pm & 7) == 7) { float* op = out_p + ((size_t)((u.pm >> 3) * 2)) * NUPC; *at<f32x4>(op + cg, o_st) = vg_raw; *at<f32x4>(op + cu, o_st) = vu_raw; }
                } else if (m == 3 && fr >= 14) { float* op = out_s + ((size_t)(((u.pm - MPT) * 4 + (g16 >> 2)) * 2)) * NUPC; *at<f32x4>(op + cg, o_st) = vg_raw; *at<f32x4>(op + cu, o_st) = vu_raw; }
                pvg = vg_raw; pvu = vu_raw;
                asm volatile("" ::: "memory");
            }
        }
    }
    template <int AH> __device__ __forceinline__ void image(const f32x4 (&acc)[2][2][4][2], const Unit& u, int wr, int fr, int lcol8, int bj) const {
#pragma unroll
        for (int ai = 0; ai < 2; ++ai) { constexpr int m = 3; const float sc = tab[u.par * BM + ai * HALF + wr * 64 + m * 16 + fr]; const int g16 = ai * 8 + wr * 4 + m;
            if (fr >= 14) { const f32x4 v0 = acc[ai][AH][m][0] * sc, v1 = acc[ai][AH][m][1] * sc;
                u32x4 w; w.x = cvt_pk_bf16(v0[0], v0[1]); w.y = cvt_pk_bf16(v0[2], v0[3]); w.z = cvt_pk_bf16(v1[0], v1[1]); w.w = cvt_pk_bf16(v1[2], v1[3]);
                typedef unsigned u32x4a __attribute__((ext_vector_type(4), may_alias)); *(PG8_LAS u32x4a*)(bnd + ((g16 * 2 + (fr - 14)) * 2 + bj) * 128 + lcol8) = w; } }
    }
    template <int MASK = 3> __device__ __forceinline__ void run(const f32x4 (&acc)[2][2][4][2], const Unit& u, int wr, int wc, int fr_, int fq_) const {
        int fr = fr_, fq = fq_; asm volatile("" : "+v"(fr), "+v"(fq));
        const int lcol8 = wc * 32 + 8 * fq, lch = wc * 16 + 4 * fq;
        const bool smp = u.pm >= MPT, seq0 = !smp && (u.pm & 7) == 0;
        image<0>(acc, u, wr, fr, lcol8, 0); image<1>(acc, u, wr, fr, lcol8, 1);
        asm volatile("s_waitcnt lgkmcnt(0)" ::: "memory"); __builtin_amdgcn_s_barrier(); asm volatile("" ::: "memory");
        half_pass<0>(acc, u, wr, fr, lcol8, lch, smp, seq0, 0);
        half_pass<1>(acc, u, wr, fr, lcol8, lch, smp, seq0, 1);
    }
    __device__ __forceinline__ void run_half(const f32x4 (&acc)[2][2][4][2], const Unit& u, int wr, int wc, int fr_, int fq_, int bj) const {
        int fr = fr_, fq = fq_; asm volatile("" : "+v"(fr), "+v"(fq));
        const int lcol8 = wc * 32 + 8 * fq, lch = wc * 16 + 4 * fq;
        const bool smp = u.pm >= MPT, seq0 = !smp && (u.pm & 7) == 0;
        image<0>(acc, u, wr, fr, lcol8, bj);
        asm volatile("s_waitcnt lgkmcnt(0)" ::: "memory"); __builtin_amdgcn_s_barrier(); asm volatile("" ::: "memory");
        half_pass<0>(acc, u, wr, fr, lcol8, lch, smp, seq0, bj);
    }
};

template <int MY, class Epi>
__device__ __forceinline__ void sk_finish(f32x4 (&acc)[2][2][4][2], const Unit& cur, int me, int pc, const SkShare& sk, const Epi& E, int tid, int lane, int wr, int wc, int fr, int fq) {
    int tid2 = tid; asm volatile("" : "+v"(tid2));
    const __amdgpu_buffer_rsrc_t rs = __builtin_amdgcn_make_buffer_rsrc(sk.slab + (size_t)me * 65536, 0, 262144, 0x00020000);
#pragma unroll
    for (int a = 0; a < 2; ++a)
#pragma unroll
        for (int m = 0; m < 4; ++m)
#pragma unroll
            for (int n = 0; n < 2; ++n) __builtin_amdgcn_raw_buffer_store_b128(__builtin_bit_cast(u32x4, acc[a][1 - MY][m][n]), rs, (unsigned)(((a * 4 + m) * 2 + n) * 512 + tid2) * 16u, 0, 16);
    asm volatile("s_waitcnt vmcnt(0)" ::: "memory");
    if (lane == 0) __hip_atomic_fetch_add(sk.flags + 16 * me, 1u, __ATOMIC_RELAXED, __HIP_MEMORY_SCOPE_AGENT);
    unsigned spins = 0;
    while ((unsigned)__builtin_amdgcn_readfirstlane(__hip_atomic_load(sk.flags + 16 * pc, __ATOMIC_RELAXED, __HIP_MEMORY_SCOPE_AGENT)) < 8u) {
        __builtin_amdgcn_s_sleep(1);
        if ((++spins & 255u) == 0u) { if (__builtin_amdgcn_readfirstlane(__hip_atomic_load(sk.tmo, __ATOMIC_RELAXED, __HIP_MEMORY_SCOPE_AGENT)) != 0u) break;
            if (spins > (1u << 20)) { if (lane == 0) __hip_atomic_store(sk.tmo, 1u, __ATOMIC_RELAXED, __HIP_MEMORY_SCOPE_AGENT); break; } } }
    __builtin_amdgcn_fence(__ATOMIC_ACQUIRE, "agent");
    asm volatile("s_waitcnt vmcnt(0)" ::: "memory");
    const f32x4* sp = (const f32x4*)(sk.slab + (size_t)pc * 65536) + tid2;
#pragma unroll
    for (int a = 0; a < 2; ++a) {
        f32x4 p[8];
#pragma unroll
        for (int j = 0; j < 8; ++j) p[j] = sp[(a * 8 + j) * 512];
#pragma unroll
        for (int m = 0; m < 4; ++m) { acc[a][MY][m][0] += p[2 * m]; acc[a][MY][m][1] += p[2 * m + 1]; }
        asm volatile("" : "+v"(acc[a][MY][0][0]), "+v"(acc[a][MY][0][1]), "+v"(acc[a][MY][1][0]), "+v"(acc[a][MY][1][1]), "+v"(acc[a][MY][2][0]), "+v"(acc[a][MY][2][1]), "+v"(acc[a][MY][3][0]), "+v"(acc[a][MY][3][1]) :: "memory"); }
    E.template run<(1 << MY)>(acc, cur, wr, wc, fr, fq);
}
__device__ __forceinline__ void sk_exchange(f32x4 (&acc)[2][2][4][2], int me, int pc, const SkShare& sk, int tid, int lane) {
    int tid2 = tid; asm volatile("" : "+v"(tid2));
    const __amdgpu_buffer_rsrc_t rs = __builtin_amdgcn_make_buffer_rsrc(sk.slab + (size_t)me * 65536, 0, 262144, 0x00020000);
#pragma unroll
    for (int a = 0; a < 2; ++a)
#pragma unroll
        for (int m = 0; m < 4; ++m)
#pragma unroll
            for (int n = 0; n < 2; ++n) __builtin_amdgcn_raw_buffer_store_b128(__builtin_bit_cast(u32x4, acc[a][1][m][n]), rs, (unsigned)(((a * 4 + m) * 2 + n) * 512 + tid2) * 16u, 0, 16);
    asm volatile("s_waitcnt vmcnt(0)" ::: "memory");
    if (lane == 0) __hip_atomic_fetch_add(sk.flags + 16 * me, 1u, __ATOMIC_RELAXED, __HIP_MEMORY_SCOPE_AGENT);
    unsigned spins = 0;
    while ((unsigned)__builtin_amdgcn_readfirstlane(__hip_atomic_load(sk.flags + 16 * pc, __ATOMIC_RELAXED, __HIP_MEMORY_SCOPE_AGENT)) < 8u) {
        __builtin_amdgcn_s_sleep(1);
        if ((++spins & 255u) == 0u) { if (__builtin_amdgcn_readfirstlane(__hip_atomic_load(sk.tmo, __ATOMIC_RELAXED, __HIP_MEMORY_SCOPE_AGENT)) != 0u) break;
            if (spins > (1u << 20)) { if (lane == 0) __hip_atomic_store(sk.tmo, 1u, __ATOMIC_RELAXED, __HIP_MEMORY_SCOPE_AGENT); break; } } }
    __builtin_amdgcn_fence(__ATOMIC_ACQUIRE, "agent");
    asm volatile("s_waitcnt vmcnt(0)" ::: "memory");
    const f32x4* sp = (const f32x4*)(sk.slab + (size_t)pc * 65536) + tid2;
#pragma unroll
    for (int a = 0; a < 2; ++a)
#pragma unroll
        for (int mm = 0; mm < 4; mm += 2) {
            const f32x4 p0 = sp[(a * 8 + 2 * mm + 0) * 512], p1 = sp[(a * 8 + 2 * mm + 1) * 512], p2 = sp[(a * 8 + 2 * mm + 2) * 512], p3 = sp[(a * 8 + 2 * mm + 3) * 512];
            acc[a][0][mm][0] += p0; acc[a][0][mm][1] += p1; acc[a][0][mm + 1][0] += p2; acc[a][0][mm + 1][1] += p3;
            asm volatile("" : "+v"(acc[a][0][mm][0]), "+v"(acc[a][0][mm][1]), "+v"(acc[a][0][mm + 1][0]), "+v"(acc[a][0][mm + 1][1]) :: "memory"); }
}
template <class Epi, class Sched, bool ALIGN_EPI = false, bool SP2 = false>
__device__ __forceinline__ void gemm_phase(PG8_LAS unsigned char* lds, const Gemm g, Sched& S, const Epi& E, const SkShare sk) {
    const int tid = threadIdx.x, wid = __builtin_amdgcn_readfirstlane(tid >> 6), lane = tid & 63, wr = wid >> 2, wc = wid & 3, fr = lane & 15, fq = lane >> 4;
    const int K = g.K;
    unsigned voffA[2], voffB[2];
#pragma unroll
    for (int i = 0; i < 2; ++i) { int R, C; stage_rc(tid * 16 + i * 8192, R, C); const int Rb = Epi::PERM ? ((R & ~31) + perm32(R & 31)) : R;
        voffA[i] = (unsigned)(R * K + C) * 2u; voffB[i] = (unsigned)(Rb * K + C) * 2u; }
    const size_t kstep = (size_t)(BK * 2);
    const size_t hstep = (size_t)HALF * K * 2;
    const size_t tstep = 2 * hstep;
    const unsigned ldsw = (unsigned)wid * 1024u;
    const int aoff = lds_byte(wr * 64 + fr, fq * 8), boff = lds_byte(wc * 32 + fr, fq * 8);
#define PG8_SA(b, h) (((b) * 2 + (h)) * HTB)
#define PG8_SB(b, h) ((4 + (b) * 2 + (h)) * HTB)
#define PG8_STAGE(bufoff, gbase, voff) do { _Pragma("unroll") for (int _i = 0; _i < 2; ++_i) \
        __builtin_amdgcn_global_load_lds((const unsigned*)((const char*)(gbase) + (voff)[_i]), (PG8_LAS unsigned*)(lds + (bufoff) + ldsw + _i * 8192), 16, 0, 0); } while (0)
#define PG8_LDA(dst, b, h) do { _Pragma("unroll") for (int m = 0; m < 4; ++m) _Pragma("unroll") for (int k = 0; k < 2; ++k) dst[m][k] = *(const PG8_LAS bf16x8*)(lds + PG8_SA(b, h) + aoff + m * 2048 + k * 1024); } while (0)
#define PG8_LDB(dst, b, h) do { _Pragma("unroll") for (int n = 0; n < 2; ++n) _Pragma("unroll") for (int k = 0; k < 2; ++k) dst[n][k] = *(const PG8_LAS bf16x8*)(lds + PG8_SB(b, h) + boff + n * 2048 + k * 1024); } while (0)
#define PG8_MMA(ai, bj, At, Bt) do { __builtin_amdgcn_s_setprio(1); _Pragma("unroll") for (int m = 0; m < 4; ++m) _Pragma("unroll") for (int n = 0; n < 2; ++n) _Pragma("unroll") for (int k = 0; k < 2; ++k) \
        acc[ai][bj][m][n] = __builtin_amdgcn_mfma_f32_16x16x32_bf16(Bt[n][k], At[m][k], acc[ai][bj][m][n], 0, 0, 0); __builtin_amdgcn_s_setprio(0); } while (0)
#define PG8_WAIT_V(n) asm volatile("s_waitcnt vmcnt(" #n ")" ::: "memory")
#define PG8_WAIT_L(n) asm volatile("s_waitcnt lgkmcnt(" #n ")" ::: "memory")
#define PG8_BAR __builtin_amdgcn_s_barrier()
#define PG8_SCHED __builtin_amdgcn_sched_barrier(0)
    Unit cur, nxt; int ui = 0;
    if (!S.next(0, cur)) return;
    int tg0 = -1, tg1 = -1, tg2 = -1, tg3 = -1, tg4 = -1, tg5 = -1;
#define PG8_TGET(sl) ((sl) == 0 ? tg0 : (sl) == 1 ? tg1 : (sl) == 2 ? tg2 : (sl) == 3 ? tg3 : (sl) == 4 ? tg4 : tg5)
#define PG8_TSET(sl, v) do { if ((sl) == 0) tg0 = (v); else if ((sl) == 1) tg1 = (v); else if ((sl) == 2) tg2 = (v); else if ((sl) == 3) tg3 = (v); else if ((sl) == 4) tg4 = (v); else tg5 = (v); } while (0)
#define PG8_SLOT(n, cpar, cpm) ({ int _s = (n).role != 0 ? 5 : (((n).pm >> 3) % 5); if (_s == (cpar) && (n).pm != (cpm)) _s = ((cpar) == 5) ? 4 : 5; _s; })
    if constexpr (Epi::CACHED_TAB) { cur.par = PG8_SLOT(cur, -1, -1); PG8_TSET(cur.par, cur.pm); } else cur.par = 0;
    E.prep(cur, tid);
    f32x4 acc[2][2][4][2];
#pragma unroll
    for (int a = 0; a < 2; ++a)
#pragma unroll
        for (int b = 0; b < 2; ++b)
#pragma unroll
            for (int m = 0; m < 4; ++m)
#pragma unroll
                for (int n = 0; n < 2; ++n) acc[a][b][m][n] = (f32x4){0.f, 0.f, 0.f, 0.f};
    bf16x8 At[4][2], B0[2][2], B1[2][2];
    const char* cA = (const char*)g.A + (size_t)cur.pm * tstep + (size_t)cur.k0 * kstep; const char* cB = (const char*)g.Bt + (size_t)cur.pn * tstep + (size_t)cur.k0 * kstep;
    if constexpr (SP2) {
        PG8_STAGE(PG8_SB(0, 0), cB, voffB); PG8_STAGE(PG8_SB(0, 1), cB + hstep, voffB); PG8_STAGE(PG8_SA(0, 0), cA, voffA); PG8_STAGE(PG8_SA(0, 1), cA + hstep, voffA);
        if (wr == 1) PG8_BAR;
        PG8_WAIT_V(2); PG8_BAR;
        PG8_STAGE(PG8_SB(1, 0), cB + kstep, voffB); PG8_STAGE(PG8_SA(1, 0), cA + kstep, voffA); PG8_STAGE(PG8_SB(1, 1), cB + hstep + kstep, voffB);
        PG8_WAIT_V(6); PG8_BAR;
    } else {
        PG8_STAGE(PG8_SB(0, 0), cB, voffB); PG8_STAGE(PG8_SA(0, 0), cA, voffA); PG8_STAGE(PG8_SB(0, 1), cB + hstep, voffB); PG8_STAGE(PG8_SA(0, 1), cA + hstep, voffA);
        if (wr == 1) PG8_BAR;
        PG8_WAIT_V(4); PG8_BAR;
        PG8_STAGE(PG8_SB(1, 0), cB + kstep, voffB); PG8_STAGE(PG8_SA(1, 0), cA + kstep, voffA); PG8_STAGE(PG8_SB(1, 1), cB + hstep + kstep, voffB);
        PG8_WAIT_V(6); PG8_BAR;
    }
    for (;;) {
        const bool has_next = S.next(ui + 1, nxt);
        if constexpr (Epi::CACHED_TAB) nxt.par = has_next ? PG8_SLOT(nxt, cur.par, cur.pm) : cur.par;
        else nxt.par = (has_next && nxt.pm != cur.pm) ? (cur.par ^ 1) : cur.par;
        const char* nA = has_next ? (const char*)g.A + (size_t)nxt.pm * tstep + (size_t)nxt.k0 * kstep : cA; const char* nB = has_next ? (const char*)g.Bt + (size_t)nxt.pn * tstep + (size_t)nxt.k0 * kstep : cB;
        const int nt = cur.nt;
        for (int t = 0; t < nt; t += 2) {
            const bool last = (t == nt - 2);
            const char* a1 = cA + (size_t)(t + 1) * kstep;
            const char* a2 = last ? nA : cA + (size_t)(t + 2) * kstep; const char* b2 = last ? nB : cB + (size_t)(t + 2) * kstep;
            const char* a3 = a2 + kstep; const char* b3 = b2 + kstep;
            if constexpr (SP2) {
            PG8_LDB(B0, 0, 0); PG8_LDB(B1, 0, 1); PG8_SCHED; PG8_LDA(At, 0, 0); PG8_STAGE(PG8_SA(1, 1), a1 + hstep, voffA);
            PG8_WAIT_V(8); PG8_WAIT_L(0); PG8_BAR; PG8_MMA(0, 0, At, B0); PG8_MMA(0, 1, At, B1); PG8_BAR; PG8_SCHED;
            PG8_LDA(At, 0, 1); PG8_STAGE(PG8_SB(0, 0), b2, voffB); PG8_STAGE(PG8_SB(0, 1), b2 + hstep, voffB); PG8_STAGE(PG8_SA(0, 0), a2, voffA);
            PG8_WAIT_V(8); PG8_WAIT_L(0); PG8_BAR; PG8_MMA(1, 0, At, B0); PG8_MMA(1, 1, At, B1); PG8_BAR; PG8_SCHED;
            PG8_LDB(B0, 1, 0); PG8_LDB(B1, 1, 1); PG8_SCHED; PG8_LDA(At, 1, 0); PG8_STAGE(PG8_SA(0, 1), a2 + hstep, voffA);
            PG8_WAIT_V(8); PG8_WAIT_L(0); PG8_BAR; PG8_MMA(0, 0, At, B0); PG8_MMA(0, 1, At, B1); PG8_BAR; PG8_SCHED;
            PG8_LDA(At, 1, 1); PG8_STAGE(PG8_SB(1, 0), b3, voffB); PG8_STAGE(PG8_SB(1, 1), b3 + hstep, voffB); PG8_STAGE(PG8_SA(1, 0), a3, voffA);
            PG8_WAIT_V(8); PG8_WAIT_L(0); PG8_BAR; PG8_MMA(1, 0, At, B0); PG8_MMA(1, 1, At, B1); PG8_BAR; PG8_SCHED;
            } else {
            PG8_LDB(B0, 0, 0); PG8_SCHED; PG8_LDA(At, 0, 0); PG8_STAGE(PG8_SA(1, 1), a1 + hstep, voffA);
            PG8_WAIT_L(8); PG8_BAR; PG8_WAIT_L(0); PG8_MMA(0, 0, At, B0); PG8_BAR; PG8_SCHED;
            PG8_LDB(B1, 0, 1); PG8_STAGE(PG8_SB(0, 0), b2, voffB);
            PG8_BAR; PG8_WAIT_L(0); PG8_MMA(0, 1, At, B1); PG8_BAR;
            PG8_LDA(At, 0, 1); PG8_STAGE(PG8_SA(0, 0), a2, voffA);
            PG8_BAR; PG8_WAIT_L(0); PG8_MMA(1, 0, At, B0); PG8_BAR; PG8_SCHED;
            PG8_STAGE(PG8_SB(0, 1), b2 + hstep, voffB);
            PG8_WAIT_V(6); PG8_BAR; PG8_MMA(1, 1, At, B1); PG8_BAR;
            PG8_LDB(B0, 1, 0); PG8_SCHED; PG8_LDA(At, 1, 0); PG8_STAGE(PG8_SA(0, 1), a2 + hstep, voffA);
            PG8_WAIT_L(8); PG8_BAR; PG8_WAIT_L(0); PG8_MMA(0, 0, At, B0); PG8_BAR; PG8_SCHED;
            PG8_LDB(B1, 1, 1); PG8_STAGE(PG8_SB(1, 0), b3, voffB);
            PG8_BAR; PG8_WAIT_L(0); PG8_MMA(0, 1, At, B1); PG8_BAR;
            PG8_LDA(At, 1, 1); PG8_STAGE(PG8_SA(1, 0), a3, voffA);
            PG8_BAR; PG8_WAIT_L(0); PG8_MMA(1, 0, At, B0); PG8_BAR; PG8_SCHED;
            PG8_STAGE(PG8_SB(1, 1), b3 + hstep, voffB);
            PG8_WAIT_V(6); PG8_BAR; PG8_MMA(1, 1, At, B1); PG8_BAR;
            }
        }
        if constexpr (ALIGN_EPI) { if (wr == 0) PG8_BAR; }
        if (cur.role != 0) break;
        E.template run<3>(acc, cur, wr, wc, fr, fq);
        if (!has_next) break;
        if constexpr (Epi::CACHED_TAB) { if (PG8_TGET(nxt.par) != nxt.pm) { E.prep(nxt, tid); PG8_TSET(nxt.par, nxt.pm); } }
        else if (nxt.pm != cur.pm) E.prep(nxt, tid);
#pragma unroll
        for (int a = 0; a < 2; ++a)
#pragma unroll
            for (int b = 0; b < 2; ++b)
#pragma unroll
                for (int m = 0; m < 4; ++m)
#pragma unroll
                    for (int n = 0; n < 2; ++n) acc[a][b][m][n] = (f32x4){0.f, 0.f, 0.f, 0.f};
        cur = nxt; cA = nA; cB = nB; ++ui;
        if constexpr (ALIGN_EPI) { if (wr == 1) PG8_BAR; }
    }
    PG8_WAIT_V(0);
    if constexpr (!ALIGN_EPI) { if (wr == 0) PG8_BAR; }
    PG8_BAR;
    if constexpr (Epi::ONE_FINISH) {
        if (cur.role != 0) { const int my = cur.role == 2 ? 0 : 1;
            if (my == 1) {
#pragma unroll
                for (int a = 0; a < 2; ++a)
#pragma unroll
                    for (int m = 0; m < 4; ++m)
#pragma unroll
                        for (int n = 0; n < 2; ++n) { const f32x4 t = acc[a][0][m][n]; acc[a][0][m][n] = acc[a][1][m][n]; acc[a][1][m][n] = t; } }
            sk_exchange(acc, S.c, my == 0 ? S.c + NXCD : S.c - NXCD, sk, tid, lane);
            E.run_half(acc, cur, wr, wc, fr, fq, my); }
    } else {
        if (cur.role == 2) sk_finish<0>(acc, cur, S.c, S.c + NXCD, sk, E, tid, lane, wr, wc, fr, fq);
        else if (cur.role == 1) sk_finish<1>(acc, cur, S.c, S.c - NXCD, sk, E, tid, lane, wr, wc, fr, fq);
    }
#undef PG8_SA
#undef PG8_SB
#undef PG8_STAGE
#undef PG8_LDA
#undef PG8_LDB
#undef PG8_MMA
#undef PG8_TGET
#undef PG8_TSET
#undef PG8_SLOT
#undef PG8_WAIT_V
#undef PG8_WAIT_L
#undef PG8_BAR
#undef PG8_SCHED
}
}

#define GAS __attribute__((address_space(1)))
#define LAS __attribute__((address_space(3)))
typedef unsigned short bf16;
typedef unsigned v4u __attribute__((ext_vector_type(4)));
typedef float f32x4 __attribute__((ext_vector_type(4)));
typedef short bf16x8 __attribute__((ext_vector_type(8)));
typedef GAS unsigned gu32;
typedef GAS unsigned long long gu64;
#define RLX_AGENT __ATOMIC_RELAXED, __HIP_MEMORY_SCOPE_AGENT
#define LDS_WAIT() asm volatile("s_waitcnt lgkmcnt(0)" ::: "memory")
#define VM_WAIT() asm volatile("s_waitcnt vmcnt(0)" ::: "memory")
__device__ __forceinline__ unsigned long long rt() { return __builtin_amdgcn_s_memrealtime(); }

#define XB_TMO      128
#define XB_XCNT(j)  (256  + 64 * (j))
#define XB_XSUB(j)  (1280 + 64 * (j))
#define XB_XGEN(j)  (2304 + 64 * (j))
#define XB_TOP      3328
#define XB_TOPGEN   3392
#define XCD_BAR_WORDS 3456
#define XB_SPIN_CAP (1u << 18)

__device__ __forceinline__ unsigned xb_ld(unsigned* p)              { return __hip_atomic_load(p, __ATOMIC_RELAXED, __HIP_MEMORY_SCOPE_AGENT); }
__device__ __forceinline__ unsigned xb_add(unsigned* p, unsigned v) { return __hip_atomic_fetch_add(p, v, __ATOMIC_RELAXED, __HIP_MEMORY_SCOPE_AGENT); }
__device__ __forceinline__ unsigned xb_xcc_id() { return (unsigned)__builtin_amdgcn_s_getreg((3 << 11) | 20) & 0xFu; }
#define XB_SPIN(cond, bar) do { unsigned _sp = 0; while (cond) { __builtin_amdgcn_s_sleep(1); \
    if ((++_sp & 255u) == 0u) { if (xb_ld(&(bar)[XB_TMO])) break; if (_sp > XB_SPIN_CAP) { atomicAdd(&(bar)[XB_TMO], 1u); break; } } } } while (0)

struct XcdBarrier {
    unsigned* bar; unsigned x;
    volatile LAS unsigned* st;
};

__device__ __forceinline__ XcdBarrier xcd_barrier_post(unsigned* bar, volatile LAS unsigned* st) {
    XcdBarrier b; b.bar = bar; b.x = xb_xcc_id(); b.st = st;
    if (threadIdx.x == 0) (void)xb_add(&bar[XB_XCNT(b.x)], 1u);
    return b;
}
__device__ __forceinline__ void xcd_barrier_complete(unsigned* bar, unsigned x, unsigned& nloc, unsigned& nx) {
    const unsigned G = gridDim.x * gridDim.y * gridDim.z;
    unsigned sum, cnt, mine, sp = 0u;
    for (;;) {
        sum = 0u; cnt = 0u; mine = 0u;
#pragma unroll
        for (unsigned j = 0; j < 16; ++j) { const unsigned c = xb_ld(&bar[XB_XCNT(j)]); sum += c; cnt += (c > 0u) ? 1u : 0u; mine = (j == x) ? c : mine; }
        if (sum == G) break;
        __builtin_amdgcn_s_sleep(1);
        if ((++sp & 255u) == 0u) { if (xb_ld(&bar[XB_TMO])) break; if (sp > XB_SPIN_CAP) { atomicAdd(&bar[XB_TMO], 1u); break; } }
    }
    nloc = mine > 0u ? mine : 1u; nx = cnt > 0u ? cnt : 1u;
}

__device__ __forceinline__ void xcd_barrier(const XcdBarrier& b) {
    asm volatile("s_waitcnt vmcnt(0)" ::: "memory");
    __syncthreads();
    if (threadIdx.x == 0) {
        unsigned* bar = b.bar;
        __builtin_amdgcn_s_waitcnt(0);
        unsigned nloc = b.st[0], nx = b.st[1];
        if (nloc == 0u) { xcd_barrier_complete(bar, b.x, nloc, nx); b.st[0] = nloc; b.st[1] = nx; }
        const unsigned old = xb_add(&bar[XB_XSUB(b.x)], 1u);
        const unsigned gen = old / nloc;
        if (old + 1u == (gen + 1u) * nloc) {
            __builtin_amdgcn_fence(__ATOMIC_RELEASE, "agent");
            asm volatile("s_waitcnt vmcnt(0)" ::: "memory");
            const unsigned og = xb_add(&bar[XB_TOP], 1u);
            const unsigned tg = og / nx;
            if (og + 1u == (tg + 1u) * nx) xb_add(&bar[XB_TOPGEN], 1u);
            else XB_SPIN(xb_ld(&bar[XB_TOPGEN]) == tg, bar);
            __builtin_amdgcn_fence(__ATOMIC_ACQUIRE, "agent");
            xb_add(&bar[XB_XGEN(b.x)], 1u);
            asm volatile("s_waitcnt vmcnt(0)" ::: "memory");
        } else {
            XB_SPIN(xb_ld(&bar[XB_XGEN(b.x)]) == gen, bar);
            __builtin_amdgcn_fence(__ATOMIC_ACQUIRE, "agent");
            asm volatile("s_waitcnt vmcnt(0)" ::: "memory");
        }
    }
    __syncthreads();
}

constexpr int NWAVES = 8, NTHR = 512;
#ifndef MK_N_LAUNCHES
#define MK_N_LAUNCHES 1
#endif
constexpr int N_PHASES = 18;
constexpr int N_LAUNCHES = MK_N_LAUNCHES;
constexpr int D = 4096, MP = 8192, MS = 2048, M = MP + MS;
constexpr int CONVD = 2048, NPROJ = 9216, DFF = 11008, NUP = 22016, NGM = 8192;
constexpr int OFF_GB = 0, OFF_GC = 2048, OFF_HV = 4096, OFF_Q = 6144, OFF_K = 8192, OFF_V = 8704;
constexpr float RMS_EPS = 1e-6f, LN_EPS = 1e-5f;
constexpr size_t O_YP = 0, O_YS = O_YP + (size_t)MP * D, O_CP = O_YS + (size_t)MS * D, O_CS = O_CP + 4 * 2 * 2048, O_KP = O_CS + 32 * 2 * 2048, O_KS = O_KP + 4 * 128 * 512,
                 O_VP = O_KS + 32 * 128 * 512, O_VS = O_VP + 4 * 128 * 512, O_FP = O_VS + 32 * 128 * 512, O_FS = O_FP + (size_t)2 * 4 * 2 * NUP, O_GV = O_FS + (size_t)2 * 32 * 2 * NUP,
                 O_END = O_GV + (size_t)MS * D;
constexpr size_t MiB = 1u << 20;
constexpr size_t WS_CTL = 0, CTL_ZERO_BYTES = 1 * MiB;
constexpr size_t WS_WIN = 1 * MiB, WS_WOUT = WS_WIN + (size_t)NPROJ * D * 2, WS_WINC = WS_WOUT + (size_t)D * D * 2, WS_WOUTC = WS_WINC + (size_t)NGM * D * 2,
                 WS_WUP = WS_WOUTC + (size_t)D * D * 2, WS_WDN = WS_WUP + (size_t)2 * NUP * D * 2, WS_XN = WS_WDN + (size_t)2 * D * DFF * 2,
                 WS_PROJ = WS_XN + (size_t)M * D * 2, WS_MIX = WS_PROJ + (size_t)M * NPROJ * 2, WS_X = WS_MIX + (size_t)M * D * 2, WS_UP = WS_X + (size_t)M * D * 4,
                 WS_ACT = WS_UP + (size_t)M * NUP * 2, WS_Z = WS_ACT + (size_t)M * DFF * 2, WS_VLN = WS_Z + (size_t)M * NGM * 2, WS_RS = WS_VLN + (size_t)M * D * 2, WS_LS = WS_RS + (size_t)M * 128 * 4, WS_RSTD = WS_LS + (size_t)M * 128 * 8, WS_SLAB = WS_RSTD + (size_t)M * 4, WS_SIDE = WS_SLAB + (size_t)2 * 256 * 262144, WS_END = WS_SIDE + (size_t)32 * 4 * NUP * 4;
constexpr int CW_BAR = 4096, CW_SK = 16384;
constexpr int RING_OFF = 0, RING_BYTES = 131072, LDSCTL_OFF = RING_BYTES, MISC_OFF = LDSCTL_OFF + 320, TAB_OFF = LDSCTL_OFF + 1024  , BND_OFF = TAB_OFF + 2048  , TABC_OFF = BND_OFF + 16384  , LDS_BYTES = TABC_OFF + 6144;

typedef unsigned short bf16;
typedef unsigned u32x4 __attribute__((ext_vector_type(4)));
typedef unsigned u32x2 __attribute__((ext_vector_type(2)));
typedef float f32x4 __attribute__((ext_vector_type(4)));
typedef float f32x16 __attribute__((ext_vector_type(16)));
typedef short bf16x8 __attribute__((ext_vector_type(8)));
typedef short s16x4 __attribute__((ext_vector_type(4)));
#define LDS_WAIT() asm volatile("s_waitcnt lgkmcnt(0)" ::: "memory")
#define MFMA32(a, b, c) __builtin_amdgcn_mfma_f32_32x32x16_bf16((a), (b), (c), 0, 0, 0)

struct Args {
    const float *x_p, *x_s, *st_conv, *cache_k, *cache_v, *st_ffn, *norm_mix, *norm_ffn, *norm_final, *w_in_ab, *conv_w_a, *sinks, *w_out_ab, *w_in_c, *ln_g, *ln_b, *w_s, *b_s, *w_out_c,
        *w_up, *conv_w_ffn, *conv_b_ffn, *w_down;
    float* out; unsigned char* ws; int ph_lo, ph_hi;
};

__device__ __forceinline__ float bflo(unsigned w) { return __uint_as_float(w << 16); }
__device__ __forceinline__ float bfhi(unsigned w) { return __uint_as_float(w & 0xffff0000u); }
__device__ __forceinline__ unsigned pk2(float lo, float hi) { return pg8::cvt_pk_bf16(lo, hi); }
__device__ __forceinline__ void unpack8(const u32x4 w, float (&f)[8]) { f[0] = bflo(w.x); f[1] = bfhi(w.x); f[2] = bflo(w.y); f[3] = bfhi(w.y); f[4] = bflo(w.z); f[5] = bfhi(w.z); f[6] = bflo(w.w); f[7] = bfhi(w.w); }
__device__ __forceinline__ u32x4 pack8(const float (&f)[8]) { u32x4 w; w.x = pk2(f[0], f[1]); w.y = pk2(f[2], f[3]); w.z = pk2(f[4], f[5]); w.w = pk2(f[6], f[7]); return w; }
__device__ __forceinline__ void load8f(const float* p, float (&f)[8]) { const f32x4 a = *(const f32x4*)p, b = *(const f32x4*)(p + 4); f[0] = a.x; f[1] = a.y; f[2] = a.z; f[3] = a.w; f[4] = b.x; f[5] = b.y; f[6] = b.z; f[7] = b.w; }
__device__ __forceinline__ void store8f(float* p, const float (&f)[8]) { *(f32x4*)p = (f32x4){f[0], f[1], f[2], f[3]}; *(f32x4*)(p + 4) = (f32x4){f[4], f[5], f[6], f[7]}; }
__device__ __forceinline__ float wave_sum(float v) {
#pragma unroll
    for (int o = 1; o < 64; o <<= 1) v += __shfl_xor(v, o);
    return v;
}
__device__ __forceinline__ int crow(int r, int hi) { return (r & 3) + 8 * (r >> 2) + 4 * hi; }

__device__ __forceinline__ void p0_load_item(const float* W, const float* gain, int N, int item, int lane, f32x4 (&v)[8]) {
    const int nblk = N / 32, kb = item / nblk, nb = item % nblk;
    const float* src = W + (size_t)(64 * kb + 8 * (lane >> 3)) * N + 32 * nb + 4 * (lane & 7);
#pragma unroll
    for (int i = 0; i < 8; ++i) v[i] = __builtin_nontemporal_load((const f32x4*)(src + (size_t)i * N));
    if (gain) { float gk[8]; load8f(gain + 64 * kb + 8 * (lane >> 3), gk);
#pragma unroll
        for (int i = 0; i < 8; ++i) v[i] = v[i] * gk[i]; }
}
template <bool PERMUP> __device__ __forceinline__ void p0_store_item(bf16* WT, int K, int N, int item, int lane, const f32x4 (&v)[8]) {
    const int nblk = N / 32, kb = item / nblk, nb = item % nblk;
    int rowb = 32 * nb + 4 * (lane & 7);
    if (PERMUP) { const int s0 = 32 * nb, hf = s0 >= DFF ? 1 : 0, ch = s0 - hf * DFF + 4 * (lane & 7), t = ch >> 7, ct = ch & 127;
        rowb = 256 * t + 128 * (ct >> 6) + 32 * ((ct >> 4) & 3) + 8 * ((ct >> 2) & 3) + 4 * hf; }
    bf16* dst = WT + (size_t)rowb * K + 64 * kb + 8 * (lane >> 3);
#pragma unroll
    for (int j = 0; j < 4; ++j) { u32x4 o; o.x = pk2(v[0][j], v[1][j]); o.y = pk2(v[2][j], v[3][j]); o.z = pk2(v[4][j], v[5][j]); o.w = pk2(v[6][j], v[7][j]);
        *(u32x4*)(dst + (size_t)j * K) = o; }
}
template <int NI, bool PERMUP = false> __device__ __forceinline__ void p0_transpose(const float* W, const float* gain, int K, int N, bf16* WT, int gw, int NGW, int lane) {
    const int nitems = (K / 64) * (N / 32);
    for (int it = gw; it < nitems; it += NI * NGW) {
        f32x4 v[NI][8];
#pragma unroll
        for (int j = 0; j < NI; ++j) { const int itj = it + j * NGW; if (itj < nitems) p0_load_item(W, gain, N, itj, lane, v[j]); }
#pragma unroll
        for (int j = 0; j < NI; ++j) { const int itj = it + j * NGW; if (itj < nitems) p0_store_item<PERMUP>(WT, K, N, itj, lane, v[j]); }
    }
}
__device__ __forceinline__ void final_row2(const float* x0, const float* x1, const float* rs0, const float* rs1, const float* g, float* o0, float* o1, bool two, int lane) {
    const float s = wave_sum(rs0[lane] + rs0[64 + lane]), t = wave_sum(rs1[lane] + rs1[64 + lane]);
    const float ra = 1.0f / sqrtf(s * (1.f / D) + RMS_EPS), rb = 1.0f / sqrtf(t * (1.f / D) + RMS_EPS);
    const f32x4* xr0 = (const f32x4*)x0 + lane; const f32x4* xr1 = (const f32x4*)x1 + lane; const f32x4* gr = (const f32x4*)g + lane;
#pragma unroll
    for (int j = 0; j < 16; ++j) { const f32x4 gg = gr[64 * j]; const f32x4 y = __builtin_nontemporal_load(xr0 + 64 * j) * ra * gg; __builtin_nontemporal_store(y, (f32x4*)o0 + lane + 64 * j);
        if (two) { const f32x4 z = __builtin_nontemporal_load(xr1 + 64 * j) * rb * gg; __builtin_nontemporal_store(z, (f32x4*)o1 + lane + 64 * j); } }
}
template <bool OUTF> __device__ __forceinline__ void rms_row2(const float* x0, const float* x1, const float* g, void* o0, void* o1, bool two, int lane) {
    const f32x4* xr0 = (const f32x4*)x0 + lane; const f32x4* xr1 = (const f32x4*)x1 + lane;
    f32x4 v[16], w[16]; float s = 0.f, t = 0.f;
#pragma unroll
    for (int j = 0; j < 16; ++j) v[j] = OUTF ? __builtin_nontemporal_load(xr0 + 64 * j) : xr0[64 * j];
    if (two) {
#pragma unroll
        for (int j = 0; j < 16; ++j) w[j] = OUTF ? __builtin_nontemporal_load(xr1 + 64 * j) : xr1[64 * j];
    } else {
#pragma unroll
        for (int j = 0; j < 16; ++j) w[j] = (f32x4){0.f, 0.f, 0.f, 0.f};
    }
#pragma unroll
    for (int j = 0; j < 16; ++j) { s += (v[j].x * v[j].x + v[j].y * v[j].y) + (v[j].z * v[j].z + v[j].w * v[j].w); t += (w[j].x * w[j].x + w[j].y * w[j].y) + (w[j].z * w[j].z + w[j].w * w[j].w); }
    const float rs = 1.0f / sqrtf(wave_sum(s) * (1.f / D) + RMS_EPS), rt = 1.0f / sqrtf(wave_sum(t) * (1.f / D) + RMS_EPS);
    const f32x4* gr = (const f32x4*)g + lane;
#pragma unroll
    for (int j = 0; j < 16; ++j) { const f32x4 gg = gr[64 * j]; const f32x4 y = v[j] * rs * gg, z = w[j] * rt * gg;
        if (OUTF) { __builtin_nontemporal_store(y, (f32x4*)o0 + lane + 64 * j); if (two) __builtin_nontemporal_store(z, (f32x4*)o1 + lane + 64 * j); }
        else { u32x2 a; a.x = pk2(y.x, y.y); a.y = pk2(y.z, y.w); ((u32x2*)o0 + lane)[64 * j] = a; if (two) { u32x2 b; b.x = pk2(z.x, z.y); b.y = pk2(z.z, z.w); ((u32x2*)o1 + lane)[64 * j] = b; } } }
}
struct Ctx { int tid, lane, wave, vcu, G; LAS unsigned char* lds; };

__device__ __forceinline__ void phase_rms(const Ctx& c, const float* xp, const float* xs, const float* g, bf16* XN) {
    const int gw = c.vcu * NWAVES + c.wave, NGW = c.G * NWAVES;
    for (int m = gw; m < M; m += 2 * NGW) { const int m2 = m + NGW; const bool two = m2 < M; const int mm = two ? m2 : m;
        const float* x0 = m < MP ? xp + (size_t)m * D : xs + (size_t)(m - MP) * D; const float* x1 = mm < MP ? xp + (size_t)mm * D : xs + (size_t)(mm - MP) * D;
        rms_row2<false>(x0, x1, g, XN + (size_t)m * D, XN + (size_t)mm * D, two, c.lane); }
}
__device__ __forceinline__ void phase_final(const Ctx& c, const bf16* X, const float* RS, const float* g, float* out) {
    const int rpbn = (M + c.G - 1) / c.G, r0 = c.vcu * rpbn, rpb = r0 >= M ? 0 : (M - r0 < rpbn ? M - r0 : rpbn);
    LAS float* tab = (LAS float*)(c.lds + TAB_OFF);
    for (int r = c.wave; r < rpb; r += NWAVES) { const float* rs = RS + (size_t)(r0 + r) * 128; const float s = wave_sum(rs[c.lane] + rs[64 + c.lane]); if (c.lane == 0) tab[r] = 1.0f / sqrtf(s * (1.f / D) + RMS_EPS); }
    __syncthreads();
    const u32x4* xp = (const u32x4*)(X + (size_t)r0 * D); float* op = out + O_YP + (size_t)r0 * D;
    const int n8 = rpb * (D / 8);
    for (int i0 = c.tid; i0 < n8; i0 += 16 * NTHR) {
        u32x4 v[16];
#pragma unroll
        for (int j = 0; j < 16; ++j) { const int i = i0 + j * NTHR; if (i < n8) v[j] = __builtin_nontemporal_load(xp + i); }
#pragma unroll
        for (int j = 0; j < 16; ++j) { const int i = i0 + j * NTHR; if (i < n8) { const float rs = tab[i >> 9]; float f[8], gg[8]; unpack8(v[j], f); load8f(g + (i & 511) * 8, gg);
#pragma unroll
                for (int e = 0; e < 8; ++e) f[e] = f[e] * rs * gg[e];
                __builtin_nontemporal_store((f32x4){f[0], f[1], f[2], f[3]}, (f32x4*)(op + (size_t)i * 8)); __builtin_nontemporal_store((f32x4){f[4], f[5], f[6], f[7]}, (f32x4*)(op + (size_t)i * 8 + 4)); } }
    }
    __syncthreads();
}
template <int NI> __device__ __forceinline__ void convert_weights(const Args& a, int which, int gw, int NGW, int lane) {
    unsigned char* ws = a.ws;
    if (which & 1) p0_transpose<NI>(a.w_in_ab, nullptr, D, NPROJ, (bf16*)(ws + WS_WIN), gw, NGW, lane);
    if (which & 2) p0_transpose<NI>(a.w_out_ab, nullptr, D, D, (bf16*)(ws + WS_WOUT), gw, NGW, lane);
    if (which & 4) p0_transpose<NI, true>(a.w_up, a.norm_ffn, D, NUP, (bf16*)(ws + WS_WUP), gw, NGW, lane);
    if (which & 8) p0_transpose<NI>(a.w_down, nullptr, DFF, D, (bf16*)(ws + WS_WDN), gw, NGW, lane);
    if (which & 16) p0_transpose<NI>(a.w_in_c, a.norm_mix + D, D, NGM, (bf16*)(ws + WS_WINC), gw, NGW, lane);
    if (which & 32) p0_transpose<NI>(a.w_out_c, nullptr, D, D, (bf16*)(ws + WS_WOUTC), gw, NGW, lane);
    if (which & 64) p0_transpose<NI, true>(a.w_up + (size_t)D * NUP, a.norm_ffn + D, D, NUP, (bf16*)(ws + WS_WUP) + (size_t)NUP * D, gw, NGW, lane);
    if (which & 128) p0_transpose<NI>(a.w_down + (size_t)DFF * D, nullptr, DFF, D, (bf16*)(ws + WS_WDN) + (size_t)D * DFF, gw, NGW, lane);
}
__device__ __forceinline__ void phase_prologue(const Ctx& c, const Args& a) {
#ifndef MK_BST
#define MK_BST true
#endif
#ifndef MK_QUAD
#define MK_QUAD true
#endif
#ifndef MK_P2_CONV
#define MK_P2_CONV 254
#endif
    convert_weights<2>(a, 255 & ~MK_P2_CONV, c.vcu * NWAVES + c.wave, c.G * NWAVES, c.lane);
    phase_rms(c, a.x_p, a.x_s, a.norm_mix, (bf16*)(a.ws + WS_XN));
}

__device__ __forceinline__ void mix0_conv(const Ctx& c, const Args& a) {
    const bf16* PROJ = (const bf16*)(a.ws + WS_PROJ); bf16* MIX = (bf16*)(a.ws + WS_MIX);
    const int gt = c.vcu * NTHR + c.tid, NT = c.G * NTHR;
    for (int it = gt; it < (M / 16) * 256; it += NT) {
        const int cc = it & 255, rb = it >> 8, r0 = rb * 16, ch = cc * 8;
        const bool smp = r0 >= MP; const int t0 = smp ? ((r0 - MP) & 63) : (r0 & 2047), T = smp ? 64 : 2048, b = smp ? ((r0 - MP) >> 6) : (r0 >> 11);
        float w0[8], w1[8], w2[8], p2[8], p1[8];
        load8f(a.conv_w_a + ch, w0); load8f(a.conv_w_a + CONVD + ch, w1); load8f(a.conv_w_a + 2 * CONVD + ch, w2);
        if (t0 == 0) {
            if (smp) { load8f(a.st_conv + (size_t)(b * 2 + 0) * CONVD + ch, p2); load8f(a.st_conv + (size_t)(b * 2 + 1) * CONVD + ch, p1); }
            else {
#pragma unroll
                for (int e = 0; e < 8; ++e) { p2[e] = 0.f; p1[e] = 0.f; } }
        } else {
            float gc[8], hv[8];
            const bf16* pr = PROJ + (size_t)(r0 - 2) * NPROJ + ch;
            unpack8(*(const u32x4*)(pr + OFF_GC), gc); unpack8(*(const u32x4*)(pr + OFF_HV), hv);
#pragma unroll
            for (int e = 0; e < 8; ++e) p2[e] = gc[e] * hv[e];
            pr += NPROJ;
            unpack8(*(const u32x4*)(pr + OFF_GC), gc); unpack8(*(const u32x4*)(pr + OFF_HV), hv);
#pragma unroll
            for (int e = 0; e < 8; ++e) p1[e] = gc[e] * hv[e];
        }
        float* so = a.out + (smp ? O_CS : O_CP) + (size_t)b * 2 * CONVD + ch;
#pragma unroll 1
        for (int i0 = 0; i0 < 16; i0 += 8) {
            u32x4 rb[8], rc[8], rh[8];
#pragma unroll
            for (int i = 0; i < 8; ++i) { const bf16* pr = PROJ + (size_t)(r0 + i0 + i) * NPROJ + ch; rb[i] = *(const u32x4*)(pr + OFF_GB); rc[i] = *(const u32x4*)(pr + OFF_GC); rh[i] = *(const u32x4*)(pr + OFF_HV); }
#pragma unroll
            for (int i = 0; i < 8; ++i) {
                float gb[8], gc[8], hv[8], cur[8], o[8];
                unpack8(rb[i], gb); unpack8(rc[i], gc); unpack8(rh[i], hv);
#pragma unroll
                for (int e = 0; e < 8; ++e) { cur[e] = gc[e] * hv[e]; o[e] = gb[e] * (w0[e] * p2[e] + w1[e] * p1[e] + w2[e] * cur[e]); }
                *(u32x4*)(MIX + (size_t)(r0 + i0 + i) * D + ch) = pack8(o);
                const int j = t0 + i0 + i - (T - 2);
                if (j >= 0) store8f(so + (size_t)j * CONVD, cur);
#pragma unroll
                for (int e = 0; e < 8; ++e) { p2[e] = p1[e]; p1[e] = cur[e]; }
            }
        }
    }
}
__device__ __forceinline__ void mix0_kvstate(const Ctx& c, const Args& a) {
    const bf16* PROJ = (const bf16*)(a.ws + WS_PROJ);
    const int gt = c.vcu * NTHR + c.tid, NT = c.G * NTHR;
    constexpr int NP = 4 * 128 * 64, NS = 32 * 128 * 64;
    for (int it = gt; it < 2 * (NP + NS); it += NT) {
        const int isv = it >= (NP + NS); int r = isv ? it - (NP + NS) : it;
        const int off = isv ? OFF_V : OFF_K; float f[8]; float* o;
        if (r < NP) { const int e8 = r & 63, j = (r >> 6) & 127, b = r >> 13;
            unpack8(*(const u32x4*)(PROJ + (size_t)(b * 2048 + 1920 + j) * NPROJ + off + e8 * 8), f);
            o = a.out + (isv ? O_VP : O_KP) + (size_t)r * 8;
        } else { r -= NP; const int e8 = r & 63, j = (r >> 6) & 127, b = r >> 13;
            if (j < 64) load8f((isv ? a.cache_v : a.cache_k) + ((size_t)(b * 128 + 64 + j) * 512 + e8 * 8), f);
            else unpack8(*(const u32x4*)(PROJ + (size_t)(MP + b * 64 + (j - 64)) * NPROJ + off + e8 * 8), f);
            o = a.out + (isv ? O_VS : O_KS) + (size_t)r * 8;
        }
        store8f(o, f);
    }
}
constexpr int KS_PITCH = 72, VT_PITCH = 200;
__device__ __forceinline__ void attn_unit(const Ctx& c, const Args& a, int unit) {
    const bf16* PROJ = (const bf16*)(a.ws + WS_PROJ); bf16* MIX = (bf16*)(a.ws + WS_MIX);
    const int tid = c.tid, wid = c.wave, lane = c.lane, l32 = lane & 31, hi = lane >> 5;
    const int ch = unit >> 3, kvh = unit & 7;
    LAS bf16* Ks = (LAS bf16*)(c.lds + RING_OFF); LAS bf16* Vt = (LAS bf16*)(c.lds + RING_OFF + 192 * KS_PITCH * 2);
    const bool smp = ch >= 128; int b, qrow0, jmin;
    if (!smp) { b = ch >> 5; const int cq = ch & 31; qrow0 = b * 2048 + cq * 64; jmin = cq >= 2 ? 0 : (2 - cq) * 64; } else { b = ch - 128; qrow0 = MP + b * 64; jmin = 0; }
    const int h = kvh * 4 + (wid >> 1), tq = 32 * (wid & 1) + l32;
    u32x4 qraw[4];
    { const bf16* qp = PROJ + (size_t)(qrow0 + tq) * NPROJ + OFF_Q + h * 64 + 8 * hi;
#pragma unroll
      for (int ks = 0; ks < 4; ++ks) qraw[ks] = *(const u32x4*)(qp + 16 * ks); }
#pragma unroll
    for (int i = 0; i < 3; ++i) {
        const int ci = tid + NTHR * i, j = ci >> 3, cc = ci & 7; u32x4 kv, vv;
        if (j < jmin) { kv = (u32x4){0u, 0u, 0u, 0u}; vv = kv; }
        else if (smp && j < 128) { float f[8]; const size_t o = ((size_t)(b * 128 + j) * 8 + kvh) * 64 + cc * 8; load8f(a.cache_k + o, f); kv = pack8(f); load8f(a.cache_v + o, f); vv = pack8(f); }
        else { const int row = smp ? (MP + b * 64 + (j - 128)) : (qrow0 - 128 + j); const bf16* p = PROJ + (size_t)row * NPROJ + kvh * 64 + cc * 8;
            kv = *(const u32x4*)(p + OFF_K); vv = *(const u32x4*)(p + OFF_V); }
        *(LAS u32x4*)(Ks + j * KS_PITCH + cc * 8) = kv;
        LAS bf16* vt = Vt + (cc * 8) * VT_PITCH + ((((j >> 2) ^ cc)) << 2) + (j & 3);
        vt[0 * VT_PITCH] = (bf16)(vv.x & 0xffffu); vt[1 * VT_PITCH] = (bf16)(vv.x >> 16); vt[2 * VT_PITCH] = (bf16)(vv.y & 0xffffu); vt[3 * VT_PITCH] = (bf16)(vv.y >> 16);
        vt[4 * VT_PITCH] = (bf16)(vv.z & 0xffffu); vt[5 * VT_PITCH] = (bf16)(vv.z >> 16); vt[6 * VT_PITCH] = (bf16)(vv.w & 0xffffu); vt[7 * VT_PITCH] = (bf16)(vv.w >> 16);
    }
    __syncthreads();
    bf16x8 qf[4];
#pragma unroll
    for (int ks = 0; ks < 4; ++ks) { float f[8]; unpack8(qraw[ks], f);
#pragma unroll
        for (int e = 0; e < 8; ++e) f[e] *= 0.125f;
        qf[ks] = __builtin_bit_cast(bf16x8, pack8(f)); }
    const float slope = exp2f(-0.25f * (float)(h + 1)), sink = a.sinks[h];
    const float t0 = (float)(tq + 128 - 4 * hi);
    const int kb0 = jmin >> 5;
    float mx = sink;
#pragma unroll
    for (int kb = 0; kb < 6; ++kb) {
        if (kb >= kb0) { f32x16 acc;
#pragma unroll
            for (int r = 0; r < 16; ++r) acc[r] = 0.f;
#pragma unroll
            for (int ks = 0; ks < 4; ++ks) { const bf16x8 kf = *(const LAS bf16x8*)(Ks + (32 * kb + l32) * KS_PITCH + 16 * ks + 8 * hi); acc = MFMA32(kf, qf[ks], acc); }
#pragma unroll
            for (int r = 0; r < 16; ++r) { const float dist = fabsf(t0 - (float)(32 * kb + (r & 3) + 8 * (r >> 2))); mx = fmaxf(mx, acc[r] - slope * dist); }
        }
        __builtin_amdgcn_sched_barrier(0);
    }
    mx = fmaxf(mx, __shfl_xor(mx, 32));
    f32x16 o0, o1; float sum = 0.f;
#pragma unroll
    for (int r = 0; r < 16; ++r) { o0[r] = 0.f; o1[r] = 0.f; }
#pragma unroll
    for (int kb = 0; kb < 6; ++kb) {
        if (kb >= kb0) { f32x16 acc;
#pragma unroll
            for (int r = 0; r < 16; ++r) acc[r] = 0.f;
#pragma unroll
            for (int ks = 0; ks < 4; ++ks) { const bf16x8 kf = *(const LAS bf16x8*)(Ks + (32 * kb + l32) * KS_PITCH + 16 * ks + 8 * hi); acc = MFMA32(kf, qf[ks], acc); }
            float p[16];
#pragma unroll
            for (int r = 0; r < 16; ++r) { const float dist = fabsf(t0 - (float)(32 * kb + (r & 3) + 8 * (r >> 2))); p[r] = __expf(acc[r] - slope * dist - mx); sum += p[r]; }
#pragma unroll
            for (int s = 0; s < 2; ++s) {
                u32x4 pw; pw.x = pk2(p[8 * s + 0], p[8 * s + 1]); pw.y = pk2(p[8 * s + 2], p[8 * s + 3]); pw.z = pk2(p[8 * s + 4], p[8 * s + 5]); pw.w = pk2(p[8 * s + 6], p[8 * s + 7]);
                const int k0 = l32 >> 3, x0 = 4 * s + hi, x1 = x0 + 2;
                const LAS bf16* vp = Vt + l32 * VT_PITCH + 32 * kb;
                const s16x4 a0 = *(const LAS s16x4*)(vp + ((x0 ^ k0) << 2)), a1 = *(const LAS s16x4*)(vp + ((x1 ^ k0) << 2)), b0 = *(const LAS s16x4*)(vp + 32 * VT_PITCH + ((x0 ^ k0 ^ 4) << 2)), b1 = *(const LAS s16x4*)(vp + 32 * VT_PITCH + ((x1 ^ k0 ^ 4) << 2));
                o0 = MFMA32(__builtin_shufflevector(a0, a1, 0, 1, 2, 3, 4, 5, 6, 7), __builtin_bit_cast(bf16x8, pw), o0);
                o1 = MFMA32(__builtin_shufflevector(b0, b1, 0, 1, 2, 3, 4, 5, 6, 7), __builtin_bit_cast(bf16x8, pw), o1); }
        }
        __builtin_amdgcn_sched_barrier(0);
    }
    sum += __shfl_xor(sum, 32);
    const float inv = 1.0f / (sum + __expf(sink - mx));
    bf16* op = MIX + (size_t)(qrow0 + tq) * D + CONVD + h * 64 + 4 * hi;
#pragma unroll
    for (int g = 0; g < 4; ++g) { u32x2 w; w.x = pk2(o0[4 * g] * inv, o0[4 * g + 1] * inv); w.y = pk2(o0[4 * g + 2] * inv, o0[4 * g + 3] * inv); *(u32x2*)(op + 8 * g) = w;
        w.x = pk2(o1[4 * g] * inv, o1[4 * g + 1] * inv); w.y = pk2(o1[4 * g + 2] * inv, o1[4 * g + 3] * inv); *(u32x2*)(op + 32 + 8 * g) = w; }
    __syncthreads();
}
__device__ __forceinline__ void phase_mix0(const Ctx& c, const Args& a) {
    if (c.vcu & 1) { convert_weights<2>(a, MK_P2_CONV, c.vcu * NWAVES + c.wave, c.G * NWAVES, c.lane); mix0_conv(c, a); mix0_kvstate(c, a); }
    for (int u = c.vcu; u < 160 * 8; u += c.G) attn_unit(c, a, u);
    if (!(c.vcu & 1)) { convert_weights<2>(a, MK_P2_CONV, c.vcu * NWAVES + c.wave, c.G * NWAVES, c.lane); mix0_conv(c, a); mix0_kvstate(c, a); }
}

__device__ __forceinline__ void phase_ffnfix(const Ctx& c, const Args& a, int layer) {
    const float* SIDE = (const float*)(a.ws + WS_SIDE); bf16* ACT = (bf16*)(a.ws + WS_ACT);
    const float* cw = a.conv_w_ffn + (size_t)layer * 3 * NUP; const float* cb = a.conv_b_ffn + (size_t)layer * NUP;
    const int gt = c.vcu * NTHR + c.tid, NT = c.G * NTHR; constexpr int NCH = DFF / 8;
    for (int it = gt; it < 32 * 2 * NCH; it += NT) {
        const int cc = it % NCH, tr = it / NCH, r = tr & 1, pm = tr >> 1, ch = cc * 8;
        if ((pm & 7) == 0) continue;
        const float* s2 = r == 0 ? SIDE + ((size_t)((pm - 1) * 4 + 2)) * NUP : SIDE + ((size_t)((pm - 1) * 4 + 3)) * NUP;
        const float* s1 = r == 0 ? SIDE + ((size_t)((pm - 1) * 4 + 3)) * NUP : SIDE + ((size_t)(pm * 4 + 0)) * NUP;
        const float* s0 = SIDE + ((size_t)(pm * 4 + r)) * NUP;
        float wg0[8], wg1[8], wg2[8], wu0[8], wu1[8], wu2[8], bg[8], bu[8], g2[8], g1[8], g0[8], u2[8], u1[8], u0[8], o[8];
        load8f(cw + ch, wg0); load8f(cw + NUP + ch, wg1); load8f(cw + 2 * NUP + ch, wg2); load8f(cw + DFF + ch, wu0); load8f(cw + NUP + DFF + ch, wu1); load8f(cw + 2 * NUP + DFF + ch, wu2);
        load8f(cb + ch, bg); load8f(cb + DFF + ch, bu);
        load8f(s2 + ch, g2); load8f(s2 + DFF + ch, u2); load8f(s1 + ch, g1); load8f(s1 + DFF + ch, u1); load8f(s0 + ch, g0); load8f(s0 + DFF + ch, u0);
#pragma unroll
        for (int e = 0; e < 8; ++e) { const float cg = wg0[e] * g2[e] + wg1[e] * g1[e] + wg2[e] * g0[e] + bg[e], cu = wu0[e] * u2[e] + wu1[e] * u1[e] + wu2[e] * u0[e] + bu[e];
            o[e] = cg / (1.0f + __expf(-cg)) * cu; }
        *(u32x4*)(ACT + (size_t)(pm * 256 + r) * DFF + ch) = pack8(o);
    }
}
constexpr int SG_PITCH = 136, SO_PITCH = 264;
constexpr int WL_OFF = 256 * SG_PITCH * 2, WL_PITCH = 136;
__device__ __forceinline__ void sgu_load_w(const Ctx& c, const Args& a, int g) {
    LAS bf16* WL = (LAS bf16*)(c.lds + RING_OFF + WL_OFF); const float* wsg = a.w_s + (size_t)g * 128 * 128;
#pragma unroll
    for (int i = 0; i < 8; ++i) { const int ci = c.tid + NTHR * i, t = ci >> 5, s0 = (ci & 31) * 4; const f32x4 w = *(const f32x4*)(wsg + (size_t)t * 128 + s0);
        u32x2 o; o.x = pk2(s0 + 0 <= t ? w.x : 0.f, s0 + 1 <= t ? w.y : 0.f); o.y = pk2(s0 + 2 <= t ? w.z : 0.f, s0 + 3 <= t ? w.w : 0.f);
        *(LAS u32x2*)(WL + t * WL_PITCH + s0) = o; }
}
__device__ __forceinline__ void sgu_unit(const Ctx& c, const Args& a, int unit, int& gcur) {
    const bf16* Z = (const bf16*)(a.ws + WS_Z); bf16* MIX = (bf16*)(a.ws + WS_MIX);
    const int tid = c.tid, wid = c.wave, lane = c.lane, l32 = lane & 31, hi = lane >> 5;
    int g, r0, nt;
    if (unit < 1024) { g = unit & 15; r0 = (unit >> 4) * 128; nt = 4; } else { const int u2 = unit - 1024; g = u2 & 15; r0 = MP + (u2 >> 4) * 64; nt = 2; }
    LAS bf16* VT = (LAS bf16*)(c.lds + RING_OFF); const LAS bf16* WL = (const LAS bf16*)(c.lds + RING_OFF + WL_OFF);
    LAS float* lnt = (LAS float*)(c.lds + TAB_OFF);
    const int cc = tid & 31, col = g * 256 + cc * 8;
    u32x4 zv[8], zu[8];
#pragma unroll
    for (int i = 0; i < 8; ++i) if (i < 2 * nt) { const bf16* zp = Z + (size_t)(r0 + (tid >> 5) + 16 * i) * NGM + col; zv[i] = *(const u32x4*)(zp + D); zu[i] = *(const u32x4*)zp; }
    float gg[8], bb[8]; load8f(a.ln_g + col, gg); load8f(a.ln_b + col, bb);
    if (g != gcur) { sgu_load_w(c, a, g); gcur = g; }
    { const int row = tid >> 2, qd = tid & 3;
      if (row < 32 * nt) { const f32x4* p = (const f32x4*)((const float*)(a.ws + WS_LS) + ((size_t)(r0 + row) * 128 + qd * 32) * 2);
          f32x4 s4 = p[0];
#pragma unroll
          for (int j = 1; j < 16; ++j) s4 += p[j];
          float s1 = s4.x + s4.z, s2 = s4.y + s4.w; s1 += __shfl_xor(s1, 1); s2 += __shfl_xor(s2, 1); s1 += __shfl_xor(s1, 2); s2 += __shfl_xor(s2, 2);
          const float mean = s1 * (1.f / D), var = fmaxf(s2 * (1.f / D) - mean * mean, 0.f);
          if (qd == 0) { lnt[2 * row] = mean; lnt[2 * row + 1] = 1.0f / sqrtf(var + LN_EPS); } } }
    __syncthreads();
#pragma unroll
    for (int i = 0; i < 8; ++i) if (i < 2 * nt) { const int s = (tid >> 5) + 16 * i;
        float f[8]; unpack8(zv[i], f);
        const float mean = lnt[2 * s], rstd = lnt[2 * s + 1];
#pragma unroll
        for (int e = 0; e < 8; ++e) f[e] = (f[e] - mean) * rstd * gg[e] + bb[e];
        if (r0 >= MP) store8f(a.out + O_GV + (size_t)(r0 - MP + s) * D + col, f);
        const u32x4 v = pack8(f);
        LAS bf16* vt = VT + (cc * 8) * SG_PITCH + ((((s >> 3) ^ cc) & 15) << 3) + (s & 7);
        vt[0 * SG_PITCH] = (bf16)(v.x & 0xffffu); vt[1 * SG_PITCH] = (bf16)(v.x >> 16); vt[2 * SG_PITCH] = (bf16)(v.y & 0xffffu); vt[3 * SG_PITCH] = (bf16)(v.y >> 16);
        vt[4 * SG_PITCH] = (bf16)(v.z & 0xffffu); vt[5 * SG_PITCH] = (bf16)(v.z >> 16); vt[6 * SG_PITCH] = (bf16)(v.w & 0xffffu); vt[7 * SG_PITCH] = (bf16)(v.w >> 16); }
    __syncthreads();
    f32x16 acc[4];
#pragma unroll
    for (int tb = 0; tb < 4; ++tb)
#pragma unroll
        for (int r = 0; r < 16; ++r) acc[tb][r] = 0.f;
#pragma unroll
    for (int ks = 0; ks < 8; ++ks) {
        if (ks < 2 * nt) {
            const bf16x8 bfr = *(const LAS bf16x8*)(VT + (32 * wid + l32) * SG_PITCH + ((((2 * ks + hi) ^ ((32 * wid + l32) >> 3)) & 15) << 3));
#pragma unroll
            for (int tb = 0; tb < 4; ++tb) {
                if (tb >= (ks >> 1) && tb < nt) { const bf16x8 afr = *(const LAS bf16x8*)(WL + (32 * tb + l32) * WL_PITCH + 16 * ks + 8 * hi); acc[tb] = MFMA32(afr, bfr, acc[tb]); }
            }
        }
    }
    __syncthreads();
    LAS bf16* SO = (LAS bf16*)(c.lds + RING_OFF);
#pragma unroll
    for (int tb = 0; tb < 4; ++tb) {
        if (tb < nt) {
#pragma unroll
            for (int r = 0; r < 16; ++r) { const int t = 32 * tb + crow(r, hi);
                SO[t * SO_PITCH + 32 * wid + l32] = (bf16)(pk2(acc[tb][r] + a.b_s[g * 128 + t], 0.f) & 0xffffu); }
        }
    }
    __syncthreads();
#pragma unroll
    for (int i = 0; i < 8; ++i) if (i < 2 * nt) { const int t = (tid >> 5) + 16 * i;
        float sv[8], uv[8], o[8]; unpack8(*(const LAS u32x4*)(SO + t * SO_PITCH + cc * 8), sv); unpack8(zu[i], uv);
#pragma unroll
        for (int e = 0; e < 8; ++e) o[e] = sv[e] * uv[e];
        *(u32x4*)(MIX + (size_t)(r0 + t) * D + col) = pack8(o); }
    __syncthreads();
}
__global__ void __launch_bounds__(NTHR, 2) mk_fwd(Args a) {
    extern __shared__ __attribute__((aligned(16))) unsigned char lds[];
    Ctx c; c.lds = (LAS unsigned char*)lds; c.tid = threadIdx.x; c.lane = c.tid & 63; c.wave = __builtin_amdgcn_readfirstlane(c.tid >> 6);
    c.G = gridDim.x; { const int bx = blockIdx.x; c.vcu = (c.G % 8 == 0) ? (bx % 8) * (c.G / 8) + bx / 8 : bx; }
    volatile LAS unsigned* MISC = (volatile LAS unsigned*)(c.lds + MISC_OFF);
    for (int u = c.tid; u < (LDS_BYTES - LDSCTL_OFF) / 4; u += NTHR) ((LAS unsigned*)(c.lds + LDSCTL_OFF))[u] = 0u;
    __syncthreads();
    unsigned char* ws = a.ws;
    unsigned* ctl = (unsigned*)(ws + WS_CTL);
    XcdBarrier bar; bar.bar = ctl + CW_BAR; bar.x = 0; bar.st = nullptr;
    if (N_LAUNCHES == 1) bar = xcd_barrier_post(ctl + CW_BAR, MISC + 8);
#define GRID_BAR() do { if (N_LAUNCHES == 1) xcd_barrier(bar); } while (0)
    const int lo = a.ph_lo, hi = a.ph_hi;
#define IN(k) (lo <= (k) && (k) < hi)
#define BOTH(k) (IN(k) && IN((k) + 1))
    bf16* XN = (bf16*)(ws + WS_XN); bf16* PROJ = (bf16*)(ws + WS_PROJ); bf16* MIX = (bf16*)(ws + WS_MIX);
    bf16* UP = (bf16*)(ws + WS_UP); bf16* ACT = (bf16*)(ws + WS_ACT); bf16* Z = (bf16*)(ws + WS_Z);
    LAS unsigned char* ring = c.lds + RING_OFF;
    float* RS = (float*)(ws + WS_RS); pg8::f32x2* LS = (pg8::f32x2*)(ws + WS_LS); LAS float* tab = (LAS float*)(c.lds + TAB_OFF);
#define SKS(gi) (pg8::SkShare{(float*)(ws + WS_SLAB) + (size_t)((gi) & 1) * 256 * 65536, ctl + CW_SK + (gi) * 256 * 16, ctl})
    const int bx = (int)blockIdx.x;

    if (IN(0)) { phase_prologue(c, a); if (BOTH(0)) GRID_BAR(); }
    if (IN(1)) {
        pg8::Gemm g{XN, (const bf16*)(ws + WS_WIN), M, NPROJ, D}; pg8::SkOrder S; S.init(M, NPROJ, D, c.G, bx, false); pg8::EpiBf16<0, false, false> E{PROJ, NPROJ, nullptr, nullptr, nullptr, 0};
        pg8::gemm_phase<pg8::EpiBf16<0, false, false>, pg8::SkOrder, true, true>(ring, g, S, E, SKS(0));
        if (BOTH(1)) GRID_BAR(); }
    if (IN(2)) { phase_mix0(c, a); if (BOTH(2)) GRID_BAR(); }
    if (IN(3)) {
        pg8::Gemm g{MIX, (const bf16*)(ws + WS_WOUT), M, D, D}; pg8::SkOrder S; S.init(M, D, D, c.G, bx, false); S.quad = MK_QUAD; pg8::EpiRes<true, true> E{a.x_p, a.x_s, XN, RS, D, MP};
        pg8::gemm_phase<pg8::EpiRes<true, true>, pg8::SkOrder, true, true>(ring, g, S, E, SKS(1));
        if (BOTH(3)) GRID_BAR(); }
    if (IN(5)) {
        pg8::Gemm g{XN, (const bf16*)(ws + WS_WUP), M, NUP, D}; pg8::SkOrder S; S.init(M, NUP, D, c.G, bx, false); S.bst = MK_BST; pg8::EpiConvGate E{ACT, RS, (LAS float*)(c.lds + TABC_OFF), (LAS bf16*)(c.lds + BND_OFF), a.conv_w_ffn + (size_t)0 * 3 * NUP, a.conv_b_ffn + (size_t)0 * NUP, a.st_ffn + (size_t)0 * 32 * 2 * NUP, (float*)(ws + WS_SIDE), a.out + O_FP + (size_t)0 * 4 * 2 * NUP, a.out + O_FS + (size_t)0 * 32 * 2 * NUP};
        pg8::gemm_phase<pg8::EpiConvGate, pg8::SkOrder, true, true>(ring, g, S, E, SKS(2));
        if (BOTH(5)) GRID_BAR(); }
    if (IN(6)) { phase_ffnfix(c, a, 0); if (BOTH(6)) GRID_BAR(); }
    if (IN(7)) {
        pg8::Gemm g{ACT, (const bf16*)(ws + WS_WDN), M, D, DFF}; pg8::SkOrder S; S.init(M, D, DFF, c.G, bx, true); S.quad = MK_QUAD; pg8::EpiRes<false, true> E{nullptr, nullptr, XN, RS, D, MP};
        pg8::gemm_phase<pg8::EpiRes<false, true>, pg8::SkOrder, true, true>(ring, g, S, E, SKS(3));
        if (BOTH(7)) GRID_BAR(); }
    if (IN(9)) {
        pg8::Gemm g{XN, (const bf16*)(ws + WS_WINC), M, NGM, D}; pg8::SkOrder S; S.init(M, NGM, D, c.G, bx, false); pg8::EpiBf16<1, true, true> E{Z, NGM, RS, tab, LS, 16};
        pg8::gemm_phase<pg8::EpiBf16<1, true, true>, pg8::SkOrder, true, true>(ring, g, S, E, SKS(4));
        if (BOTH(9)) GRID_BAR(); }
    if (IN(11)) { int gcur = -1; for (int u = c.vcu; u < 1024 + 512; u += c.G) sgu_unit(c, a, u, gcur); if (BOTH(11)) GRID_BAR(); }
    if (IN(12)) {
        pg8::Gemm g{MIX, (const bf16*)(ws + WS_WOUTC), M, D, D}; pg8::SkOrder S; S.init(M, D, D, c.G, bx, false); S.quad = MK_QUAD; pg8::EpiRes<false, true> E{nullptr, nullptr, XN, RS, D, MP};
        pg8::gemm_phase<pg8::EpiRes<false, true>, pg8::SkOrder, true, true>(ring, g, S, E, SKS(5));
        if (BOTH(12)) GRID_BAR(); }
    if (IN(14)) {
        pg8::Gemm g{XN, (const bf16*)(ws + WS_WUP) + (size_t)NUP * D, M, NUP, D}; pg8::SkOrder S; S.init(M, NUP, D, c.G, bx, false); S.bst = MK_BST; pg8::EpiConvGate E{ACT, RS, (LAS float*)(c.lds + TABC_OFF), (LAS bf16*)(c.lds + BND_OFF), a.conv_w_ffn + (size_t)1 * 3 * NUP, a.conv_b_ffn + (size_t)1 * NUP, a.st_ffn + (size_t)1 * 32 * 2 * NUP, (float*)(ws + WS_SIDE), a.out + O_FP + (size_t)1 * 4 * 2 * NUP, a.out + O_FS + (size_t)1 * 32 * 2 * NUP};
        pg8::gemm_phase<pg8::EpiConvGate, pg8::SkOrder, true, true>(ring, g, S, E, SKS(6));
        if (BOTH(14)) GRID_BAR(); }
    if (IN(15)) { phase_ffnfix(c, a, 1); if (BOTH(15)) GRID_BAR(); }
    if (IN(16)) {
        pg8::Gemm g{ACT, (const bf16*)(ws + WS_WDN) + (size_t)D * DFF, M, D, DFF}; pg8::SkOrder S; S.init(M, D, DFF, c.G, bx, true); S.quad = MK_QUAD; pg8::EpiRes<false, true> E{nullptr, nullptr, XN, RS, D, MP};
        pg8::gemm_phase<pg8::EpiRes<false, true>, pg8::SkOrder, true, true>(ring, g, S, E, SKS(7));
        if (BOTH(16)) GRID_BAR(); }
    if (IN(17)) { phase_final(c, XN, RS, a.norm_final, a.out); }
#undef IN
#undef BOTH
}

extern "C" void kernel_launch(void* const* d_in, const int* in_sizes, int n_in, void* d_out, int out_size, void* d_ws, size_t ws_size, hipStream_t stream) {
    static int grid = 0;
    if (grid == 0) {
        if (n_in != 23 || in_sizes[0] != MP * D || (size_t)out_size != O_END || ws_size < WS_END) {
            fprintf(stderr, "kernel_launch: shape mismatch: n_in %d in0 %d out %d (want %zu) ws %zu (want %zu); nothing launched\n", n_in, n_in > 0 ? in_sizes[0] : -1, out_size, (size_t)O_END, ws_size, (size_t)WS_END); grid = -1; return; }
        int dev = 0, cus = 0, per_cu = 0;
        if (hipGetDevice(&dev) != hipSuccess || hipDeviceGetAttribute(&cus, hipDeviceAttributeMultiprocessorCount, dev) != hipSuccess) { grid = -1; return; }
        if (hipFuncSetAttribute((const void*)mk_fwd, hipFuncAttributeMaxDynamicSharedMemorySize, LDS_BYTES) != hipSuccess) { fprintf(stderr, "kernel_launch: hipFuncSetAttribute failed\n"); grid = -1; return; }
        if (hipOccupancyMaxActiveBlocksPerMultiprocessor(&per_cu, (const void*)mk_fwd, NTHR, LDS_BYTES) != hipSuccess || per_cu < 1) fprintf(stderr, "kernel_launch: occupancy query reports %d blocks per CU\n", per_cu);
        (void)hipGetLastError();
        grid = cus;
    }
    if (grid < 0) return;
    if (hipMemsetAsync((char*)d_ws + WS_CTL, 0, CTL_ZERO_BYTES, stream) != hipSuccess) { fprintf(stderr, "kernel_launch: memset failed\n"); return; }
    Args a{};
    const float* const* in = (const float* const*)d_in;
    a.x_p = in[0]; a.x_s = in[1]; a.st_conv = in[2]; a.cache_k = in[3]; a.cache_v = in[4]; a.st_ffn = in[5]; a.norm_mix = in[6]; a.norm_ffn = in[7]; a.norm_final = in[8]; a.w_in_ab = in[9];
    a.conv_w_a = in[10]; a.sinks = in[11]; a.w_out_ab = in[12]; a.w_in_c = in[13]; a.ln_g = in[14]; a.ln_b = in[15]; a.w_s = in[16]; a.b_s = in[17]; a.w_out_c = in[18]; a.w_up = in[19];
    a.conv_w_ffn = in[20]; a.conv_b_ffn = in[21]; a.w_down = in[22];
    a.out = (float*)d_out; a.ws = (unsigned char*)d_ws;
    for (int li = 0; li < N_LAUNCHES; ++li) {
        a.ph_lo = (N_LAUNCHES == 1) ? 0 : li; a.ph_hi = (N_LAUNCHES == 1) ? N_PHASES : li + 1;
        hipLaunchKernelGGL(mk_fwd, dim3(grid), dim3(NTHR), LDS_BYTES, stream, a);
        const hipError_t le = hipPeekAtLastError();
        if (le != hipSuccess) { fprintf(stderr, "kernel_launch: launch %d failed: %s\n", li, hipGetErrorName(le)); break; }
    }
}
```
